# Optimizing an MI355X kernel written in HIP

```python
import jax, jax.numpy as jnp
from jax import lax
import numpy as np

D_MODEL = 1024
BATCH = 16
SEQ = 4096
DEPTH = 4

GRID_W = 64
CTX_LEN = 256
D_CONV = D_MODEL // 4
CONV_K = 3
D_GMLP = D_MODEL // 4
GMLP_GROUPS = 4
GMLP_CHUNK = 128
HEAD_DIM = 64
N_HEADS = D_MODEL // 128
N_KV_HEADS = N_HEADS // 4
Q_PER_KV = N_HEADS // N_KV_HEADS
WINDOW = 128
ATT_BLOCK = 128
ROPE_BASE = 10000.0
N_BRANCH = 3
D_FF_DENSE = ((8 * D_MODEL // 3) + 255) // 256 * 256
N_EXPERTS = 8
TOP_K = 2
D_FF_EXPERT = 7 * D_MODEL // 2
N_DENSE = (DEPTH + 1) // 2
N_MOE = DEPTH // 2
EPS = 1e-6
NEG_INF = -1e30

OFF_CONV = 0
OFF_GMLP = OFF_CONV + 3 * D_CONV
OFF_Q = OFF_GMLP + 2 * D_GMLP
OFF_K = OFF_Q + N_HEADS * HEAD_DIM
OFF_V = OFF_K + N_KV_HEADS * HEAD_DIM
OFF_GATE = OFF_V + N_KV_HEADS * HEAD_DIM
D_IN = OFF_GATE + N_BRANCH * D_MODEL
KV_W = N_KV_HEADS * HEAD_DIM

kernel_name = "hybrid_parallel_conv_gmlp_swa_moe_dit"


def rms_norm(x, g):
    xf = x.astype(jnp.float32)
    y = xf * lax.rsqrt(jnp.mean(xf * xf, axis=-1, keepdims=True) + EPS)
    return (y * g.astype(jnp.float32)).astype(x.dtype)


def ada_params(cvec, w_mod, b_mod, n):
    m = jax.nn.silu(cvec) @ w_mod[:, :n * D_MODEL] + b_mod[:n * D_MODEL]
    return [p[..., None, :] for p in jnp.split(m, n, axis=-1)]


def modulate(h, shift, scale):
    return h * (1.0 + scale) + shift


def short_conv(z, w):
    L = z.shape[1]
    pad = CONV_K // 2
    zp = jnp.pad(z, ((0, 0), (pad, pad), (0, 0)))
    out = zp[:, 0:L] * w[0]
    for j in range(1, CONV_K):
        out = out + zp[:, j:j + L] * w[j]
    return out


def conv_branch(z, conv_w):
    b_g = z[..., OFF_CONV:OFF_CONV + D_CONV]
    c_g = z[..., OFF_CONV + D_CONV:OFF_CONV + 2 * D_CONV]
    h = z[..., OFF_CONV + 2 * D_CONV:OFF_GMLP]
    return b_g * short_conv(c_g * h, conv_w)


def gmlp_branch(z, ws, bs):
    uv = jax.nn.gelu(z[..., OFF_GMLP:OFF_Q])
    u, v = uv[..., :D_GMLP], uv[..., D_GMLP:]
    vf = v.astype(jnp.float32)
    mu = jnp.mean(vf, axis=-1, keepdims=True)
    var = jnp.mean(jnp.square(vf - mu), axis=-1, keepdims=True)
    vn = ((vf - mu) * lax.rsqrt(var + EPS)).astype(v.dtype)
    b_, L, _ = v.shape
    nc = L // GMLP_CHUNK
    vn = vn.reshape(b_, nc, GMLP_CHUNK, GMLP_GROUPS, D_GMLP // GMLP_GROUPS)
    sp = jnp.einsum("gpq,bnqgc->bnpgc", ws, vn) + bs.T[None, None, :, :, None]
    return u * sp.reshape(b_, L, D_GMLP)


def rope_tables(L):
    rows = L // GRID_W
    row = jnp.repeat(jnp.arange(rows), GRID_W).astype(jnp.float32)
    col = jnp.tile(jnp.arange(GRID_W), rows).astype(jnp.float32)
    half = HEAD_DIM // 2
    inv = 1.0 / (ROPE_BASE ** (jnp.arange(0, half, 2, dtype=jnp.float32) / half))
    ang_r = row[:, None] * inv[None, :]
    ang_c = col[:, None] * inv[None, :]
    ang = jnp.concatenate([ang_r, ang_r, ang_c, ang_c], axis=-1)
    return jnp.cos(ang), jnp.sin(ang)


def apply_rope_2d(x, cos, sin):
    half = HEAD_DIM // 2
    q = half // 2

    def rot(xh):
        return jnp.concatenate([-xh[..., q:], xh[..., :q]], axis=-1)

    xr = jnp.concatenate([rot(x[..., :half]), rot(x[..., half:])], axis=-1)
    c = cos.astype(x.dtype)[None, :, None, :]
    s = sin.astype(x.dtype)[None, :, None, :]
    return x * c + xr * s


def joint_softmax(sink, parts):
    m = sink
    for p in parts:
        m = jnp.maximum(m, jnp.max(p, axis=-1, keepdims=True))
    es = [jnp.exp(p - m) for p in parts]
    den = jnp.exp(sink - m)
    for e in es:
        den = den + jnp.sum(e, axis=-1, keepdims=True)
    inv = 1.0 / den
    return [e * inv for e in es]


def latent_attention(q, k, v, kc, vc, sink):
    b_, S = q.shape[0], q.shape[1]
    nb = S // ATT_BLOCK
    scale = HEAD_DIM ** -0.5
    qb = q.reshape(b_, nb, ATT_BLOCK, N_KV_HEADS, Q_PER_KV, HEAD_DIM)

    def band(t):
        tp = jnp.pad(t, ((0, 0), (ATT_BLOCK, ATT_BLOCK), (0, 0), (0, 0)))
        tp = tp.reshape(b_, nb + 2, ATT_BLOCK, N_KV_HEADS, HEAD_DIM)
        return jnp.concatenate([tp[:, :-2], tp[:, 1:-1], tp[:, 2:]], axis=2)

    kb, vb = band(k), band(v)
    s_loc = jnp.einsum("bnqkgd,bnjkd->bnkgqj", qb, kb, preferred_element_type=jnp.float32) * scale
    blk = jnp.arange(nb)[:, None, None]
    qpos = blk * ATT_BLOCK + jnp.arange(ATT_BLOCK)[None, :, None]
    kpos = (blk - 1) * ATT_BLOCK + jnp.arange(3 * ATT_BLOCK)[None, None, :]
    valid = (kpos >= 0) & (kpos < S) & (jnp.abs(qpos - kpos) <= WINDOW)
    s_loc = jnp.where(valid[None, :, None, None], s_loc, NEG_INF)
    s_ctx = jnp.einsum("bnqkgd,bckd->bnkgqc", qb, kc, preferred_element_type=jnp.float32) * scale
    sink_l = sink.astype(jnp.float32).reshape(N_KV_HEADS, Q_PER_KV)[:, :, None, None]
    p_loc, p_ctx = joint_softmax(sink_l, [s_loc, s_ctx])
    o = (jnp.einsum("bnkgqj,bnjkd->bnqkgd", p_loc.astype(v.dtype), vb)
         + jnp.einsum("bnkgqc,bckd->bnqkgd", p_ctx.astype(vc.dtype), vc))
    return o.reshape(b_, S, N_HEADS * HEAD_DIM)


def context_attention(qc, kc, vc, sink):
    b_, Lc = qc.shape[0], qc.shape[1]
    qg = qc.reshape(b_, Lc, N_KV_HEADS, Q_PER_KV, HEAD_DIM)
    s = jnp.einsum("bqkgd,bckd->bkgqc", qg, kc, preferred_element_type=jnp.float32) * (HEAD_DIM ** -0.5)
    sink_l = sink.astype(jnp.float32).reshape(N_KV_HEADS, Q_PER_KV)[:, :, None, None]
    (p,) = joint_softmax(sink_l, [s])
    o = jnp.einsum("bkgqc,bckd->bqkgd", p.astype(vc.dtype), vc)
    return o.reshape(b_, Lc, N_HEADS * HEAD_DIM)


def merge_branches(z, y_conv, y_gmlp, y_attn, w_bc, w_bg, w_ba, w_o):
    g = jax.nn.sigmoid(z[..., OFF_GATE:])
    mix = (g[..., :D_MODEL] * (y_conv @ w_bc)
           + g[..., D_MODEL:2 * D_MODEL] * (y_gmlp @ w_bg)
           + g[..., 2 * D_MODEL:] * (y_attn @ w_ba))
    return mix @ w_o


def token_mixers(hx, hc, w_in, conv_w, gm_ws, gm_b, sink, w_bc, w_bg, w_ba, w_o, cos, sin, ctx_out):
    b_, S = hx.shape[0], hx.shape[1]
    Lc = hc.shape[1]
    zx = hx @ w_in
    if ctx_out:
        zc = hc @ w_in
        zkv = zc[..., OFF_K:OFF_GATE]
    else:
        zkv = hc @ w_in[:, OFF_K:OFF_GATE]
    kc = zkv[..., :KV_W].reshape(b_, Lc, N_KV_HEADS, HEAD_DIM)
    vc = zkv[..., KV_W:].reshape(b_, Lc, N_KV_HEADS, HEAD_DIM)
    q = apply_rope_2d(zx[..., OFF_Q:OFF_K].reshape(b_, S, N_HEADS, HEAD_DIM), cos, sin)
    k = apply_rope_2d(zx[..., OFF_K:OFF_V].reshape(b_, S, N_KV_HEADS, HEAD_DIM), cos, sin)
    v = zx[..., OFF_V:OFF_GATE].reshape(b_, S, N_KV_HEADS, HEAD_DIM)
    ya = latent_attention(q, k, v, kc, vc, sink)
    out_x = merge_branches(zx, conv_branch(zx, conv_w), gmlp_branch(zx, gm_ws, gm_b), ya,
                           w_bc, w_bg, w_ba, w_o)
    out_c = None
    if ctx_out:
        qc = zc[..., OFF_Q:OFF_K].reshape(b_, Lc, N_HEADS, HEAD_DIM)
        yac = context_attention(qc, kc, vc, sink)
        out_c = merge_branches(zc, conv_branch(zc, conv_w), gmlp_branch(zc, gm_ws, gm_b), yac,
                               w_bc, w_bg, w_ba, w_o)
    return out_x, out_c


def swiglu(h, w_gu, w_d):
    gu = h @ w_gu
    g, u = jnp.split(gu, 2, axis=-1)
    return (jax.nn.silu(g) * u) @ w_d


def moe_swiglu(h, router, w_gu, w_d):
    logits = jnp.einsum("bld,de->ble", h, router, preferred_element_type=jnp.float32)
    top_v, top_i = lax.top_k(logits, TOP_K)
    top_w = jax.nn.softmax(top_v, axis=-1)
    gates = jnp.sum(jax.nn.one_hot(top_i, N_EXPERTS, dtype=jnp.float32) * top_w[..., None], axis=-2)
    gates = gates.astype(h.dtype)
    y = gates[..., 0:1] * swiglu(h, w_gu[0], w_d[0])
    for e in range(1, N_EXPERTS):
        y = y + gates[..., e:e + 1] * swiglu(h, w_gu[e], w_d[e])
    return y


def channel_mixer(h, i, ffn_w_gu, ffn_w_d, moe_router, moe_w_gu, moe_w_d):
    if i % 2 == 0:
        return swiglu(h, ffn_w_gu[i // 2], ffn_w_d[i // 2])
    j = i // 2
    return moe_swiglu(h, moe_router[j], moe_w_gu[j], moe_w_d[j])


def setup_inputs(seed: int = 0) -> dict:
    key = jax.random.key(seed)
    ks = jax.random.split(key, 24)
    f32 = jnp.float32

    def nrm(k, shape, scale):
        return jax.random.normal(k, shape, f32) * scale

    D = D_MODEL
    return {
        "x": nrm(ks[0], (BATCH, SEQ, D), 1.0),
        "c": nrm(ks[1], (BATCH, D), 1.0),
        "ctx": nrm(ks[2], (BATCH, CTX_LEN, D), 1.0),
        "c_ctx": nrm(ks[3], (D,), 1.0),
        "w_mod": nrm(ks[4], (DEPTH, D, 6 * D), 0.5 * D ** -0.5),
        "b_mod": nrm(ks[5], (DEPTH, 6 * D), 0.01),
        "norm1_g": 1.0 + nrm(ks[6], (DEPTH, D), 0.05),
        "norm2_g": 1.0 + nrm(ks[7], (DEPTH, D), 0.05),
        "w_in": nrm(ks[8], (DEPTH, D, D_IN), D ** -0.5),
        "conv_w": nrm(ks[9], (DEPTH, CONV_K, D_CONV), CONV_K ** -0.5),
        "gmlp_ws": nrm(ks[10], (DEPTH, GMLP_GROUPS, GMLP_CHUNK, GMLP_CHUNK), GMLP_CHUNK ** -0.5),
        "gmlp_b": 1.0 + nrm(ks[11], (DEPTH, GMLP_GROUPS, GMLP_CHUNK), 0.05),
        "attn_sink": nrm(ks[12], (DEPTH, N_HEADS), 0.5),
        "w_br_conv": nrm(ks[13], (DEPTH, D_CONV, D), D_CONV ** -0.5),
        "w_br_gmlp": nrm(ks[14], (DEPTH, D_GMLP, D), D_GMLP ** -0.5),
        "w_br_attn": nrm(ks[15], (DEPTH, N_HEADS * HEAD_DIM, D), (N_HEADS * HEAD_DIM) ** -0.5),
        "w_out": nrm(ks[16], (DEPTH, D, D), D ** -0.5),
        "ffn_w_gu": nrm(ks[17], (N_DENSE, D, 2 * D_FF_DENSE), D ** -0.5),
        "ffn_w_d": nrm(ks[18], (N_DENSE, D_FF_DENSE, D), D_FF_DENSE ** -0.5),
        "moe_router": nrm(ks[19], (N_MOE, D, N_EXPERTS), D ** -0.5),
        "moe_w_gu": nrm(ks[20], (N_MOE, N_EXPERTS, D, 2 * D_FF_EXPERT), D ** -0.5),
        "moe_w_d": nrm(ks[21], (N_MOE, N_EXPERTS, D_FF_EXPERT, D), D_FF_EXPERT ** -0.5),
        "final_norm_g": 1.0 + nrm(ks[22], (D,), 0.05),
    }


def reference(x, c, ctx, c_ctx, w_mod, b_mod, norm1_g, norm2_g, w_in, conv_w, gmlp_ws, gmlp_b,
              attn_sink, w_br_conv, w_br_gmlp, w_br_attn, w_out, ffn_w_gu, ffn_w_d,
              moe_router, moe_w_gu, moe_w_d, final_norm_g):
    cos, sin = rope_tables(x.shape[1])
    cx = ctx
    for i in range(DEPTH):
        last = i == DEPTH - 1
        sh1, sc1, g1, sh2, sc2, g2 = ada_params(c, w_mod[i], b_mod[i], 6)
        if last:
            csh1, csc1 = ada_params(c_ctx, w_mod[i], b_mod[i], 2)
        else:
            csh1, csc1, cg1, csh2, csc2, cg2 = ada_params(c_ctx, w_mod[i], b_mod[i], 6)
        hx = modulate(rms_norm(x, norm1_g[i]), sh1, sc1)
        hc = modulate(rms_norm(cx, norm1_g[i]), csh1, csc1)
        ax, ac = token_mixers(hx, hc, w_in[i], conv_w[i], gmlp_ws[i], gmlp_b[i], attn_sink[i],
                              w_br_conv[i], w_br_gmlp[i], w_br_attn[i], w_out[i], cos, sin,
                              not last)
        x = x + g1 * ax
        hx = modulate(rms_norm(x, norm2_g[i]), sh2, sc2)
        x = x + g2 * channel_mixer(hx, i, ffn_w_gu, ffn_w_d, moe_router, moe_w_gu, moe_w_d)
        if not last:
            cx = cx + cg1 * ac
            hc = modulate(rms_norm(cx, norm2_g[i]), csh2, csc2)
            cx = cx + cg2 * channel_mixer(hc, i, ffn_w_gu, ffn_w_d, moe_router, moe_w_gu, moe_w_d)
    return rms_norm(x, final_norm_g)
```

```cpp
#include <hip/hip_runtime.h>
#include <hip/hip_bf16.h>
#include <cstdio>
#include <cstdint>

#ifndef USE_AGPR
#define USE_AGPR 0
#endif
#ifndef Z8
#define Z8 0
#endif
#ifndef MERGE8
#define MERGE8 0
#endif
#ifndef MK_MULTI
#define MK_MULTI 0
#endif

constexpr int D = 1024, NB = 16, SEQ = 4096, CTXL = 256, DEPTH = 4;
constexpr int TX = NB * SEQ, TC = NB * CTXL, T = TX + TC;
constexpr int DIN = 5120, DFF = 2816, DFE = 3584, NEXP = 8, NMODR = 17;
constexpr int NPX = TX / 256, NPA = T / 256;
constexpr int SROWS = 2 * T + 2048;
constexpr float EPS = 1e-6f;
constexpr float QSCALE = 0.125f * 1.4426950408889634f;
constexpr float A8_SCALE = 8.0f, W_GU_SCALE = 64.0f, H8_SCALE = 4.0f, W_D_SCALE = 128.0f, GP8_SCALE = 16.0f;

constexpr size_t al256(size_t x) { return (x + 255) & ~(size_t)255; }
constexpr size_t WS_CTL = 0, CTL_BYTES = 1u << 20;
constexpr size_t WS_MOD = WS_CTL + CTL_BYTES;
constexpr size_t WS_ROPE = WS_MOD + al256((size_t)DEPTH * NMODR * 6 * D * 4);
constexpr size_t WS_GWS = WS_ROPE + 8192;
constexpr size_t WS_SELE = WS_GWS + (size_t)DEPTH * 4 * 128 * 128 * 2;
constexpr size_t WS_SELW = WS_SELE + al256((size_t)T * 4);
constexpr size_t WS_CNT = WS_SELW + al256((size_t)T * 8);
constexpr size_t WS_META = WS_CNT + 8192;
constexpr size_t WS_RINFO = WS_META + 256;
constexpr size_t WS_XC = WS_RINFO + al256((size_t)SROWS * 4);
constexpr size_t WS_WIN = WS_XC + (size_t)TC * D * 4;
constexpr size_t WS_WG8 = WS_WIN + (size_t)DEPTH * 2048 * D * 2;
constexpr size_t WS_WO8 = WS_WG8 + (size_t)DEPTH * 3072 * D;
static_assert(WS_WO8 + (size_t)DEPTH * D * 3072 <= WS_WIN + (size_t)DEPTH * DIN * D * 2, "fp8 copies fit the w_in region");
constexpr size_t WS_WBR = WS_WIN + (size_t)DEPTH * DIN * D * 2;
constexpr size_t WS_WO = WS_WBR + (size_t)DEPTH * D * D * 2;
constexpr size_t WS_FGU = WS_WO + (size_t)DEPTH * D * D * 2;
constexpr size_t WS_FD = WS_FGU + (size_t)2 * 2 * DFF * D * 2;
constexpr size_t WS_MGU = WS_FD + (size_t)2 * D * DFF * 2;
constexpr size_t WS_MD = WS_MGU + (size_t)2 * NEXP * 2 * DFE * D;
constexpr size_t WS_RA = WS_MD + (size_t)2 * NEXP * D * DFE;
constexpr size_t RA_BYTES = (size_t)SROWS * D * 2;
constexpr size_t WS_RH = WS_RA + RA_BYTES;
constexpr size_t RH_BYTES = (size_t)SROWS * DFE * 2;
constexpr size_t WS_END = WS_RH + RH_BYTES;
static_assert((size_t)2 * T * D * 2 <= RA_BYTES, "Yslot fits region A");
static_assert(WS_END <= (size_t)1879048192, "d_ws map exceeds 4x largest tensor");
constexpr size_t RH_ZC = 0;
constexpr size_t RH_ZG = RH_ZC + (size_t)T * 768 * 2;
constexpr size_t RH_Q = RH_ZG + (size_t)T * 512 * 2;
constexpr size_t RH_K = RH_Q + (size_t)T * 512 * 2;
constexpr size_t RH_V = RH_K + (size_t)T * 128 * 2;
constexpr size_t RH_G = RH_V + (size_t)T * 128 * 2;
constexpr size_t RH_ZEND = RH_G + (size_t)T * 3072 * 2;
constexpr size_t RH_BUFA = RH_ZEND;
constexpr size_t RH_BUFB = RH_BUFA + (size_t)T * D * 2;
constexpr size_t RH_GP8 = 0;
static_assert((size_t)T * 3072 <= RH_G, "gated products fit below the gates");
constexpr size_t RH_HD = 0;
static_assert(RH_BUFB + (size_t)T * D * 2 <= RH_BYTES && (size_t)T * DFF * 2 <= RH_ZEND, "region H overlays");

#define LAS __attribute__((address_space(3)))
#define GAS __attribute__((address_space(1)))
typedef unsigned short bf16_t;
typedef short bf16x8 __attribute__((ext_vector_type(8)));
typedef float f32x4 __attribute__((ext_vector_type(4)));
typedef float f32x2 __attribute__((ext_vector_type(2)));
typedef float f32x16 __attribute__((ext_vector_type(16)));
typedef unsigned u32x4 __attribute__((ext_vector_type(4)));
typedef unsigned u32x2 __attribute__((ext_vector_type(2)));
#define LDS_WAIT() asm volatile("s_waitcnt lgkmcnt(0)" ::: "memory")
#define VM_WAIT() asm volatile("s_waitcnt vmcnt(0)" ::: "memory")

typedef __bf16 bf16x2_v __attribute__((ext_vector_type(2)));
__device__ __forceinline__ unsigned cvt_pk_bf16(float lo, float hi) { const f32x2 v = {lo, hi}; const bf16x2_v b = __builtin_convertvector(v, bf16x2_v); return __builtin_bit_cast(unsigned, b); }
__device__ __forceinline__ float clamp8(float v) { return __builtin_fminf(__builtin_fmaxf(v, -448.0f), 448.0f); }
__device__ __forceinline__ unsigned pk4_fp8(float a, float b, float c, float d) { int w = 0; w = __builtin_amdgcn_cvt_pk_fp8_f32(clamp8(a), clamp8(b), w, false); w = __builtin_amdgcn_cvt_pk_fp8_f32(clamp8(c), clamp8(d), w, true); return (unsigned)w; }
__device__ __forceinline__ float bf_lo(unsigned u) { return __uint_as_float(u << 16); }
__device__ __forceinline__ float bf_hi(unsigned u) { return __uint_as_float(u & 0xffff0000u); }
__device__ __forceinline__ u32x4 pack8(f32x4 a, f32x4 b) { u32x4 w; w.x = cvt_pk_bf16(a[0], a[1]); w.y = cvt_pk_bf16(a[2], a[3]); w.z = cvt_pk_bf16(b[0], b[1]); w.w = cvt_pk_bf16(b[2], b[3]); return w; }
__device__ __forceinline__ void unpack8(u32x4 w, f32x4& a, f32x4& b) { a = (f32x4){bf_lo(w.x), bf_hi(w.x), bf_lo(w.y), bf_hi(w.y)}; b = (f32x4){bf_lo(w.z), bf_hi(w.z), bf_lo(w.w), bf_hi(w.w)}; }
__device__ __forceinline__ float fast_sigmoid(float x) { return __builtin_amdgcn_rcpf(1.0f + __builtin_amdgcn_exp2f(-1.4426950408889634f * x)); }
__device__ __forceinline__ float fast_silu(float x) { return x * fast_sigmoid(x); }
__device__ __forceinline__ float gelu_tanh(float x) { const float t = x * (1.0f + 0.044715f * x * x); return x * __builtin_amdgcn_rcpf(1.0f + __builtin_amdgcn_exp2f(-2.302208198f * t)); }
template <class Tp> __device__ __forceinline__ Tp* as_global(GAS Tp* p) { return (Tp*)p; }
template <int K> __device__ __forceinline__ float xor_lane(float v) { return __int_as_float(__builtin_amdgcn_ds_swizzle(__float_as_int(v), (K << 10) | 0x1F)); }
__device__ __forceinline__ float wave_sum(float v) {
    v += xor_lane<1>(v); v += xor_lane<2>(v); v += xor_lane<4>(v); v += xor_lane<8>(v); v += xor_lane<16>(v);
    const auto rr = __builtin_amdgcn_permlane32_swap(__float_as_uint(v), __float_as_uint(v), false, false);
    return __uint_as_float(rr[0]) + __uint_as_float(rr[1]);
}
__device__ __forceinline__ int lane_read(int v, int srclane) { return __builtin_amdgcn_ds_bpermute(srclane << 2, v); }

constexpr int WAVEMAP_OFF = 131072 + 256;
__device__ __forceinline__ int hw_wave_key() { return (int)(__builtin_amdgcn_s_getreg((6 << 11) | 4) & 63u); }
__device__ __forceinline__ int opaque_tid() { int key_ = hw_wave_key(); asm volatile("" : "+s"(key_)); int w = *(volatile LAS int*)(unsigned long)(WAVEMAP_OFF + 4 * key_); unsigned z0 = 0u; asm volatile("" : "+v"(z0)); int l = (int)__builtin_amdgcn_mbcnt_hi(~0u, __builtin_amdgcn_mbcnt_lo(~0u, z0)); int t = (w << 6) | l; asm volatile("" : "+v"(t)); return t; }
#define XB_TMO      128
#define XB_XCNT(j)  (256  + 64 * (j))
#define XB_XSUB(j)  (1280 + 64 * (j))
#define XB_XGEN(j)  (2304 + 64 * (j))
#define XB_TOP      3328
#define XB_TOPGEN   3392
#define XCD_BAR_WORDS 3456
#define XB_SPIN_CAP (1u << 18)
__device__ __forceinline__ unsigned xb_ld(unsigned* p)              { return __hip_atomic_load(p, __ATOMIC_RELAXED, __HIP_MEMORY_SCOPE_AGENT); }
__device__ __forceinline__ unsigned xb_add(unsigned* p, unsigned v) { return __hip_atomic_fetch_add(p, v, __ATOMIC_RELAXED, __HIP_MEMORY_SCOPE_AGENT); }
__device__ __forceinline__ unsigned xb_xcc_id() { return (unsigned)__builtin_amdgcn_s_getreg((3 << 11) | 20) & 0xFu; }
#define XB_SPIN(cond, bar) do { unsigned _sp = 0; while (cond) { __builtin_amdgcn_s_sleep(1); \
    if ((++_sp & 255u) == 0u) { if (xb_ld(&(bar)[XB_TMO])) break; if (_sp > XB_SPIN_CAP) { atomicAdd(&(bar)[XB_TMO], 1u); break; } } } } while (0)
struct XcdBarrier { unsigned* bar; unsigned x; volatile LAS unsigned* st; };
__device__ __forceinline__ XcdBarrier xcd_barrier_post(unsigned* bar, volatile LAS unsigned* st) {
    XcdBarrier b; b.bar = bar; b.x = xb_xcc_id(); b.st = st;
    if (opaque_tid() == 0) (void)xb_add(&bar[XB_XCNT(b.x)], 1u);
    return b;
}
__device__ __forceinline__ void xcd_barrier_complete(unsigned* bar, unsigned x, unsigned& nloc, unsigned& nx) {
    const unsigned G = gridDim.x * gridDim.y * gridDim.z;
    unsigned sum, cnt, mine, sp = 0u;
    for (;;) {
        sum = 0u; cnt = 0u; mine = 0u;
#pragma unroll
        for (unsigned j = 0; j < 16; ++j) { const unsigned c = xb_ld(&bar[XB_XCNT(j)]); sum += c; cnt += (c > 0u) ? 1u : 0u; mine = (j == x) ? c : mine; }
        if (sum == G) break;
        __builtin_amdgcn_s_sleep(1);
        if ((++sp & 255u) == 0u) { if (xb_ld(&bar[XB_TMO])) break; if (sp > XB_SPIN_CAP) { atomicAdd(&bar[XB_TMO], 1u); break; } }
    }
    nloc = mine > 0u ? mine : 1u; nx = cnt > 0u ? cnt : 1u;
}
__device__ __forceinline__ void xcd_barrier(const XcdBarrier& b) {
    asm volatile("s_waitcnt vmcnt(0)" ::: "memory");
    __syncthreads();
    if (opaque_tid() == 0) {
        unsigned* bar = b.bar;
        __builtin_amdgcn_s_waitcnt(0);
        unsigned nloc = b.st[0], nx = b.st[1];
        if (nloc == 0u) { xcd_barrier_complete(bar, b.x, nloc, nx); b.st[0] = nloc; b.st[1] = nx; }
        const unsigned old = xb_add(&bar[XB_XSUB(b.x)], 1u);
        const unsigned gen = old / nloc;
        if (old + 1u == (gen + 1u) * nloc) {
            __builtin_amdgcn_fence(__ATOMIC_RELEASE, "agent");
            asm volatile("s_waitcnt vmcnt(0)" ::: "memory");
            const unsigned og = xb_add(&bar[XB_TOP], 1u);
            const unsigned tg = og / nx;
            if (og + 1u == (tg + 1u) * nx) xb_add(&bar[XB_TOPGEN], 1u);
            else XB_SPIN(xb_ld(&bar[XB_TOPGEN]) == tg, bar);
            __builtin_amdgcn_fence(__ATOMIC_ACQUIRE, "agent");
            xb_add(&bar[XB_XGEN(b.x)], 1u);
            asm volatile("s_waitcnt vmcnt(0)" ::: "memory");
        } else {
            XB_SPIN(xb_ld(&bar[XB_XGEN(b.x)]) == gen, bar);
            __builtin_amdgcn_fence(__ATOMIC_ACQUIRE, "agent");
            asm volatile("s_waitcnt vmcnt(0)" ::: "memory");
        }
    }
    __syncthreads();
}

namespace pg8 {
constexpr int BM = 256, BK = 64, HALF = 128, HTB = HALF * BK * 2, STAGE_BYTES = 8 * HTB;
__device__ __forceinline__ int lds_byte(int r, int c) { const int st = (r >> 4) * 2 + (c >> 5), rr = r & 15, cc = c & 31, ob = rr * 64 + cc * 2; return st * 1024 + (ob ^ (((ob >> 9) & 1) << 5)); }
__device__ __forceinline__ void stage_rc(int b, int& R, int& C) { const int st = b / 1024, sb = b % 1024, swz = sb ^ (((sb >> 9) & 1) << 5); R = (st >> 1) * 16 + swz / 64; C = (st & 1) * 32 + (swz % 64) / 2; }
__device__ __forceinline__ int perm32(int rho) { const int n = rho >> 4, i = rho & 15; return 8 * (i >> 2) + 4 * n + (i & 3); }

struct GUnit { const char* A; const char* B; int nt; int pm, pn, aux; };

__device__ __forceinline__ void tile_of(int L, int nM, int nN, int& pm, int& pn) {
    const int nwg = nM * nN; int wgid = L;
    { const int q = nwg / 8, r = nwg % 8, xcd = wgid % 8, off = wgid / 8; wgid = (xcd < r ? xcd * (q + 1) : r * (q + 1) + (xcd - r) * q) + off; }
    const int nig = 8 * nN, gid = wgid / nig, fm = gid * 8, gsz = (nM - fm) < 8 ? (nM - fm) : 8;
    pm = fm + ((wgid % nig) % gsz); pn = (wgid % nig) / gsz;
}

typedef int i32x8 __attribute__((ext_vector_type(8)));
__device__ __forceinline__ void glds_saddr(const char* gbase_, unsigned voff, unsigned ldsdst) { unsigned keep;
    const unsigned long long gb_ = (unsigned long long)gbase_; const unsigned long long gbase = ((unsigned long long)(unsigned)__builtin_amdgcn_readfirstlane((int)(gb_ >> 32)) << 32) | (unsigned)__builtin_amdgcn_readfirstlane((int)gb_);
    asm volatile("s_mov_b32 %0, m0\n\ts_mov_b32 m0, %2\n\ts_nop 0\n\tglobal_load_lds_dwordx4 %1, %3\n\ts_mov_b32 m0, %0" : "=&s"(keep) : "v"(voff), "s"(ldsdst), "s"(gbase) : "memory"); }
template <class Epi, class Sched, bool FP8 = false>
__device__ __forceinline__ void gemm_phase(LAS unsigned char* lds, const unsigned lda, const unsigned ldb, const Sched& S, const Epi& E) {
    const int tid = opaque_tid(), wid = __builtin_amdgcn_readfirstlane(tid >> 6), lane = tid & 63, wr = wid >> 2, wc = wid & 3, fr = lane & 15, fq = lane >> 4;
    unsigned voffA[2], voffB[2];
#pragma unroll
    for (int i = 0; i < 2; ++i) { int R, C; stage_rc(tid * 16 + i * 8192, R, C); const int Rb = (R & ~31) + perm32(R & 31);
        voffA[i] = (unsigned)R * lda + (unsigned)C * 2u; voffB[i] = (unsigned)Rb * ldb + (unsigned)C * 2u; }
    const size_t kstep = (size_t)(BK * 2);
    const size_t hstepA = (size_t)HALF * lda, hstepB = (size_t)HALF * ldb;
    const unsigned ldsw = (unsigned)wid * 1024u;
    const int aoff = lds_byte(wr * 64 + fr, fq * 8), boff = lds_byte(wc * 32 + fr, fq * 8);
#define PG8_SA(b, h) (((b) * 2 + (h)) * HTB)
#define PG8_SB(b, h) ((4 + (b) * 2 + (h)) * HTB)
    const unsigned ldsb = (unsigned)(unsigned long)lds + ldsw;
#define PG8_STAGE(bufoff, gbase, voff) do { _Pragma("unroll") for (int _i = 0; _i < 2; ++_i) { \
        if constexpr (FP8) glds_saddr((const char*)(gbase), (voff)[_i], (unsigned)__builtin_amdgcn_readfirstlane((int)(ldsb + (bufoff) + _i * 8192))); \
        else __builtin_amdgcn_global_load_lds((const unsigned*)((const char*)(gbase) + (voff)[_i]), (LAS unsigned*)(lds + (bufoff) + ldsw + _i * 8192), 16, 0, 0); } } while (0)
#define PG8_LDA(dst, b, h) do { _Pragma("unroll") for (int m = 0; m < 4; ++m) _Pragma("unroll") for (int k = 0; k < 2; ++k) dst[m][k] = *(const LAS bf16x8*)(lds + PG8_SA(b, h) + aoff + m * 2048 + k * 1024); } while (0)
#define PG8_LDB(dst, b, h) do { _Pragma("unroll") for (int n = 0; n < 2; ++n) _Pragma("unroll") for (int k = 0; k < 2; ++k) dst[n][k] = *(const LAS bf16x8*)(lds + PG8_SB(b, h) + boff + n * 2048 + k * 1024); } while (0)
#define PG8_CAT(x) (__builtin_bit_cast(i32x8, __builtin_shufflevector((x)[0], (x)[1], 0, 1, 2, 3, 4, 5, 6, 7, 8, 9, 10, 11, 12, 13, 14, 15)))
#define PG8_MMA(ai, bj, At, Bt) do { __builtin_amdgcn_s_setprio(1); _Pragma("unroll") for (int m = 0; m < 4; ++m) _Pragma("unroll") for (int n = 0; n < 2; ++n) { \
        if constexpr (FP8) acc[ai][bj][m][n] = __builtin_amdgcn_mfma_scale_f32_16x16x128_f8f6f4(PG8_CAT(Bt[n]), PG8_CAT(At[m]), acc[ai][bj][m][n], 0, 0, 0, 0x7F7F7F7F, 0, 0x7F7F7F7F); \
        else { _Pragma("unroll") for (int k = 0; k < 2; ++k) acc[ai][bj][m][n] = __builtin_amdgcn_mfma_f32_16x16x32_bf16(Bt[n][k], At[m][k], acc[ai][bj][m][n], 0, 0, 0); } } __builtin_amdgcn_s_setprio(0); } while (0)
#define PG8_WAIT_V(n) asm volatile("s_waitcnt vmcnt(" #n ")" ::: "memory")
#define PG8_WAIT_L(n) asm volatile("s_waitcnt lgkmcnt(" #n ")" ::: "memory")
#define PG8_BAR __builtin_amdgcn_s_barrier()
#define PG8_SCHED __builtin_amdgcn_sched_barrier(0)
    GUnit cur, nxt; int ui = 0;
    if (!S.next(0, cur)) return;
#if USE_AGPR
    { int z_ = 0; asm volatile("" : "+a"(z_)); }
#endif
    f32x4 acc[2][2][4][2];
#pragma unroll
    for (int a = 0; a < 2; ++a)
#pragma unroll
        for (int b = 0; b < 2; ++b)
#pragma unroll
            for (int m = 0; m < 4; ++m)
#pragma unroll
                for (int n = 0; n < 2; ++n) acc[a][b][m][n] = (f32x4){0.f, 0.f, 0.f, 0.f};
    bf16x8 At[4][2], B0[2][2], B1[2][2];
    const char* cA = cur.A; const char* cB = cur.B;
    PG8_STAGE(PG8_SB(0, 0), cB, voffB); PG8_STAGE(PG8_SB(0, 1), cB + hstepB, voffB); PG8_STAGE(PG8_SA(0, 0), cA, voffA); PG8_STAGE(PG8_SA(0, 1), cA + hstepA, voffA);
    if (wr == 1) PG8_BAR;
    PG8_WAIT_V(2); PG8_BAR;
    PG8_STAGE(PG8_SB(1, 0), cB + kstep, voffB); PG8_STAGE(PG8_SA(1, 0), cA + kstep, voffA); PG8_STAGE(PG8_SB(1, 1), cB + hstepB + kstep, voffB);
    PG8_WAIT_V(6); PG8_BAR;
    for (;;) {
        const bool has_next = S.next(ui + 1, nxt);
        const char* nA = has_next ? nxt.A : cA; const char* nB = has_next ? nxt.B : cB;
        const int nt = cur.nt;
        for (int t = 0; t < nt; t += 2) {
            const bool last = (t == nt - 2);
            const char* a1 = cA + (size_t)(t + 1) * kstep;
            const char* a2 = last ? nA : cA + (size_t)(t + 2) * kstep; const char* b2 = last ? nB : cB + (size_t)(t + 2) * kstep;
            const char* a3 = a2 + kstep; const char* b3 = b2 + kstep;
            PG8_LDB(B0, 0, 0); PG8_LDB(B1, 0, 1); PG8_SCHED; PG8_LDA(At, 0, 0); PG8_STAGE(PG8_SA(1, 1), a1 + hstepA, voffA);
            PG8_WAIT_V(8); PG8_WAIT_L(0); PG8_BAR; PG8_MMA(0, 0, At, B0); PG8_MMA(0, 1, At, B1); PG8_BAR; PG8_SCHED;
            PG8_LDA(At, 0, 1); PG8_STAGE(PG8_SB(0, 0), b2, voffB); PG8_STAGE(PG8_SB(0, 1), b2 + hstepB, voffB); PG8_STAGE(PG8_SA(0, 0), a2, voffA);
            PG8_WAIT_V(8); PG8_WAIT_L(0); PG8_BAR; PG8_MMA(1, 0, At, B0); PG8_MMA(1, 1, At, B1); PG8_BAR; PG8_SCHED;
            PG8_LDB(B0, 1, 0); PG8_LDB(B1, 1, 1); PG8_SCHED; PG8_LDA(At, 1, 0); PG8_STAGE(PG8_SA(0, 1), a2 + hstepA, voffA);
            PG8_WAIT_V(8); PG8_WAIT_L(0); PG8_BAR; PG8_MMA(0, 0, At, B0); PG8_MMA(0, 1, At, B1); PG8_BAR; PG8_SCHED;
            PG8_LDA(At, 1, 1); PG8_STAGE(PG8_SB(1, 0), b3, voffB); PG8_STAGE(PG8_SB(1, 1), b3 + hstepB, voffB); PG8_STAGE(PG8_SA(1, 0), a3, voffA);
            PG8_WAIT_V(8); PG8_WAIT_L(0); PG8_BAR; PG8_MMA(1, 0, At, B0); PG8_MMA(1, 1, At, B1); PG8_BAR; PG8_SCHED;
            if constexpr (Epi::HOOK) { if (E.want(t + 2)) { const int l2_ = opaque_tid() & 63; E.mid(acc, cur, t + 2, wr, wc, l2_ & 15, l2_ >> 4); } }
        }
        if (wr == 0) PG8_BAR;
        { const int l2_ = opaque_tid() & 63; E(acc, cur, wr, wc, l2_ & 15, l2_ >> 4); }
        if (!has_next) break;
#pragma unroll
        for (int a = 0; a < 2; ++a)
#pragma unroll
            for (int b = 0; b < 2; ++b)
#pragma unroll
                for (int m = 0; m < 4; ++m)
#pragma unroll
                    for (int n = 0; n < 2; ++n) acc[a][b][m][n] = (f32x4){0.f, 0.f, 0.f, 0.f};
        cur = nxt; cA = nA; cB = nB; ++ui;
        if (wr == 1) PG8_BAR;
    }
    PG8_WAIT_V(0);
    PG8_BAR;
#undef PG8_SA
#undef PG8_SB
#undef PG8_STAGE
#undef PG8_LDA
#undef PG8_LDB
#undef PG8_MMA
#undef PG8_CAT
#undef PG8_WAIT_V
#undef PG8_WAIT_L
#undef PG8_BAR
#undef PG8_SCHED
}

__device__ __forceinline__ const char* sgpr_ptr(const char* p) { const unsigned long long v = (unsigned long long)p; return (const char*)(((unsigned long long)(unsigned)__builtin_amdgcn_readfirstlane((int)(v >> 32)) << 32) | (unsigned)__builtin_amdgcn_readfirstlane((int)v)); }
struct DenseSched {
    const char* A; const char* B; unsigned lda, ldb; int nM, nN, nt, G, c, nExtra, exPm0, exPn;
    __device__ __forceinline__ bool next(int i, GUnit& u) const {
        const long L = (long)i * G + c; const int nwg = nM * nN; if (L >= nwg + nExtra) return false;
        int pm, pn; if (L < nwg) tile_of((int)L, nM, nN, pm, pn); else { pm = exPm0 + (int)(L - nwg); pn = exPn; }
        u.pm = pm; u.pn = pn; u.aux = 0; u.nt = nt; u.A = sgpr_ptr(A + (size_t)pm * 256 * lda); u.B = sgpr_ptr(B + (size_t)pn * 256 * ldb); return true;
    }
};
struct MergeSched {
    const char* A; const char* B; int nM, G, c;
    __device__ __forceinline__ bool next(int i, GUnit& u) const {
        const int tile = i / 3, seg = i - 3 * tile; const long L = (long)tile * G + c; if (L >= nM * 4) return false;
        int pm, pn; tile_of((int)L, nM, 4, pm, pn); const int koff = seg == 0 ? 0 : (seg == 1 ? 256 : 512);
        u.pm = pm; u.pn = pn; u.aux = seg; u.nt = seg == 2 ? 8 : 4; u.A = sgpr_ptr(A + (size_t)pm * 256 * 2048 + koff * 2); u.B = sgpr_ptr(B + (size_t)pn * 256 * 2048 + koff * 2); return true;
    }
};
struct MoeSched {
    const char* A; const char* B; unsigned lda, ldb; size_t estride; int nN, nt, G, c; int P[9];
    __device__ __forceinline__ bool next(int i, GUnit& u) const {
        const int nM = P[8]; const long L = (long)i * G + c; if (L >= (long)nM * nN) return false;
        int pm, pn; tile_of((int)L, nM, nN, pm, pn); int e = 0;
#pragma unroll
        for (int k = 1; k < 8; ++k) e += (pm >= P[k]) ? 1 : 0;
        u.pm = pm; u.pn = pn; u.aux = e; u.nt = nt; u.A = sgpr_ptr(A + (size_t)pm * 256 * lda); u.B = sgpr_ptr(B + (size_t)e * estride + (size_t)pn * 256 * ldb); return true;
    }
};

typedef f32x4 Acc[2][2][4][2];
struct EpiZ {
    static constexpr bool HOOK = false;
    bf16_t *ZC, *ZG, *Q, *K, *V, *G; const float* rope; float scz;
    __device__ __forceinline__ void operator()(const Acc& acc, const GUnit& u, int wr, int wc, int fr, int fq) const {
        const int pn = u.pn, row0 = u.pm * 256 + wr * 64 + fr, c8 = wc * 32 + fq * 8; const bool isx = u.pm < NPX; float sc_ = scz; asm volatile("" : "+s"(sc_));
#pragma unroll
        for (int ai = 0; ai < 2; ++ai)
#pragma unroll
            for (int m = 0; m < 4; ++m) { const int row = row0 + ai * 128 + m * 16;
                f32x4 a0 = acc[ai][0][m][0] * sc_, a1 = acc[ai][0][m][1] * sc_, b0 = acc[ai][1][m][0] * sc_, b1 = acc[ai][1][m][1] * sc_;
                if (pn < 3) { bf16_t* rp = ZC + (size_t)row * 768 + pn * 256 + c8; *(u32x4*)rp = pack8(a0, a1); *(u32x4*)(rp + 128) = pack8(b0, b1);
                } else if (pn < 5) { bf16_t* rp = ZG + (size_t)row * 512 + (pn - 3) * 256 + c8;
#pragma unroll
                    for (int j = 0; j < 4; ++j) { a0[j] = gelu_tanh(a0[j]); a1[j] = gelu_tanh(a1[j]); b0[j] = gelu_tanh(b0[j]); b1[j] = gelu_tanh(b1[j]); }
                    *(u32x4*)rp = pack8(a0, a1); *(u32x4*)(rp + 128) = pack8(b0, b1);
                } else if (pn < 8) {
                    if (pn == 7 && wc >= 2) {
                        bf16_t* vp = V + (size_t)row * 128 + (wc - 2) * 32 + fq * 8; *(u32x4*)vp = pack8(a0, a1); *(u32x4*)(vp + 64) = pack8(b0, b1);
                    } else {
                        if (isx) { const int s = row & (SEQ - 1), p = (fq < 2) ? (s >> 6) : (s & 63); const float* cs = rope + p * 16 + (fq & 1) * 8;
                            const f32x4 c0 = *(const f32x4*)cs, c1 = *(const f32x4*)(cs + 4), s0 = *(const f32x4*)(cs + 1024), s1 = *(const f32x4*)(cs + 1028);
                            const f32x4 oa0 = a0 * c0 - b0 * s0, oa1 = a1 * c1 - b1 * s1, ob0 = b0 * c0 + a0 * s0, ob1 = b1 * c1 + a1 * s1;
                            a0 = oa0; a1 = oa1; b0 = ob0; b1 = ob1; }
                        if (pn < 7) { a0 *= QSCALE; a1 *= QSCALE; b0 *= QSCALE; b1 *= QSCALE;
                            bf16_t* qp = Q + (size_t)row * 512 + ((pn - 5) * 4 + wc) * 64 + fq * 8; *(u32x4*)qp = pack8(a0, a1); *(u32x4*)(qp + 32) = pack8(b0, b1);
                        } else { bf16_t* kp = K + (size_t)row * 128 + wc * 64 + fq * 8; *(u32x4*)kp = pack8(a0, a1); *(u32x4*)(kp + 32) = pack8(b0, b1); }
                    }
                } else { bf16_t* rp = G + (size_t)row * 3072 + (pn - 8) * 256 + c8;
#pragma unroll
                    for (int j = 0; j < 4; ++j) { a0[j] = fast_sigmoid(a0[j]); a1[j] = fast_sigmoid(a1[j]); b0[j] = fast_sigmoid(b0[j]); b1[j] = fast_sigmoid(b1[j]); }
                    *(u32x4*)rp = pack8(a0, a1); *(u32x4*)(rp + 128) = pack8(b0, b1);
                }
                }
    }
};
struct EpiGate8 {
    static constexpr bool HOOK = false;
    bf16_t* G;
    __device__ __forceinline__ void operator()(const Acc& acc, const GUnit& u, int wr, int wc, int fr, int fq) const {
        const int row0 = u.pm * 256 + wr * 64 + fr, col = u.pn * 256 + wc * 32 + fq * 8; float sc = 1.0f / (A8_SCALE * W_GU_SCALE); asm volatile("" : "+s"(sc));
#pragma unroll
        for (int ai = 0; ai < 2; ++ai)
#pragma unroll
            for (int m = 0; m < 4; ++m) { bf16_t* rp = G + (size_t)(row0 + ai * 128 + m * 16) * 3072 + col;
#pragma unroll
                for (int bj = 0; bj < 2; ++bj) { f32x4 a = acc[ai][bj][m][0] * sc, b = acc[ai][bj][m][1] * sc;
#pragma unroll
                    for (int j = 0; j < 4; ++j) { a[j] = fast_sigmoid(a[j]); b[j] = fast_sigmoid(b[j]); }
                    *(u32x4*)(rp + bj * 128) = pack8(a, b); } }
    }
};
struct EpiMerge {
    static constexpr bool HOOK = false;
    const bf16_t* G; bf16_t* MIX;
    __device__ __forceinline__ void operator()(const Acc& acc, const GUnit& u, int wr, int wc, int fr, int fq) const {
        const int seg = u.aux, row0 = u.pm * 256 + wr * 64 + fr, col = u.pn * 256 + wc * 32 + fq * 8;
#pragma unroll
        for (int ai = 0; ai < 2; ++ai)
#pragma unroll
            for (int m = 0; m < 4; ++m) { const size_t row = (size_t)(row0 + ai * 128 + m * 16);
#pragma unroll
                for (int bj = 0; bj < 2; ++bj) { f32x4 g0, g1; unpack8(*(const u32x4*)(G + row * 3072 + seg * 1024 + col + bj * 128), g0, g1);
                    f32x4 v0 = g0 * acc[ai][bj][m][0], v1 = g1 * acc[ai][bj][m][1]; bf16_t* mp = MIX + row * 1024 + col + bj * 128;
                    if (seg) { f32x4 o0, o1; unpack8(*(const u32x4*)mp, o0, o1); v0 += o0; v1 += o1; }
                    *(u32x4*)mp = pack8(v0, v1); } }
    }
};
struct EpiMergeH {
    static constexpr bool HOOK = true;
    const bf16_t* G; bf16_t* MIX;
    __device__ __forceinline__ bool want(int kdone) const { return kdone == 4 || kdone == 8; }
    __device__ __forceinline__ void mid(Acc& acc, const GUnit& u, int kdone, int wr, int wc, int fr, int fq) const {
        const int seg = kdone == 4 ? 0 : 1, row0 = u.pm * 256 + wr * 64 + fr, col = u.pn * 256 + wc * 32 + fq * 8;
#pragma unroll
        for (int ai = 0; ai < 2; ++ai)
#pragma unroll
            for (int m = 0; m < 4; ++m) { const bf16_t* gp = G + (size_t)(row0 + ai * 128 + m * 16) * 3072 + seg * 1024 + col;
#pragma unroll
                for (int bj = 0; bj < 2; ++bj) { f32x4 p0, p1, n0, n1; unpack8(*(const u32x4*)(gp + bj * 128), p0, p1); unpack8(*(const u32x4*)(gp + 1024 + bj * 128), n0, n1);
#pragma unroll
                    for (int j = 0; j < 4; ++j) { acc[ai][bj][m][0][j] *= __builtin_fmaxf(p0[j], 1e-30f) * __builtin_amdgcn_rcpf(__builtin_fmaxf(n0[j], 1e-30f)); acc[ai][bj][m][1][j] *= __builtin_fmaxf(p1[j], 1e-30f) * __builtin_amdgcn_rcpf(__builtin_fmaxf(n1[j], 1e-30f)); } }
                asm volatile("" ::: "memory"); }
    }
    __device__ __forceinline__ void operator()(const Acc& acc, const GUnit& u, int wr, int wc, int fr, int fq) const {
        const int row0 = u.pm * 256 + wr * 64 + fr, col = u.pn * 256 + wc * 32 + fq * 8;
#pragma unroll
        for (int ai = 0; ai < 2; ++ai)
#pragma unroll
            for (int m = 0; m < 4; ++m) { const size_t row = (size_t)(row0 + ai * 128 + m * 16);
#pragma unroll
                for (int bj = 0; bj < 2; ++bj) { f32x4 g0, g1; unpack8(*(const u32x4*)(G + row * 3072 + 2048 + col + bj * 128), g0, g1);
#pragma unroll
                    for (int j = 0; j < 4; ++j) { g0[j] = __builtin_fmaxf(g0[j], 1e-30f); g1[j] = __builtin_fmaxf(g1[j], 1e-30f); }
                    *(u32x4*)(MIX + row * 1024 + col + bj * 128) = pack8(g0 * acc[ai][bj][m][0], g1 * acc[ai][bj][m][1]); }
                asm volatile("" ::: "memory"); }
    }
};
struct Merge12Sched {
    const char* A; const char* B; int nM, G, c;
    __device__ __forceinline__ bool next(int i, GUnit& u) const {
        const long L = (long)i * G + c; if (L >= (long)nM * 12) return false;
        int pm, pn; tile_of((int)L, nM, 12, pm, pn); const int j = pn >> 2, koff = j == 0 ? 0 : (j == 1 ? 256 : 512);
        u.pm = pm; u.pn = pn; u.aux = j; u.nt = j == 2 ? 8 : 4; u.A = sgpr_ptr(A + (size_t)pm * 256 * 2048 + koff * 2); u.B = sgpr_ptr(B + (size_t)(pn & 3) * 256 * 2048 + koff * 2); return true;
    }
};
struct EpiMerge8 {
    static constexpr bool HOOK = false;
    const bf16_t* G; unsigned char* GP;
    __device__ __forceinline__ void operator()(const Acc& acc, const GUnit& u, int wr, int wc, int fr, int fq) const {
        const int row0 = u.pm * 256 + wr * 64 + fr, col = u.pn * 256 + wc * 32 + fq * 8; float sc = GP8_SCALE; asm volatile("" : "+s"(sc));
#pragma unroll
        for (int ai = 0; ai < 2; ++ai)
#pragma unroll
            for (int m = 0; m < 4; ++m) { const unsigned row = (unsigned)(row0 + ai * 128 + m * 16);
#pragma unroll
                for (int bj = 0; bj < 2; ++bj) { f32x4 g0, g1; unpack8(*(const u32x4*)(G + (size_t)row * 3072 + col + bj * 128), g0, g1);
                    const f32x4 v0 = g0 * acc[ai][bj][m][0] * sc, v1 = g1 * acc[ai][bj][m][1] * sc;
                    u32x2 o; o.x = pk4_fp8(v0[0], v0[1], v0[2], v0[3]); o.y = pk4_fp8(v1[0], v1[1], v1[2], v1[3]);
                    *(u32x2*)(GP + row * 3072u + (unsigned)(col + bj * 128)) = o; } }
    }
};
struct EpiResid {
    static constexpr bool HOOK = false;
    const float* xin_x; const float* xin_c; float* xout_x; float* xout_c; const float* gate; float sc;
    __device__ __forceinline__ void operator()(const Acc& acc, const GUnit& u, int wr, int wc, int fr, int fq) const {
        const bool isx = u.pm < NPX; const int b = isx ? (u.pm >> 4) : 16;
        const float* xi = isx ? xin_x + (size_t)u.pm * 256 * D : xin_c + (size_t)(u.pm - NPX) * 256 * D;
        float* xo = isx ? xout_x + (size_t)u.pm * 256 * D : xout_c + (size_t)(u.pm - NPX) * 256 * D;
        const int col = u.pn * 256 + wc * 32 + fq * 8; const float* gp = gate + (size_t)b * 6 * D + col;
        f32x4 gv[2][2];
#pragma unroll
        for (int bj = 0; bj < 2; ++bj) { gv[bj][0] = *(const f32x4*)(gp + bj * 128) * sc; gv[bj][1] = *(const f32x4*)(gp + bj * 128 + 4) * sc; }
#pragma unroll
        for (int ai = 0; ai < 2; ++ai)
#pragma unroll
            for (int m = 0; m < 4; ++m) { const size_t off = (size_t)(wr * 64 + fr + ai * 128 + m * 16) * D + col;
#pragma unroll
                for (int bj = 0; bj < 2; ++bj) { const f32x4 x0 = *(const f32x4*)(xi + off + bj * 128), x1 = *(const f32x4*)(xi + off + bj * 128 + 4);
                    *(f32x4*)(xo + off + bj * 128) = x0 + gv[bj][0] * acc[ai][bj][m][0]; *(f32x4*)(xo + off + bj * 128 + 4) = x1 + gv[bj][1] * acc[ai][bj][m][1]; } }
    }
};
struct EpiGU {
    static constexpr bool HOOK = false;
    bf16_t* H; int ldh;
    __device__ __forceinline__ void operator()(const Acc& acc, const GUnit& u, int wr, int wc, int fr, int fq) const {
        const int row0 = u.pm * 256 + wr * 64 + fr, col = u.pn * 128 + wc * 32 + fq * 8;
#pragma unroll
        for (int ai = 0; ai < 2; ++ai)
#pragma unroll
            for (int m = 0; m < 4; ++m) { f32x4 a = acc[ai][0][m][0], b = acc[ai][0][m][1]; const f32x4 c = acc[ai][1][m][0], d = acc[ai][1][m][1];
#pragma unroll
                for (int j = 0; j < 4; ++j) { a[j] = fast_silu(a[j]) * c[j]; b[j] = fast_silu(b[j]) * d[j]; }
                *(u32x4*)(H + (size_t)(row0 + ai * 128 + m * 16) * ldh + col) = pack8(a, b); }
    }
};
struct EpiGU8 {
    static constexpr bool HOOK = false;
    unsigned char* H; int ldh;
    __device__ __forceinline__ void operator()(const Acc& acc, const GUnit& u, int wr, int wc, int fr, int fq) const {
        const int row0 = u.pm * 256 + wr * 64 + fr, col = u.pn * 128 + wc * 32 + fq * 8; float sc = 1.0f / (A8_SCALE * W_GU_SCALE), sch = H8_SCALE / (A8_SCALE * W_GU_SCALE);
        asm volatile("" : "+s"(sc), "+s"(sch));
#pragma unroll
        for (int ai = 0; ai < 2; ++ai)
#pragma unroll
            for (int m = 0; m < 4; ++m) { f32x4 a = acc[ai][0][m][0] * sc, b = acc[ai][0][m][1] * sc; const f32x4 c = acc[ai][1][m][0] * sch, d = acc[ai][1][m][1] * sch;
#pragma unroll
                for (int j = 0; j < 4; ++j) { a[j] = fast_silu(a[j]) * c[j]; b[j] = fast_silu(b[j]) * d[j]; }
                u32x2 o; o.x = pk4_fp8(a[0], a[1], a[2], a[3]); o.y = pk4_fp8(b[0], b[1], b[2], b[3]);
                const unsigned off = (unsigned)(row0 + ai * 128 + m * 16) * (unsigned)ldh + (unsigned)col;
                *(u32x2*)(H + off) = o; }
    }
};
struct EpiMoeDown {
    static constexpr bool HOOK = false;
    const int* rinfo; bf16_t* Y; float sc;
    __device__ __forceinline__ void operator()(const Acc& acc, const GUnit& u, int wr, int wc, int fr, int fq) const {
        const int row0 = u.pm * 256 + wr * 64 + fr, col = u.pn * 256 + wc * 32 + fq * 8;
#pragma unroll
        for (int ai = 0; ai < 2; ++ai)
#pragma unroll
            for (int m = 0; m < 4; ++m) { const int info = rinfo[row0 + ai * 128 + m * 16];
                if (info >= 0) { const unsigned t = (unsigned)info & 0xfffffu, k = ((unsigned)info >> 20) & 1u; const unsigned off = ((k * (unsigned)T + t) * (unsigned)D + (unsigned)col) * 2u;
#pragma unroll
                    for (int bj = 0; bj < 2; ++bj) *(u32x4*)((unsigned char*)Y + off + bj * 256) = pack8(acc[ai][bj][m][0] * sc, acc[ai][bj][m][1] * sc); } }
    }
};
}

namespace attn_body {
using bf16=__hip_bfloat16;
using s16x4=__attribute__((ext_vector_type(4)))short;
constexpr int D64=64,NW=8,QBLK=32,KVBLK=64;
constexpr int QP=512,KP=128,OP=1024;
__device__ __forceinline__ int crow(int r,int hi){return (r&3)+8*(r>>2)+4*hi;}
#define SBAR() __builtin_amdgcn_sched_barrier(0)
__device__ __forceinline__ void wmask(f32x16&p0,f32x16&p1,int base,int hi){
  const float NEG=-INFINITY; const int kb=base+4*hi;
  #pragma unroll
  for(int r=0;r<16;++r){const int d=kb+(r&3)+8*(r>>2); if(d>128||d<-128)p0[r]=NEG; if(d+32>128||d+32<-128)p1[r]=NEG;}
}
constexpr int NSLOT=3, SLOTB=8192;
constexpr int LDS_K=0, LDS_V=NSLOT*SLOTB, LDS_WS=2*NSLOT*SLOTB, LDS_OST=LDS_WS+NW*64*4, LDS_BYTES=LDS_OST+NW*4096;
__device__ __forceinline__ void glds16(const void*gsrc,unsigned lds_dst){unsigned keep;
  asm volatile("s_mov_b32 %0, m0\n\ts_mov_b32 m0, %2\n\ts_nop 0\n\tglobal_load_lds_dwordx4 %1, off\n\ts_mov_b32 m0, %0":"=&s"(keep):"v"(gsrc),"s"(lds_dst):"memory");}
__device__ __forceinline__ float max3f(float a,float b,float c){float r;asm("v_max3_f32 %0, %1, %2, %3":"=v"(r):"v"(a),"v"(b),"v"(c));return r;}
__device__ __forceinline__ float max2f(float a,float b){float r;asm("v_max_f32_e32 %0, %1, %2":"=v"(r):"v"(a),"v"(b));return r;}
__device__ __forceinline__ float fadd_s(float a,float b){float r;asm("v_add_f32_e32 %0, %1, %2":"=v"(r):"v"(a),"v"(b));return r;}
__device__ __forceinline__ float fsub_s(float a,float b){float r;asm("v_sub_f32_e32 %0, %1, %2":"=v"(r):"v"(a),"v"(b));return r;}
typedef float f32x2_t __attribute__((ext_vector_type(2))); typedef __bf16 bf16x2_t __attribute__((ext_vector_type(2)));
__device__ __forceinline__ unsigned cvtpk_s(float lo,float hi){f32x2_t v={lo,hi};bf16x2_t b=__builtin_convertvector(v,bf16x2_t);return __builtin_bit_cast(unsigned,b);}
#define WAIT_BAR(N) asm volatile("s_waitcnt vmcnt(" #N ") lgkmcnt(0)\n\ts_barrier":::"memory")
__device__ __forceinline__ void qkt(f32x16&p0,f32x16&p1,const char*Kslot,const bf16x8*qr,const f32x16&negm,int r32,int hi){
  const char*kb=Kslot+hi*1024+r32*16;
  #pragma unroll
  for(int d0=0;d0<4;++d0){
    const bf16x8 b0=*reinterpret_cast<const bf16x8*>(kb+d0*2048);
    const bf16x8 b1=*reinterpret_cast<const bf16x8*>(kb+d0*2048+512);
    if(d0==0){p0=__builtin_amdgcn_mfma_f32_32x32x16_bf16(b0,qr[0],negm,0,0,0);p1=__builtin_amdgcn_mfma_f32_32x32x16_bf16(b1,qr[0],negm,0,0,0);}
    else{p0=__builtin_amdgcn_mfma_f32_32x32x16_bf16(b0,qr[d0],p0,0,0,0);p1=__builtin_amdgcn_mfma_f32_32x32x16_bf16(b1,qr[d0],p1,0,0,0);}}
}
typedef __attribute__((address_space(3))) const char* lds_cptr;
typedef short v4i16_t __attribute__((ext_vector_type(4)));
__device__ __forceinline__ void kload8(bf16x8*kf,lds_cptr kp){
  kf[0]=*(const __attribute__((address_space(3))) bf16x8*)(kp);      kf[1]=*(const __attribute__((address_space(3))) bf16x8*)(kp+512);
  kf[2]=*(const __attribute__((address_space(3))) bf16x8*)(kp+2048); kf[3]=*(const __attribute__((address_space(3))) bf16x8*)(kp+2560);
  kf[4]=*(const __attribute__((address_space(3))) bf16x8*)(kp+4096); kf[5]=*(const __attribute__((address_space(3))) bf16x8*)(kp+4608);
  kf[6]=*(const __attribute__((address_space(3))) bf16x8*)(kp+6144); kf[7]=*(const __attribute__((address_space(3))) bf16x8*)(kp+6656);
}
__device__ __forceinline__ void kload2(bf16x8*kf,lds_cptr kp,int j){ kf[2*j]=*(const __attribute__((address_space(3))) bf16x8*)(kp+j*2048); kf[2*j+1]=*(const __attribute__((address_space(3))) bf16x8*)(kp+j*2048+512); }
__device__ __forceinline__ s16x4 vtr(lds_cptr p){ return __builtin_bit_cast(s16x4,__builtin_amdgcn_ds_read_tr16_b64_v4i16((__attribute__((address_space(3))) v4i16_t*)p)); }
__device__ __forceinline__ float rowmax(const f32x16&p0,const f32x16&p1){
  float a=max3f(p0[0],p0[1],p1[0]),b=max3f(p0[2],p0[3],p1[1]);a=max3f(a,p1[2],p1[3]);
  #pragma unroll
  for(int r=4;r<16;r+=4){a=max3f(a,p0[r],p0[r+1]);b=max3f(b,p0[r+2],p0[r+3]);a=max3f(a,p1[r],p1[r+1]);b=max3f(b,p1[r+2],p1[r+3]);}
  const float m=max2f(a,b);
  auto rr=__builtin_amdgcn_permlane32_swap(__float_as_uint(m),__float_as_uint(m),false,false);
  return max2f(__uint_as_float(rr[0]),__uint_as_float(rr[1]));
}
__device__ __forceinline__ void pv(f32x16*o,int vb,bf16x8 pa0,bf16x8 pa1,bf16x8 pa2,bf16x8 pa3){
  #pragma unroll
  for(int d0=0;d0<2;++d0){s16x4 lo[4],hi[4];
    #pragma unroll
    for(int ks=0;ks<4;++ks){
      asm volatile("ds_read_b64_tr_b16 %0,%1 offset:%c2":"=&v"(lo[ks]):"v"(vb),"i"(d0*4096+ks*1024):"memory");
      asm volatile("ds_read_b64_tr_b16 %0,%1 offset:%c2":"=&v"(hi[ks]):"v"(vb),"i"(d0*4096+ks*1024+512):"memory");}
    asm volatile("s_waitcnt lgkmcnt(0)":::"memory");SBAR();
    #define PK(k) (bf16x8){lo[k][0],lo[k][1],lo[k][2],lo[k][3],hi[k][0],hi[k][1],hi[k][2],hi[k][3]}
    o[d0]=__builtin_amdgcn_mfma_f32_32x32x16_bf16(pa0,PK(0),o[d0],0,0,0);
    o[d0]=__builtin_amdgcn_mfma_f32_32x32x16_bf16(pa1,PK(1),o[d0],0,0,0);
    o[d0]=__builtin_amdgcn_mfma_f32_32x32x16_bf16(pa2,PK(2),o[d0],0,0,0);
    o[d0]=__builtin_amdgcn_mfma_f32_32x32x16_bf16(pa3,PK(3),o[d0],0,0,0);
    #undef PK
  }
}
template<int THRL> __device__ __forceinline__ void attn_unit(const bf16*Qw,const bf16*__restrict__ Kc,const bf16*__restrict__ Vc,bf16*Ow,int crow0,int lrow0,int NT,int qoff0,float sink_l2,char*shm){
  const int tid=opaque_tid(),lane=tid&63,r32=lane&31,hi=lane>>5; const int wid=__builtin_amdgcn_readfirstlane(tid>>6);
  const unsigned lds0=(unsigned)(uintptr_t)shm;
  float*wsf=(float*)(shm+LDS_WS)+wid*64;
  const bf16*ksrc=Kc+(long)lane*KP+wid*8;
  const bf16*vsrc=Vc+(long)(16*(wid&3)+(lane>>2))*KP+(wid>>2)*32+(lane&3)*8;
  const unsigned kdst=lds0+LDS_K+wid*1024, vdst=lds0+LDS_V+wid*1024;
  #define TROW(t) ((long)(((t)<4)?(crow0+64*(t)):(lrow0+64*((t)-4)))*KP)
  #define DMA_K(t,slot) glds16(ksrc+TROW(t),(unsigned)__builtin_amdgcn_readfirstlane(kdst+(slot)))
  #define DMA_V(t,slot) glds16(vsrc+TROW(t),(unsigned)__builtin_amdgcn_readfirstlane(vdst+(slot)))
  const int vb0=(int)(lds0+LDS_V)+((lane>>4)&1)*32+(lane&3)*8+(4*hi+((lane&15)>>2))*64;
  const char*Kbase=shm+LDS_K; bf16x8 kf[8];
  const lds_cptr shm3=(lds_cptr)shm; const lds_cptr kp0=shm3+LDS_K+hi*1024+r32*16; const lds_cptr vp0=shm3+LDS_V+((lane>>4)&1)*32+(lane&3)*8+(4*hi+((lane&15)>>2))*64;
  DMA_K(0,0);DMA_V(0,0);DMA_K(1,SLOTB);
  bf16x8 qr[4];
  #pragma unroll
  for(int d0=0;d0<4;++d0)qr[d0]=*reinterpret_cast<const bf16x8*>(&Qw[(long)r32*QP+d0*16+hi*8]);
  float mhat=0.f,l_reg=0.f;f32x16 o[2];o[0]=f32x16{};o[1]=f32x16{};const f32x16 negm=f32x16{};
  const int qoff=qoff0+r32;
  #define CMASK(P0,P1,t) do{ if((t)>=4){ const int kb_=64*((t)-4); if(kb_-(qoff0+31)<-128||kb_+63-qoff0>128) wmask(P0,P1,kb_-qoff,hi);} }while(0)
  bool resc=false;
  #define START(P0,P1) do{ const float rm=rowmax(P0,P1); resc=false; mhat=rm; \
    _Pragma("unroll") for(int r=0;r<16;++r){P0[r]=fsub_s(P0[r],mhat);P1[r]=fsub_s(P1[r],mhat);} \
    _Pragma("unroll") for(int r=0;r<16;++r)P0[r]=__builtin_amdgcn_exp2f(P0[r]); }while(0)
  #define RESC() do{ if(resc){ asm volatile("s_waitcnt lgkmcnt(0)":::"memory"); \
      _Pragma("unroll") for(int d_=0;d_<2;++d_) _Pragma("unroll") for(int r=0;r<16;++r)o[d_][r]*=wsf[crow(r,hi)]; } }while(0)
  f32x16 pA0,pA1,pB0,pB1;
  int sl_prev=0,sl_cur=0,sl_next=SLOTB;
  #define ROT() do{sl_prev=sl_cur;sl_cur=sl_next;sl_next=(sl_next==(NSLOT-1)*SLOTB)?0:sl_next+SLOTB;}while(0)
  DMA_K(2,2*SLOTB);
  WAIT_BAR(3);
  qkt(pA0,pA1,Kbase,qr,negm,r32,hi);asm volatile("s_nop 15\n\ts_nop 7":"+v"(pA0),"+v"(pA1));
  START(pA0,pA1);
  _Pragma("unroll") for(int r=0;r<16;++r)pA1[r]=__builtin_amdgcn_exp2f(pA1[r]);
  WAIT_BAR(0);
  DMA_K(3,0);DMA_V(1,SLOTB);
  ROT();
  kload8(kf,kp0+sl_cur);
  WAIT_BAR(2);
  s16x4 vlo[8],vhi[8]; u32x4 pw0,pw1,pw2,pw3;
  #define PKW(P,B) cvtpk_s(P[B],P[B+1])
  #define PAF(k) __builtin_bit_cast(bf16x8,pw##k)
  #define VFR(i) (bf16x8){vlo[i][0],vlo[i][1],vlo[i][2],vlo[i][3],vhi[i][0],vhi[i][1],vhi[i][2],vhi[i][3]}
  #define PIN(x) asm volatile("":"+v"(x))
  #define MX3(a,b,c) __builtin_fmaxf(__builtin_fmaxf((a),(b)),(c))
  #define GAPA(MF,A0,A1,A2,A3,W0,W1,PW) do{ MF; sacc+=A0; sacc+=A1; sacc+=A2; sacc+=A3; PIN(sacc); W0; W1; PIN(PW); SBAR(); }while(0)
  #define EX(v) __builtin_amdgcn_exp2f(v)
  #define GAPB(MF,X,B) do{ MF; X[B]=EX(X[B]-mhat); X[B+1]=EX(X[B+1]-mhat); X[B+2]=EX(X[B+2]-mhat); X[B+3]=EX(X[B+3]-mhat); PIN(X); SBAR(); }while(0)
  #define VRD(i) do{ vlo[i]=vtr(vp_+(((i)>>2)*4096+((i)&3)*1024)); vhi[i]=vtr(vp_+(((i)>>2)*4096+((i)&3)*1024+512)); }while(0)
  #define KRD(G,j) do{ if(G){ kload2(kf,kp0+sl_next,j); SBAR(); } }while(0)
  #define STEP(C0,C1,P0,P1,t,GK,GV,GL) do{ SBAR(); \
    const lds_cptr vp_=vp0+sl_prev; \
    VRD(0); SBAR(); float sacc=(P0[0]+P0[1]); \
    GAPA(C0=__builtin_amdgcn_mfma_f32_32x32x16_bf16(kf[0],qr[0],negm,0,0,0), P0[2],P0[3],P0[4],P0[5],     pw0[0]=PKW(P0,0), pw0[1]=PKW(P0,2), pw0); \
    VRD(4); SBAR(); GAPA(C1=__builtin_amdgcn_mfma_f32_32x32x16_bf16(kf[1],qr[0],negm,0,0,0), P0[6],P0[7],P0[8],P0[9],     pw0[2]=PKW(P0,4), pw0[3]=PKW(P0,6), pw0); \
    VRD(1); SBAR(); GAPA(C0=__builtin_amdgcn_mfma_f32_32x32x16_bf16(kf[2],qr[1],C0,0,0,0),   P0[10],P0[11],P0[12],P0[13], pw1[0]=PKW(P0,8), pw1[1]=PKW(P0,10), pw1); \
    VRD(5); SBAR(); GAPA(C1=__builtin_amdgcn_mfma_f32_32x32x16_bf16(kf[3],qr[1],C1,0,0,0),   P0[14],P0[15],P1[0],P1[1],   pw1[2]=PKW(P0,12),pw1[3]=PKW(P0,14), pw1); \
    VRD(2); SBAR(); GAPA(C0=__builtin_amdgcn_mfma_f32_32x32x16_bf16(kf[4],qr[2],C0,0,0,0),   P1[2],P1[3],P1[4],P1[5],     pw2[0]=PKW(P1,0), pw2[1]=PKW(P1,2), pw2); \
    VRD(6); SBAR(); GAPA(C1=__builtin_amdgcn_mfma_f32_32x32x16_bf16(kf[5],qr[2],C1,0,0,0),   P1[6],P1[7],P1[8],P1[9],     pw2[2]=PKW(P1,4), pw2[3]=PKW(P1,6), pw2); \
    VRD(3); SBAR(); GAPA(C0=__builtin_amdgcn_mfma_f32_32x32x16_bf16(kf[6],qr[3],C0,0,0,0),   P1[10],P1[11],P1[12],P1[13], pw3[0]=PKW(P1,8), pw3[1]=PKW(P1,10), pw3); \
    VRD(7); SBAR(); GAPA(C1=__builtin_amdgcn_mfma_f32_32x32x16_bf16(kf[7],qr[3],C1,0,0,0),   P1[14],P1[15],0.f,0.f,       pw3[2]=PKW(P1,12),pw3[3]=PKW(P1,14), pw3); \
    l_reg+=sacc; \
    if(GK){DMA_K((t)+3,sl_cur);} if(GV){DMA_V((t)+1,sl_next);} \
    CMASK(C0,C1,t); \
    { float a=MX3(C0[0],C0[1],C1[0]),b=MX3(C0[2],C0[3],C1[1]); a=MX3(a,C1[2],C1[3]); \
      _Pragma("unroll") for(int r=4;r<16;r+=4){a=MX3(a,C0[r],C0[r+1]);b=MX3(b,C0[r+2],C0[r+3]);a=MX3(a,C1[r],C1[r+1]);b=MX3(b,C1[r+2],C1[r+3]);} \
      float rm=__builtin_fmaxf(a,b); { auto rr=__builtin_amdgcn_permlane32_swap(__float_as_uint(rm),__float_as_uint(rm),false,false); rm=__builtin_fmaxf(__uint_as_float(rr[0]),__uint_as_float(rr[1])); } \
      resc=false; \
      rm-=mhat; \
      if(__builtin_expect(__any(rm>(float)THRL),0)){ const float dl=__builtin_fmaxf(rm,0.f); mhat+=dl; \
        const float f=__builtin_amdgcn_exp2f(-dl); l_reg*=f; if(hi==0)wsf[r32]=f; resc=true; } } \
    SBAR(); \
    GAPB(o[0]=__builtin_amdgcn_mfma_f32_32x32x16_bf16(PAF(0),VFR(0),o[0],0,0,0), C0,0); \
    GAPB(o[1]=__builtin_amdgcn_mfma_f32_32x32x16_bf16(PAF(0),VFR(4),o[1],0,0,0), C0,4); \
    KRD(GL,0); GAPB(o[0]=__builtin_amdgcn_mfma_f32_32x32x16_bf16(PAF(1),VFR(1),o[0],0,0,0), C0,8); \
    KRD(GL,1); GAPB(o[1]=__builtin_amdgcn_mfma_f32_32x32x16_bf16(PAF(1),VFR(5),o[1],0,0,0), C0,12); \
    KRD(GL,2); GAPB(o[0]=__builtin_amdgcn_mfma_f32_32x32x16_bf16(PAF(2),VFR(2),o[0],0,0,0), C1,0); \
    KRD(GL,3); GAPB(o[1]=__builtin_amdgcn_mfma_f32_32x32x16_bf16(PAF(2),VFR(6),o[1],0,0,0), C1,4); \
    GAPB(o[0]=__builtin_amdgcn_mfma_f32_32x32x16_bf16(PAF(3),VFR(3),o[0],0,0,0), C1,8); \
    GAPB(o[1]=__builtin_amdgcn_mfma_f32_32x32x16_bf16(PAF(3),VFR(7),o[1],0,0,0), C1,12); \
    }while(0)
  int t=1;
  #define ENDW(tt) do{ if((tt)+3<NT){WAIT_BAR(2);} else if((tt)+2<NT){WAIT_BAR(1);} else {WAIT_BAR(0);} }while(0)
  for(;t+1<NT;t+=2){
    STEP(pB0,pB1,pA0,pA1,t,(t+3<NT),(t+1<NT),(t+1<NT));       ENDW(t);   RESC(); ROT();
    STEP(pA0,pA1,pB0,pB1,t+1,(t+4<NT),(t+2<NT),(t+2<NT));     ENDW(t+1); RESC(); ROT();
  }
  STEP(pB0,pB1,pA0,pA1,NT-1,false,false,false); RESC();
  { float sacc=pB0[0]+pB0[1]; _Pragma("unroll") for(int r=2;r<16;++r)sacc+=pB0[r]; _Pragma("unroll") for(int r=0;r<16;++r)sacc+=pB1[r]; l_reg+=sacc;
    pw0=(u32x4){PKW(pB0,0),PKW(pB0,2),PKW(pB0,4),PKW(pB0,6)};pw1=(u32x4){PKW(pB0,8),PKW(pB0,10),PKW(pB0,12),PKW(pB0,14)};pw2=(u32x4){PKW(pB1,0),PKW(pB1,2),PKW(pB1,4),PKW(pB1,6)};pw3=(u32x4){PKW(pB1,8),PKW(pB1,10),PKW(pB1,12),PKW(pB1,14)};
    SBAR(); pv(o,vb0+sl_cur,PAF(0),PAF(1),PAF(2),PAF(3)); }
  #undef PKW
  #undef PAF
  #undef VFR
  #undef PIN
  #undef MX3
  #undef GAPA
  #undef GAPB
  #undef EX
  #undef VRD
  #undef KRD
  #undef STEP
  #undef ENDW
  {auto rr=__builtin_amdgcn_permlane32_swap(__float_as_uint(l_reg),__float_as_uint(l_reg),false,false);l_reg=__uint_as_float(rr[0])+__uint_as_float(rr[1]);}
  l_reg+=__builtin_amdgcn_exp2f(sink_l2-mhat);
  if(hi==0)wsf[32+r32]=l_reg;asm volatile("s_waitcnt lgkmcnt(0)":::"memory");
  float rli[16];
  #pragma unroll
  for(int r=0;r<16;++r)rli[r]=__builtin_amdgcn_rcpf(wsf[32+crow(r,hi)]);
  { bf16*stg=(bf16*)(shm+LDS_OST)+wid*2048;
    #pragma unroll
    for(int r=0;r<16;++r){const int orow=crow(r,hi);
      #pragma unroll
      for(int d0=0;d0<2;++d0)stg[orow*64+d0*32+r32]=__float2bfloat16(o[d0][r]*rli[r]);}
    asm volatile("s_waitcnt lgkmcnt(0)":::"memory");
    #pragma unroll
    for(int i=0;i<4;++i){const int row=i*8+(lane>>3),ch=lane&7; const u32x4 v=*(const u32x4*)(stg+row*64+ch*8); *(u32x4*)(Ow+(long)row*OP+ch*8)=v;} }
  asm volatile("s_waitcnt lgkmcnt(0)\n\ts_barrier":::"memory");
  #undef TROW
  #undef DMA_K
  #undef DMA_V
  #undef CMASK
  #undef START
  #undef RESC
  #undef ROT
}
#undef SBAR
#undef WAIT_BAR
}

constexpr int NWAVES = 8, NTHREADS = 512;
constexpr int RING_BYTES = 131072;
constexpr int MISC_OFF = RING_BYTES;
constexpr int LDS_BYTES = 147456;
constexpr int CW_BAR = 4096;

struct Args { GAS const float* in[23]; GAS float* out; GAS unsigned char* ws; int ph_lo, ph_hi; };
enum { I_X = 0, I_C, I_CTX, I_CCTX, I_WMOD, I_BMOD, I_N1G, I_N2G, I_WIN, I_CONVW, I_GWS, I_GB, I_SINK, I_WBC, I_WBG, I_WBA, I_WOUT, I_FGU, I_FD, I_ROUTER, I_MGU, I_MD, I_FNG };

struct Ctx {
    LAS unsigned char* lds; int tid, lane, wave, G, wg;
    const Args __attribute__((address_space(4)))* a; GAS unsigned char* ws;
};

__device__ __forceinline__ int zmap(int n) {
    const int pn = n >> 8;
    if (pn < 5 || pn > 7) return n;
    const int half = (n >> 7) & 1, hc = n & 127, idx = hc & 31, d = (idx < 16 ? idx : idx + 16) + 16 * half;
    if (pn < 7) return 1280 + (((pn - 5) * 4 + (hc >> 5)) * 64) + d;
    if (hc < 64) return 1792 + (hc >> 5) * 64 + d;
    return 1920 + half * 64 + (hc - 64);
}
__device__ __forceinline__ int gumap(int n, int ff) { const int p = n >> 8, half = (n >> 7) & 1, hc = n & 127; return half * ff + p * 128 + hc; }
template <int MAP> __device__ __forceinline__ void transpose_item(const float* W, int Nsrc, int Ndst, bf16_t* WT, int ldwt, int koff, int ff, LAS float* scr, int item, int lane) {
    const int nblk = Ndst / 32, kb = item / nblk, nb = item % nblk, k0 = 64 * kb, n0 = 32 * nb;
    const int nd = n0 + (lane & 31); const int sc = MAP == 0 ? nd : (MAP == 1 ? zmap(nd) : gumap(nd, ff));
#pragma unroll 8
    for (int i = 0; i < 32; ++i) { const int kk = 2 * i + (lane >> 5); scr[kk * 33 + (lane & 31)] = W[(size_t)(k0 + kk) * Nsrc + sc]; }
    LDS_WAIT(); asm volatile("" ::: "memory");
    const int c = lane & 7;
#pragma unroll
    for (int j = 0; j < 4; ++j) { const int n = (lane >> 3) + 8 * j; const LAS float* s = scr + (8 * c) * 33 + n;
        u32x4 o; o.x = cvt_pk_bf16(s[0 * 33], s[1 * 33]); o.y = cvt_pk_bf16(s[2 * 33], s[3 * 33]); o.z = cvt_pk_bf16(s[4 * 33], s[5 * 33]); o.w = cvt_pk_bf16(s[6 * 33], s[7 * 33]);
        *(u32x4*)(WT + (size_t)(n0 + n) * ldwt + koff + k0 + 8 * c) = o; }
    LDS_WAIT(); asm volatile("" ::: "memory");
}
template <int MAP> __device__ __forceinline__ void transpose_item8(const float* W, int Nsrc, int Ndst, unsigned char* WT, int ldwt, int ff, float scale, LAS float* scr, int item, int lane, int koff = 0) {
    const int nblk = Ndst / 32, kb = item / nblk, nb = item % nblk, k0 = 64 * kb, n0 = 32 * nb;
    const int nd = n0 + (lane & 31); const int sc = MAP == 0 ? nd : (MAP == 1 ? zmap(nd) : gumap(nd, ff));
#pragma unroll 8
    for (int i = 0; i < 32; ++i) { const int kk = 2 * i + (lane >> 5); scr[kk * 33 + (lane & 31)] = W[(size_t)(k0 + kk) * Nsrc + sc] * scale; }
    LDS_WAIT(); asm volatile("" ::: "memory");
    const int c = lane & 3;
#pragma unroll
    for (int j = 0; j < 2; ++j) { const int n = (lane >> 2) + 16 * j; const LAS float* s = scr + (16 * c) * 33 + n;
        u32x4 o; o.x = pk4_fp8(s[0 * 33], s[1 * 33], s[2 * 33], s[3 * 33]); o.y = pk4_fp8(s[4 * 33], s[5 * 33], s[6 * 33], s[7 * 33]); o.z = pk4_fp8(s[8 * 33], s[9 * 33], s[10 * 33], s[11 * 33]); o.w = pk4_fp8(s[12 * 33], s[13 * 33], s[14 * 33], s[15 * 33]);
        *(u32x4*)(WT + (size_t)(n0 + n) * ldwt + koff + k0 + 16 * c) = o; }
    LDS_WAIT(); asm volatile("" ::: "memory");
}
template <int MAP> __device__ __forceinline__ void transpose_class8(const Ctx& F, const float* W, size_t wstride, int K, int Nsrc, int Ndst, unsigned char* WT, size_t wtstride, int ldwt, int ff, float scale, int nmat, int koff = 0) {
    LAS float* scr = (LAS float*)(F.lds + F.wave * 16384);
    const int per = (K / 64) * (Ndst / 32), total = per * nmat, gw = F.wg * NWAVES + F.wave, NGW = F.G * NWAVES;
    for (int it = gw; it < total; it += NGW) { const int mi = it / per, r = it - mi * per;
        transpose_item8<MAP>(W + (size_t)mi * wstride, Nsrc, Ndst, WT + (size_t)mi * wtstride, ldwt, ff, scale, scr, r, F.lane, koff); }
}
template <int MAP> __device__ __forceinline__ void transpose_class(const Ctx& F, const float* W, size_t wstride, int K, int Nsrc, int Ndst, bf16_t* WT, size_t wtstride, int ldwt, int koff, int ff, int nmat) {
    LAS float* scr = (LAS float*)(F.lds + F.wave * 16384);
    const int per = (K / 64) * (Ndst / 32), total = per * nmat, gw = F.wg * NWAVES + F.wave, NGW = F.G * NWAVES;
    for (int it = gw; it < total; it += NGW) { const int mi = it / per, r = it - mi * per;
        transpose_item<MAP>(W + (size_t)mi * wstride, Nsrc, Ndst, WT + (size_t)mi * wtstride, ldwt, koff, ff, scr, r, F.lane); }
}
__device__ __forceinline__ void ada_tasks(const Ctx& F) {
    LAS float* St = (LAS float*)F.lds;
    LAS float* red = (LAS float*)(F.lds + 1024 * 20 * 4);
    const float* c = as_global(F.a->in[I_C]); const float* cc = as_global(F.a->in[I_CCTX]);
    bool have = false;
    for (int task = F.wg; task < DEPTH * 96; task += F.G) {
        if (!have) { for (int i = F.tid; i < NMODR * 1024; i += NTHREADS) { const int r = i >> 10, k = i & 1023; const float v = r < 16 ? c[r * 1024 + k] : cc[k]; St[k * 20 + r] = fast_silu(v); }
            LDS_WAIT(); __syncthreads(); have = true; }
        const int layer = task / 96, n0 = (task % 96) * 64; const float* W = as_global(F.a->in[I_WMOD]) + (size_t)layer * 1024 * 6144 + n0 + F.lane;
        float accv[NMODR];
#pragma unroll
        for (int r = 0; r < NMODR; ++r) accv[r] = 0.f;
        const int kb = F.wave * 128;
#pragma unroll 4
        for (int k = 0; k < 128; ++k) { const float w = W[(size_t)(kb + k) * 6144]; const LAS float* s = St + (kb + k) * 20;
            const f32x4 s0 = *(const LAS f32x4*)s, s1 = *(const LAS f32x4*)(s + 4), s2 = *(const LAS f32x4*)(s + 8), s3 = *(const LAS f32x4*)(s + 12); const float s4 = s[16];
#pragma unroll
            for (int j = 0; j < 4; ++j) { accv[j] += s0[j] * w; accv[4 + j] += s1[j] * w; accv[8 + j] += s2[j] * w; accv[12 + j] += s3[j] * w; }
            accv[16] += s4 * w; }
#pragma unroll
        for (int r = 0; r < NMODR; ++r) red[(F.wave * NMODR + r) * 64 + F.lane] = accv[r];
        LDS_WAIT(); __syncthreads();
        for (int i = F.tid; i < NMODR * 64; i += NTHREADS) { const int r = i >> 6, l = i & 63; float s = as_global(F.a->in[I_BMOD])[layer * 6144 + n0 + l];
#pragma unroll
            for (int w = 0; w < 8; ++w) s += red[(w * NMODR + r) * 64 + l];
            ((float*)(F.ws + WS_MOD))[((size_t)layer * NMODR + r) * 6144 + n0 + l] = s; }
        LDS_WAIT(); __syncthreads();
    }
    __syncthreads();
}
__device__ __forceinline__ void prologue_phase(const Ctx& F) {
    ada_tasks(F);
    const int gt = F.wg * NTHREADS + F.tid, NGT = F.G * NTHREADS;
    if (gt < 1024) { const int pos = gt >> 4, f = gt & 15; const double ang = (double)pos * pow(10000.0, -(double)f / 16.0);
        float* rp = (float*)(F.ws + WS_ROPE); rp[gt] = (float)cos(ang); rp[1024 + gt] = (float)sin(ang); }
    { const float* s = as_global(F.a->in[I_GWS]); bf16_t* d = (bf16_t*)(F.ws + WS_GWS);
      for (int i = gt; i < DEPTH * 4 * 128 * 128 / 2; i += NGT) ((unsigned*)d)[i] = cvt_pk_bf16(s[2 * i], s[2 * i + 1]); }
#if Z8
    transpose_class8<1>(F, as_global(F.a->in[I_WIN]), (size_t)D * DIN, D, DIN, 2048, (unsigned char*)(F.ws + WS_WIN), (size_t)2048 * D, D, 0, W_GU_SCALE, DEPTH);
#else
    transpose_class<1>(F, as_global(F.a->in[I_WIN]), (size_t)D * DIN, D, DIN, 2048, (bf16_t*)(F.ws + WS_WIN), (size_t)2048 * D, D, 0, 0, DEPTH);
#endif
    transpose_class8<0>(F, as_global(F.a->in[I_WIN]) + 2048, (size_t)D * DIN, D, DIN, 3072, (unsigned char*)(F.ws + WS_WG8), (size_t)3072 * D, D, 0, W_GU_SCALE, DEPTH);
    transpose_class<0>(F, as_global(F.a->in[I_WBC]), (size_t)256 * D, 256, D, D, (bf16_t*)(F.ws + WS_WBR), (size_t)D * D, D, 0, 0, DEPTH);
    transpose_class<0>(F, as_global(F.a->in[I_WBG]), (size_t)256 * D, 256, D, D, (bf16_t*)(F.ws + WS_WBR), (size_t)D * D, D, 256, 0, DEPTH);
    transpose_class<0>(F, as_global(F.a->in[I_WBA]), (size_t)512 * D, 512, D, D, (bf16_t*)(F.ws + WS_WBR), (size_t)D * D, D, 512, 0, DEPTH);
#if MERGE8
    for (int rep3 = 0; rep3 < 3; ++rep3) transpose_class8<0>(F, as_global(F.a->in[I_WOUT]), (size_t)D * D, D, D, D, (unsigned char*)(F.ws + WS_WO8), (size_t)D * 3072, 3072, 0, W_GU_SCALE, DEPTH, rep3 * 1024);
#else
    transpose_class<0>(F, as_global(F.a->in[I_WOUT]), (size_t)D * D, D, D, D, (bf16_t*)(F.ws + WS_WO), (size_t)D * D, D, 0, 0, DEPTH);
#endif
    transpose_class<2>(F, as_global(F.a->in[I_FGU]), (size_t)D * 2 * DFF, D, 2 * DFF, 2 * DFF, (bf16_t*)(F.ws + WS_FGU), (size_t)2 * DFF * D, D, 0, DFF, 1);
    transpose_class8<2>(F, as_global(F.a->in[I_FGU]) + (size_t)D * 2 * DFF, (size_t)D * 2 * DFF, D, 2 * DFF, 2 * DFF, (unsigned char*)(F.ws + WS_FGU) + (size_t)2 * DFF * D * 2, (size_t)2 * DFF * D, D, DFF, W_GU_SCALE, 1);
    transpose_class<0>(F, as_global(F.a->in[I_FD]), (size_t)DFF * D, DFF, D, D, (bf16_t*)(F.ws + WS_FD), (size_t)D * DFF, DFF, 0, 0, 1);
    transpose_class8<0>(F, as_global(F.a->in[I_FD]) + (size_t)DFF * D, (size_t)DFF * D, DFF, D, D, (unsigned char*)(F.ws + WS_FD) + (size_t)D * DFF * 2, (size_t)D * DFF, DFF, 0, W_D_SCALE, 1);
    transpose_class8<2>(F, as_global(F.a->in[I_MGU]), (size_t)D * 2 * DFE, D, 2 * DFE, 2 * DFE, (unsigned char*)(F.ws + WS_MGU), (size_t)2 * DFE * D, D, DFE, W_GU_SCALE, 2 * NEXP);
    transpose_class8<0>(F, as_global(F.a->in[I_MD]), (size_t)DFE * D, DFE, D, D, (unsigned char*)(F.ws + WS_MD), (size_t)D * DFE, DFE, 0, W_D_SCALE, 2 * NEXP);
    __syncthreads();
}

struct NormP {
    int M, layer;
    const float* xin_x; const float* xin_c; float* xout_x; float* xout_c;
    const float* gain; int chunk;
    bf16_t* HX; unsigned char* HX8;
    const float* g2prev;
    const float* router;
};
template <bool COMBINE, bool ROUTER, bool FINAL, bool OUT8 = false, bool DUAL = false> __device__ __forceinline__ void norm_phase(const Ctx& F, const NormP& P) {
    const float* MOD = (const float*)(F.ws + WS_MOD) + (size_t)P.layer * NMODR * 6144;
    const bf16_t* Y = (const bf16_t*)(F.ws + WS_RA); const f32x2* selw = (const f32x2*)(F.ws + WS_SELW);
    int* sel_e = (int*)(F.ws + WS_SELE); f32x2* selw_o = (f32x2*)(F.ws + WS_SELW);
    LAS float* RT = (LAS float*)F.lds; LAS int* cl = (LAS int*)(F.lds + 32768);
    if (ROUTER) { for (int i = F.tid; i < 8192; i += NTHREADS) RT[i] = P.router[i]; if (F.tid < 8) cl[F.tid] = 0; LDS_WAIT(); __syncthreads(); }
    const int nr = (P.M + F.G - 1) / F.G;
    const int r0 = ROUTER ? F.wg * nr : F.wg * NWAVES, r1 = ROUTER ? ((r0 + nr < P.M) ? r0 + nr : P.M) : P.M; const int rstep = ROUTER ? NWAVES : F.G * NWAVES;
    const int l4 = F.lane * 4;
    f32x4 gn[4], sh[4], sc[4], g2[4];
#pragma unroll
    for (int j = 0; j < 4; ++j) { gn[j] = *(const f32x4*)(P.gain + 256 * j + l4); sh[j] = sc[j] = g2[j] = (f32x4){0.f, 0.f, 0.f, 0.f}; }
    int curb = -1;
    f32x4 vn[4];
    { const int row = r0 + F.wave; if (row < r1) { const float* xr = row < TX ? P.xin_x + (size_t)row * D : P.xin_c + (size_t)(row - TX) * D;
#pragma unroll
        for (int j = 0; j < 4; ++j) vn[j] = *(const f32x4*)(xr + 256 * j + l4); } }
    for (int row = r0 + F.wave; row < r1; row += rstep) {
        const bool isx = row < TX; const int b = isx ? (row >> 12) : 16;
        if (b != curb) { curb = b;
#pragma unroll
            for (int j = 0; j < 4; ++j) { if (!FINAL) { sh[j] = *(const f32x4*)(MOD + (size_t)b * 6144 + P.chunk * 1024 + 256 * j + l4); sc[j] = *(const f32x4*)(MOD + (size_t)b * 6144 + (P.chunk + 1) * 1024 + 256 * j + l4); }
                if (COMBINE) g2[j] = *(const f32x4*)(P.g2prev + (size_t)b * 6144 + 256 * j + l4); } }
        f32x4 v[4];
#pragma unroll
        for (int j = 0; j < 4; ++j) v[j] = vn[j];
        { const int nrow = row + rstep; if (nrow < r1) { const float* xr = nrow < TX ? P.xin_x + (size_t)nrow * D : P.xin_c + (size_t)(nrow - TX) * D;
#pragma unroll
            for (int j = 0; j < 4; ++j) vn[j] = *(const f32x4*)(xr + 256 * j + l4); } }
        if (COMBINE) { const f32x2 w = selw[row]; float* xo = isx ? P.xout_x + (size_t)row * D : P.xout_c + (size_t)(row - TX) * D;
#pragma unroll
            for (int j = 0; j < 4; ++j) { const u32x2 y0 = *(const u32x2*)(Y + (size_t)row * D + 256 * j + l4), y1 = *(const u32x2*)(Y + ((size_t)T + row) * D + 256 * j + l4);
                const f32x4 a = (f32x4){bf_lo(y0.x), bf_hi(y0.x), bf_lo(y0.y), bf_hi(y0.y)}, c = (f32x4){bf_lo(y1.x), bf_hi(y1.x), bf_lo(y1.y), bf_hi(y1.y)};
                v[j] += g2[j] * (a * w.x + c * w.y); if (!FINAL) *(f32x4*)(xo + 256 * j + l4) = v[j]; } }
        float ss = 0.f;
#pragma unroll
        for (int j = 0; j < 4; ++j) ss += (v[j].x * v[j].x + v[j].y * v[j].y) + (v[j].z * v[j].z + v[j].w * v[j].w);
        const float rs = 1.0f / sqrtf(wave_sum(ss) * (1.0f / D) + EPS);
        if (FINAL) { float* xo = P.xout_x + (size_t)row * D;
#pragma unroll
            for (int j = 0; j < 4; ++j) *(f32x4*)(xo + 256 * j + l4) = v[j] * rs * gn[j];
        } else {
#pragma unroll
            for (int j = 0; j < 4; ++j) { v[j] = v[j] * rs * gn[j] * (sc[j] + 1.0f) + sh[j];
                if (OUT8) *(unsigned*)((unsigned char*)P.HX + (size_t)row * D + 256 * j + l4) = pk4_fp8(v[j].x * A8_SCALE, v[j].y * A8_SCALE, v[j].z * A8_SCALE, v[j].w * A8_SCALE);
                else { u32x2 o; o.x = cvt_pk_bf16(v[j].x, v[j].y); o.y = cvt_pk_bf16(v[j].z, v[j].w); *(u32x2*)(P.HX + (size_t)row * D + 256 * j + l4) = o;
                    if (DUAL) *(unsigned*)(P.HX8 + (size_t)row * D + 256 * j + l4) = pk4_fp8(v[j].x * A8_SCALE, v[j].y * A8_SCALE, v[j].z * A8_SCALE, v[j].w * A8_SCALE); } }
            if (ROUTER) { float lg[8];
#pragma unroll
                for (int e = 0; e < 8; ++e) lg[e] = 0.f;
#pragma unroll
                for (int j = 0; j < 4; ++j)
#pragma unroll
                    for (int q = 0; q < 4; ++q) { const LAS float* rp = RT + (256 * j + l4 + q) * 8; const f32x4 ra = *(const LAS f32x4*)rp, rb = *(const LAS f32x4*)(rp + 4); const float hv = v[j][q];
#pragma unroll
                        for (int e = 0; e < 4; ++e) { lg[e] += hv * ra[e]; lg[4 + e] += hv * rb[e]; } }
#pragma unroll
                for (int e = 0; e < 8; ++e) lg[e] = wave_sum(lg[e]);
                int e0 = 0; float v0 = lg[0];
#pragma unroll
                for (int e = 1; e < 8; ++e) if (lg[e] > v0) { v0 = lg[e]; e0 = e; }
                int e1 = -1; float v1 = -INFINITY;
#pragma unroll
                for (int e = 0; e < 8; ++e) if (e != e0 && lg[e] > v1) { v1 = lg[e]; e1 = e; }
                if (F.lane == 0) { const float w0 = 1.0f / (1.0f + expf(v1 - v0)); sel_e[row] = e0 | (e1 << 8); selw_o[row] = (f32x2){w0, 1.0f - w0};
                    __hip_atomic_fetch_add(cl + e0, 1, __ATOMIC_RELAXED, __HIP_MEMORY_SCOPE_WORKGROUP); __hip_atomic_fetch_add(cl + e1, 1, __ATOMIC_RELAXED, __HIP_MEMORY_SCOPE_WORKGROUP); } }
        }
    }
    if (ROUTER) { LDS_WAIT(); __syncthreads(); if (F.tid < 8) ((int*)(F.ws + WS_CNT))[F.wg * 8 + F.tid] = cl[F.tid]; }
    __syncthreads();
}

__device__ __forceinline__ void moe_gather_phase(const Ctx& F, int M, const bf16_t* HX) {
    LAS int* sm = (LAS int*)F.lds;
    const int* cnt = (const int*)(F.ws + WS_CNT); const int* sel_e = (const int*)(F.ws + WS_SELE);
    int* rinfo = (int*)(F.ws + WS_RINFO); unsigned char* AS = (unsigned char*)(F.ws + WS_RA);
    const int nr = (M + F.G - 1) / F.G, r0 = F.wg * nr, r1 = (r0 + nr < M) ? r0 + nr : M;
    { const int e = F.wave;
      int c4[4]; int s = 0;
#pragma unroll
      for (int j = 0; j < 4; ++j) { const int w = 4 * F.lane + j; c4[j] = (w < F.G) ? cnt[w * 8 + e] : 0; s += c4[j]; }
      int incl = s;
#pragma unroll
      for (int o = 1; o < 64; o <<= 1) { const int t = lane_read(incl, F.lane >= o ? F.lane - o : F.lane); if (F.lane >= o) incl += t; }
      const int tot = __builtin_amdgcn_readlane(incl, 63); int excl = incl - s;
      if (F.lane == (F.wg >> 2)) { for (int j = 0; j < (F.wg & 3); ++j) excl += c4[j]; sm[8 + e] = excl; }
      if (F.lane == 0) sm[e] = tot; }
    LDS_WAIT(); __syncthreads();
    if (F.tid == 0) { int s = 0; for (int e = 0; e < 8; ++e) { sm[16 + e] = s; s += (sm[e] + 255) & ~255; } sm[24] = s; }
    LDS_WAIT(); __syncthreads();
    if (F.wg == 0 && F.tid < 9) ((int*)(F.ws + WS_META))[F.tid] = sm[16 + F.tid] >> 8;
    if (F.wg < 8) { const int e = F.wg, lo = sm[16 + e] + sm[e], hi = sm[17 + e]; for (int i = lo + F.tid; i < hi; i += NTHREADS) rinfo[i] = -1; }
    LAS int* pos0 = sm + 64; LAS int* pos1 = pos0 + nr;
    if (F.wave == 0) { int run[8];
#pragma unroll
        for (int e = 0; e < 8; ++e) run[e] = sm[16 + e] + sm[8 + e];
        for (int base = r0; base < r1; base += 64) { const int t = base + F.lane; const bool valid = t < r1; const int ee = valid ? sel_e[t] : 0xffff; const int e0 = ee & 0xff, e1 = (ee >> 8) & 0xff;
            int p0 = 0, p1 = 0; const unsigned long long lt = (1ull << F.lane) - 1ull;
#pragma unroll
            for (int e = 0; e < 8; ++e) { const unsigned long long m = __ballot(valid && (e0 == e || e1 == e)); const int pc = __popcll(m & lt);
                if (e0 == e) p0 = run[e] + pc; if (e1 == e) p1 = run[e] + pc; run[e] += __popcll(m); }
            if (valid) { pos0[t - r0] = p0; pos1[t - r0] = p1; rinfo[p0] = t; rinfo[p1] = t | (1 << 20); } } }
    LDS_WAIT(); __syncthreads();
    for (int p = F.wave; p < 2 * (r1 - r0); p += NWAVES) { const int tl = p >> 1, k = p & 1; const int dst = k ? pos1[tl] : pos0[tl];
        const u32x4* s = (const u32x4*)(HX + (size_t)(r0 + tl) * D); u32x4* d = (u32x4*)(AS + (size_t)dst * D);
        f32x4 a0, a1, b0, b1; unpack8(s[2 * F.lane], a0, a1); unpack8(s[2 * F.lane + 1], b0, b1); a0 *= A8_SCALE; a1 *= A8_SCALE; b0 *= A8_SCALE; b1 *= A8_SCALE;
        u32x4 o; o.x = pk4_fp8(a0[0], a0[1], a0[2], a0[3]); o.y = pk4_fp8(a1[0], a1[1], a1[2], a1[3]); o.z = pk4_fp8(b0[0], b0[1], b0[2], b0[3]); o.w = pk4_fp8(b1[0], b1[1], b1[2], b1[3]);
        d[F.lane] = o; }
    __syncthreads();
}

constexpr int GM_PITCH = 272;
__device__ __forceinline__ void gmlp_units(const Ctx& F, int layer, int M, const bf16_t* ZG, bf16_t* Y) {
    const bf16_t* GWS = (const bf16_t*)(F.ws + WS_GWS) + (size_t)layer * 4 * 128 * 128; const float* GB = as_global(F.a->in[I_GB]) + layer * 512;
    const int g = F.wave >> 1, ph = F.wave & 1, r = F.lane & 31, h = F.lane >> 5;
    bf16x8 wf[2][8];
#pragma unroll
    for (int pt = 0; pt < 2; ++pt)
#pragma unroll
        for (int s = 0; s < 8; ++s) wf[pt][s] = *(const bf16x8*)(GWS + ((size_t)g * 128 + ph * 64 + 32 * pt + r) * 128 + 16 * s + 8 * h);
    float bsv[2];
#pragma unroll
    for (int pt = 0; pt < 2; ++pt) bsv[pt] = GB[g * 128 + ph * 64 + 32 * pt + r];
    LAS unsigned char* VT = F.lds;
    const int nchunk = M / 128;
    for (int ch = F.wg; ch < nchunk; ch += F.G) {
        const int r0 = ch * 128;
#pragma unroll
        for (int i = 0; i < 8; ++i) { const int q = 16 * F.wave + 2 * i;
            const u32x2 wa = *(const u32x2*)(ZG + (size_t)(r0 + q) * 512 + 256 + 4 * F.lane), wb = *(const u32x2*)(ZG + (size_t)(r0 + q + 1) * 512 + 256 + 4 * F.lane);
            f32x4 a = (f32x4){bf_lo(wa.x), bf_hi(wa.x), bf_lo(wa.y), bf_hi(wa.y)}, b = (f32x4){bf_lo(wb.x), bf_hi(wb.x), bf_lo(wb.y), bf_hi(wb.y)};
            const float ma = wave_sum((a.x + a.y) + (a.z + a.w)) * (1.0f / 256.0f), mb = wave_sum((b.x + b.y) + (b.z + b.w)) * (1.0f / 256.0f);
            a = a - ma; b = b - mb;
            const float va = wave_sum((a.x * a.x + a.y * a.y) + (a.z * a.z + a.w * a.w)) * (1.0f / 256.0f), vb = wave_sum((b.x * b.x + b.y * b.y) + (b.z * b.z + b.w * b.w)) * (1.0f / 256.0f);
            const float ra = 1.0f / sqrtf(va + EPS), rb = 1.0f / sqrtf(vb + EPS);
#pragma unroll
            for (int j = 0; j < 4; ++j) *(LAS unsigned*)(VT + (4 * F.lane + j) * GM_PITCH + 2 * q) = cvt_pk_bf16(a[j] * ra, b[j] * rb); }
        LDS_WAIT(); __syncthreads();
        f32x16 acc[2][2];
#pragma unroll
        for (int ct = 0; ct < 2; ++ct)
#pragma unroll
            for (int pt = 0; pt < 2; ++pt) acc[ct][pt] = f32x16{};
#pragma unroll
        for (int s = 0; s < 8; ++s)
#pragma unroll
            for (int ct = 0; ct < 2; ++ct) { const bf16x8 af = *(const LAS bf16x8*)(VT + (g * 64 + 32 * ct + r) * GM_PITCH + 32 * s + 16 * h);
#pragma unroll
                for (int pt = 0; pt < 2; ++pt) acc[ct][pt] = __builtin_amdgcn_mfma_f32_32x32x16_bf16(af, wf[pt][s], acc[ct][pt], 0, 0, 0); }
#pragma unroll
        for (int pt = 0; pt < 2; ++pt) { const size_t row = (size_t)(r0 + ph * 64 + 32 * pt + r);
#pragma unroll
            for (int ct = 0; ct < 2; ++ct)
#pragma unroll
                for (int rg = 0; rg < 4; ++rg) { const int c0 = g * 64 + 32 * ct + 8 * rg + 4 * h; const u32x2 uw = *(const u32x2*)(ZG + row * 512 + c0);
                    const float y0 = bf_lo(uw.x) * (acc[ct][pt][4 * rg + 0] + bsv[pt]), y1 = bf_hi(uw.x) * (acc[ct][pt][4 * rg + 1] + bsv[pt]);
                    const float y2 = bf_lo(uw.y) * (acc[ct][pt][4 * rg + 2] + bsv[pt]), y3 = bf_hi(uw.y) * (acc[ct][pt][4 * rg + 3] + bsv[pt]);
                    u32x2 o; o.x = cvt_pk_bf16(y0, y1); o.y = cvt_pk_bf16(y2, y3); *(u32x2*)(Y + row * D + 256 + c0) = o; } }
        LDS_WAIT(); __syncthreads();
    }
}
__device__ __forceinline__ void conv_units(const Ctx& F, int layer, int M, const bf16_t* ZC, bf16_t* Y) {
    const float* CW = as_global(F.a->in[I_CONVW]) + layer * 768;
    const int gt = F.wg * NTHREADS + F.tid, NGT = F.G * NTHREADS;
    for (int it = gt; it < M * 32; it += NGT) { const int row = it >> 5, c0 = (it & 31) * 8;
        const int s = row < TX ? (row & (SEQ - 1)) : ((row - TX) & (CTXL - 1)), L = row < TX ? SEQ : CTXL;
        const bf16_t* zp = ZC + (size_t)row * 768 + c0;
        f32x4 bg0, bg1, c0a, c0b, h0a, h0b; unpack8(*(const u32x4*)zp, bg0, bg1); unpack8(*(const u32x4*)(zp + 256), c0a, c0b); unpack8(*(const u32x4*)(zp + 512), h0a, h0b);
        const f32x4 w0a = *(const f32x4*)(CW + c0), w0b = *(const f32x4*)(CW + c0 + 4), w1a = *(const f32x4*)(CW + 256 + c0), w1b = *(const f32x4*)(CW + 256 + c0 + 4), w2a = *(const f32x4*)(CW + 512 + c0), w2b = *(const f32x4*)(CW + 512 + c0 + 4);
        f32x4 sa = w1a * (c0a * h0a), sb = w1b * (c0b * h0b);
        if (s > 0) { f32x4 ca, cb, ha, hb; unpack8(*(const u32x4*)(zp - 768 + 256), ca, cb); unpack8(*(const u32x4*)(zp - 768 + 512), ha, hb); sa += w0a * (ca * ha); sb += w0b * (cb * hb); }
        if (s < L - 1) { f32x4 ca, cb, ha, hb; unpack8(*(const u32x4*)(zp + 768 + 256), ca, cb); unpack8(*(const u32x4*)(zp + 768 + 512), ha, hb); sa += w2a * (ca * ha); sb += w2b * (cb * hb); }
        *(u32x4*)(Y + (size_t)row * D + c0) = pack8(bg0 * sa, bg1 * sb); }
}
__device__ __forceinline__ void mixer_phase(const Ctx& F, int layer, bool ctx_out) {
    GAS unsigned char* rh = F.ws + WS_RH;
    const attn_body::bf16* Q = (const attn_body::bf16*)(rh + RH_Q); const attn_body::bf16* K = (const attn_body::bf16*)(rh + RH_K); const attn_body::bf16* V = (const attn_body::bf16*)(rh + RH_V);
    attn_body::bf16* Y = (attn_body::bf16*)(rh + RH_BUFA);
    const float* sink = as_global(F.a->in[I_SINK]) + layer * 8;
    char* shm = (char*)F.lds;
    for (int uid = F.wg; uid < NB * 32 * 4; uid += F.G) {
        const int hp = uid & 3, n = (uid >> 2) & 31, b = uid >> 7, kvh = hp >> 1, head = 2 * hp + (F.wave >> 2);
        const int i_lo = n == 0 ? 2 : 0, i_hi = n == 31 ? 3 : 5, NT = 4 + (i_hi - i_lo + 1);
        const int qrow = b * SEQ + n * 128 + 32 * (F.wave & 3), lrow0 = b * SEQ + n * 128 - 128 + 64 * i_lo, crow0 = TX + b * CTXL;
        const int qoff0 = 32 * (F.wave & 3) + 128 - 64 * i_lo;
        attn_body::attn_unit<8>(Q + (size_t)qrow * 512 + head * 64, K + kvh * 64, V + kvh * 64, Y + (size_t)qrow * D + 512 + head * 64, crow0, lrow0, NT, qoff0, sink[head] * 1.4426950408889634f, shm);
    }
    if (ctx_out) for (int uid = F.wg; uid < NB * 4 * 2; uid += F.G) {
        const int hp = uid & 3, half = (uid >> 2) & 1, b = uid >> 3, kvh = hp >> 1, head = 2 * hp + (F.wave >> 2);
        const int qrow = TX + b * CTXL + half * 128 + 32 * (F.wave & 3), crow0 = TX + b * CTXL;
        attn_body::attn_unit<8>(Q + (size_t)qrow * 512 + head * 64, K + kvh * 64, V + kvh * 64, Y + (size_t)qrow * D + 512 + head * 64, crow0, 0, 4, 0, sink[head] * 1.4426950408889634f, shm);
    }
    __syncthreads();
    const int M = ctx_out ? T : TX;
#ifndef REP_GC
#define REP_GC 0
#endif
    _Pragma("nounroll") for (int rep_ = 0; rep_ < 1 + ((REP_GC >> 0) & 1); ++rep_) gmlp_units(F, layer, M, (const bf16_t*)(rh + RH_ZG), (bf16_t*)(rh + RH_BUFA));
    _Pragma("nounroll") for (int rep_ = 0; rep_ < 1 + ((REP_GC >> 1) & 1); ++rep_) conv_units(F, layer, M, (const bf16_t*)(rh + RH_ZC), (bf16_t*)(rh + RH_BUFA));
}

constexpr int NPHASES = 38;
__global__ void __launch_bounds__(NTHREADS, 2) fwd(Args args) {
    extern __shared__ __attribute__((aligned(16))) unsigned char lds_[];
    Ctx F; F.lds = (LAS unsigned char*)lds_; F.tid = threadIdx.x; F.lane = F.tid & 63; F.wave = __builtin_amdgcn_readfirstlane(F.tid >> 6); F.G = gridDim.x; F.wg = blockIdx.x; F.a = (const Args __attribute__((address_space(4)))*)__builtin_amdgcn_kernarg_segment_ptr(); F.ws = F.a->ws;
    volatile LAS unsigned* MISC = (volatile LAS unsigned*)(F.lds + MISC_OFF);
    for (int u = F.tid; u < (LDS_BYTES - MISC_OFF) / 4; u += NTHREADS) ((LAS unsigned*)(F.lds + MISC_OFF))[u] = 0u;
    __syncthreads();
    if (F.lane == 0) *(volatile LAS int*)(unsigned long)(WAVEMAP_OFF + 4 * hw_wave_key()) = F.wave;
    __syncthreads();
    XcdBarrier bar = xcd_barrier_post((unsigned*)(F.ws + WS_CTL) + CW_BAR, MISC + 8);
    const int lo = F.a->ph_lo, hi = F.a->ph_hi;
#ifndef PHMASK
#define PHMASK 0xffff
#endif
#define EN(b) ((PHMASK >> (b)) & 1)
#ifndef REP_MASK
#define REP_MASK 0
#endif
#define REPS(b) _Pragma("nounroll") for (int rep_ = 0; rep_ < (((REP_MASK >> (b)) & 1) ? 2 : 1); ++rep_)
#define IN(k) (lo <= (k) && (k) < hi)
#define SEAM(a, b) do { if (IN(a) && IN(b)) xcd_barrier(bar); } while (0)
#define REFRESH_G() do { const Args __attribute__((address_space(4)))* a_ = (const Args __attribute__((address_space(4)))*)__builtin_amdgcn_kernarg_segment_ptr(); asm volatile("" : "+s"(a_)); F.a = a_; GAS unsigned char* w_ = a_->ws; asm volatile("" : "+s"(w_)); F.ws = w_; } while (0)
#define REFRESH() do { F.tid = opaque_tid(); F.lane = F.tid & 63; F.wave = __builtin_amdgcn_readfirstlane(F.tid >> 6); const Args __attribute__((address_space(4)))* a_ = (const Args __attribute__((address_space(4)))*)__builtin_amdgcn_kernarg_segment_ptr(); asm volatile("" : "+s"(a_)); F.a = a_; GAS unsigned char* w_ = a_->ws; asm volatile("" : "+s"(w_)); F.ws = w_; } while (0)
#define rh (F.ws + WS_RH)
#define BUFA ((bf16_t*)(F.ws + WS_RH + RH_BUFA))
#define BUFB ((bf16_t*)(F.ws + WS_RH + RH_BUFB))
#define XC ((float*)(F.ws + WS_XC))
#define MODALL ((const float*)(F.ws + WS_MOD))

    if (EN(0) && IN(0)) REPS(0) { REFRESH(); prologue_phase(F); }
    SEAM(0, 1);
#pragma nounroll
    for (int i = 0; i < DEPTH; ++i) {
        const int pb = 1 + 9 * i; const bool moe = (i & 1) != 0, last = (i == DEPTH - 1); const int j = i >> 1;
        const int Mact = last ? TX : T, nMact = Mact / 256;
#define MODL (MODALL + (size_t)i * NMODR * 6144)
        if (EN(1) && IN(pb + 0)) REPS(1) { REFRESH(); NormP P; P.M = T; P.layer = i; P.xin_x = i == 0 ? as_global(F.a->in[I_X]) : as_global(F.a->out); P.xin_c = i == 0 ? as_global(F.a->in[I_CTX]) : XC; P.xout_x = as_global(F.a->out); P.xout_c = XC;
            P.gain = as_global(F.a->in[I_N1G]) + i * D; P.chunk = 0; P.HX = BUFA; P.g2prev = MODALL + (size_t)(i - 1) * NMODR * 6144 + 5 * D; P.router = nullptr;
            P.HX8 = (unsigned char*)BUFB;
            if (i == 2) norm_phase<true, false, false, false, true>(F, P); else norm_phase<false, false, false, false, true>(F, P); }
        SEAM(pb + 0, pb + 1);
        if (EN(2) && IN(pb + 1)) REPS(2) { REFRESH_G();
#if Z8
            { pg8::DenseSched S{(const char*)BUFB, (const char*)(F.ws + WS_WIN) + (size_t)i * 2048 * D, 1024u, 1024u, nMact, 8, D / 128, F.G, F.wg, last ? TC / 256 : 0, NPX, 7};
              pg8::EpiZ E{(bf16_t*)(rh + RH_ZC), (bf16_t*)(rh + RH_ZG), (bf16_t*)(rh + RH_Q), (bf16_t*)(rh + RH_K), (bf16_t*)(rh + RH_V), (bf16_t*)(rh + RH_G), (const float*)(F.ws + WS_ROPE), 1.0f / (A8_SCALE * W_GU_SCALE)};
              pg8::gemm_phase<pg8::EpiZ, pg8::DenseSched, true>(F.lds, 1024u, 1024u, S, E); }
#else
            { pg8::DenseSched S{(const char*)BUFA, (const char*)(F.ws + WS_WIN) + (size_t)i * 2048 * D * 2, 2048u, 2048u, nMact, 8, 16, F.G, F.wg, last ? TC / 256 : 0, NPX, 7};
              pg8::EpiZ E{(bf16_t*)(rh + RH_ZC), (bf16_t*)(rh + RH_ZG), (bf16_t*)(rh + RH_Q), (bf16_t*)(rh + RH_K), (bf16_t*)(rh + RH_V), (bf16_t*)(rh + RH_G), (const float*)(F.ws + WS_ROPE), 1.0f};
              pg8::gemm_phase(F.lds, 2048u, 2048u, S, E); }
#endif
            { pg8::DenseSched S{(const char*)BUFB, (const char*)(F.ws + WS_WG8) + (size_t)i * 3072 * D, 1024u, 1024u, nMact, 12, D / 128, F.G, F.wg, 0, 0, 0};
              pg8::EpiGate8 E{(bf16_t*)(rh + RH_G)};
              pg8::gemm_phase<pg8::EpiGate8, pg8::DenseSched, true>(F.lds, 1024u, 1024u, S, E); } }
        SEAM(pb + 1, pb + 2);
        if (EN(3) && IN(pb + 2)) REPS(3) { REFRESH(); mixer_phase(F, i, !last); }
        SEAM(pb + 2, pb + 3);
#if MERGE8
        if (EN(4) && IN(pb + 3)) REPS(4) { REFRESH_G(); pg8::Merge12Sched S{(const char*)BUFA, (const char*)(F.ws + WS_WBR) + (size_t)i * D * D * 2, nMact, F.G, F.wg};
            pg8::EpiMerge8 E{(const bf16_t*)(rh + RH_G), (unsigned char*)(rh + RH_GP8)};
            pg8::gemm_phase(F.lds, 2048u, 2048u, S, E); }
#else
        if (EN(4) && IN(pb + 3)) REPS(4) { REFRESH_G(); pg8::MergeSched S{(const char*)BUFA, (const char*)(F.ws + WS_WBR) + (size_t)i * D * D * 2, nMact, F.G, F.wg};
            pg8::EpiMerge E{(const bf16_t*)(rh + RH_G), BUFB};
            pg8::gemm_phase(F.lds, 2048u, 2048u, S, E); }
#endif
        SEAM(pb + 3, pb + 4);
#if MERGE8
        if (EN(5) && IN(pb + 4)) REPS(5) { REFRESH_G(); pg8::DenseSched S{(const char*)(rh + RH_GP8), (const char*)(F.ws + WS_WO8) + (size_t)i * D * 3072, 3072u, 3072u, nMact, 4, 3072 / 128, F.G, F.wg, 0, 0, 0};
            pg8::EpiResid E{i == 0 ? as_global(F.a->in[I_X]) : as_global(F.a->out), i == 0 ? as_global(F.a->in[I_CTX]) : XC, as_global(F.a->out), XC, MODL + 2 * D, 1.0f / (GP8_SCALE * W_GU_SCALE)};
            pg8::gemm_phase<pg8::EpiResid, pg8::DenseSched, true>(F.lds, 3072u, 3072u, S, E); }
#else
        if (EN(5) && IN(pb + 4)) REPS(5) { REFRESH_G(); pg8::DenseSched S{(const char*)BUFB, (const char*)(F.ws + WS_WO) + (size_t)i * D * D * 2, 2048u, 2048u, nMact, 4, 16, F.G, F.wg, 0, 0, 0};
            pg8::EpiResid E{i == 0 ? as_global(F.a->in[I_X]) : as_global(F.a->out), i == 0 ? as_global(F.a->in[I_CTX]) : XC, as_global(F.a->out), XC, MODL + 2 * D, 1.0f};
            pg8::gemm_phase(F.lds, 2048u, 2048u, S, E); }
#endif
        SEAM(pb + 4, pb + 5);
        if (EN(6) && IN(pb + 5)) REPS(6) { REFRESH(); NormP P; P.M = Mact; P.layer = i; P.xin_x = as_global(F.a->out); P.xin_c = XC; P.xout_x = as_global(F.a->out); P.xout_c = XC; P.gain = as_global(F.a->in[I_N2G]) + i * D; P.chunk = 3; P.HX = BUFA; P.g2prev = nullptr;
            P.router = as_global(F.a->in[I_ROUTER]) + (size_t)j * D * NEXP;
            if (moe) norm_phase<false, true, false>(F, P); else if (i == 0) norm_phase<false, false, false>(F, P); else norm_phase<false, false, false, true>(F, P); }
        if (moe) {
            SEAM(pb + 5, pb + 6);
            if (EN(7) && IN(pb + 6)) REPS(7) { REFRESH(); moe_gather_phase(F, Mact, BUFA); }
            SEAM(pb + 6, pb + 7);
            if (EN(8) && IN(pb + 7)) REPS(8) { REFRESH_G(); pg8::MoeSched S; S.A = (const char*)(F.ws + WS_RA); S.B = (const char*)(F.ws + WS_MGU) + (size_t)j * NEXP * 2 * DFE * D; S.lda = 1024u; S.ldb = 1024u; S.estride = (size_t)2 * DFE * D;
                S.nN = 2 * DFE / 256; S.nt = D / 128; S.G = F.G; S.c = F.wg;
#pragma unroll
                for (int k = 0; k < 9; ++k) S.P[k] = __builtin_amdgcn_readfirstlane(((const int*)(F.ws + WS_META))[k]);
                pg8::EpiGU8 E{(unsigned char*)rh, DFE};
                pg8::gemm_phase<pg8::EpiGU8, pg8::MoeSched, true>(F.lds, 1024u, 1024u, S, E); }
            SEAM(pb + 7, pb + 8);
            if (EN(9) && IN(pb + 8)) REPS(9) { REFRESH_G(); pg8::MoeSched S; S.A = (const char*)rh; S.B = (const char*)(F.ws + WS_MD) + (size_t)j * NEXP * D * DFE; S.lda = (unsigned)DFE; S.ldb = (unsigned)DFE; S.estride = (size_t)D * DFE;
                S.nN = 4; S.nt = DFE / 128; S.G = F.G; S.c = F.wg;
#pragma unroll
                for (int k = 0; k < 9; ++k) S.P[k] = __builtin_amdgcn_readfirstlane(((const int*)(F.ws + WS_META))[k]);
                pg8::EpiMoeDown E{(const int*)(F.ws + WS_RINFO), (bf16_t*)(F.ws + WS_RA), 1.0f / (H8_SCALE * W_D_SCALE)};
                pg8::gemm_phase<pg8::EpiMoeDown, pg8::MoeSched, true>(F.lds, (unsigned)DFE, (unsigned)DFE, S, E); }
        } else {
            SEAM(pb + 5, pb + 7);
            if (EN(10) && IN(pb + 7)) REPS(10) { REFRESH_G();
                if (i == 0) { pg8::DenseSched S{(const char*)BUFA, (const char*)(F.ws + WS_FGU), 2048u, 2048u, nMact, 2 * DFF / 256, 16, F.G, F.wg, 0, 0, 0};
                    pg8::EpiGU E{(bf16_t*)(rh + RH_HD), DFF};
                    pg8::gemm_phase(F.lds, 2048u, 2048u, S, E); }
                else { pg8::DenseSched S{(const char*)BUFA, (const char*)(F.ws + WS_FGU) + (size_t)2 * DFF * D * 2, 1024u, 1024u, nMact, 2 * DFF / 256, D / 128, F.G, F.wg, 0, 0, 0};
                    pg8::EpiGU8 E{(unsigned char*)(rh + RH_HD), DFF};
                    pg8::gemm_phase<pg8::EpiGU8, pg8::DenseSched, true>(F.lds, 1024u, 1024u, S, E); } }
            SEAM(pb + 7, pb + 8);
            if (EN(11) && IN(pb + 8)) REPS(11) { REFRESH_G();
                if (i == 0) { pg8::DenseSched S{(const char*)(rh + RH_HD), (const char*)(F.ws + WS_FD), 2u * DFF, 2u * DFF, nMact, 4, DFF / 64, F.G, F.wg, 0, 0, 0};
                    pg8::EpiResid E{as_global(F.a->out), XC, as_global(F.a->out), XC, MODL + 5 * D, 1.0f};
                    pg8::gemm_phase(F.lds, 2u * DFF, 2u * DFF, S, E); }
                else { pg8::DenseSched S{(const char*)(rh + RH_HD), (const char*)(F.ws + WS_FD) + (size_t)D * DFF * 2, (unsigned)DFF, (unsigned)DFF, nMact, 4, DFF / 128, F.G, F.wg, 0, 0, 0};
                    pg8::EpiResid E{as_global(F.a->out), XC, as_global(F.a->out), XC, MODL + 5 * D, 1.0f / (H8_SCALE * W_D_SCALE)};
                    pg8::gemm_phase<pg8::EpiResid, pg8::DenseSched, true>(F.lds, (unsigned)DFF, (unsigned)DFF, S, E); } }
        }
        SEAM(pb + 8, pb + 9);
    }
    if (EN(12) && IN(37)) REPS(12) { REFRESH(); NormP P; P.M = TX; P.layer = DEPTH - 1; P.xin_x = as_global(F.a->out); P.xin_c = XC; P.xout_x = as_global(F.a->out); P.xout_c = XC; P.gain = as_global(F.a->in[I_FNG]); P.chunk = 0; P.HX = nullptr;
        P.g2prev = MODALL + (size_t)(DEPTH - 1) * NMODR * 6144 + 5 * D; P.router = nullptr;
        norm_phase<true, false, true>(F, P); }
#undef IN
#undef SEAM
#undef rh
#undef BUFA
#undef BUFB
#undef XC
#undef MODALL
#undef MODL
}


extern "C" void kernel_launch(void* const* d_in, const int* in_sizes, int n_in, void* d_out, int out_size, void* d_ws, size_t ws_size, hipStream_t stream) {
    static int grid = 0;
    if (grid == 0) {
        if (n_in != 23 || out_size != TX * D || ws_size < WS_END) { fprintf(stderr, "kernel_launch: unexpected shapes (n_in %d, out %d, ws %zu < %zu)\n", n_in, out_size, ws_size, (size_t)WS_END); grid = -1; return; }
        int dev = 0, cus = 0, per_cu = 0;
        if (hipGetDevice(&dev) != hipSuccess || hipDeviceGetAttribute(&cus, hipDeviceAttributeMultiprocessorCount, dev) != hipSuccess) { grid = -1; return; }
        if (hipFuncSetAttribute((const void*)fwd, hipFuncAttributeMaxDynamicSharedMemorySize, LDS_BYTES) != hipSuccess) { fprintf(stderr, "kernel_launch: hipFuncSetAttribute failed\n"); grid = -1; return; }
        if (hipOccupancyMaxActiveBlocksPerMultiprocessor(&per_cu, (const void*)fwd, NTHREADS, LDS_BYTES) != hipSuccess || per_cu < 1) fprintf(stderr, "kernel_launch: occupancy query says %d\n", per_cu);
        (void)hipGetLastError();
        grid = cus > 256 ? 256 : cus;
    }
    if (grid < 0) return;
    (void)hipMemsetAsync((char*)d_ws + WS_CTL, 0, CTL_BYTES, stream);
    Args a{};
    for (int i = 0; i < 23; ++i) a.in[i] = (GAS const float*)d_in[i];
    a.out = (GAS float*)d_out; a.ws = (GAS unsigned char*)d_ws;
#if MK_MULTI
    for (int p = 0; p < NPHASES; ++p) { if (p >= 1 && p < 37) { const int i = (p - 1) / 9, k = (p - 1) % 9; if (k == 6 && !(i & 1)) continue; }
        a.ph_lo = p; a.ph_hi = p + 1; hipLaunchKernelGGL(fwd, dim3(grid), dim3(NTHREADS), LDS_BYTES, stream, a); }
#else
    a.ph_lo = 0; a.ph_hi = NPHASES;
    hipLaunchKernelGGL(fwd, dim3(grid), dim3(NTHREADS), LDS_BYTES, stream, a);
#endif
    const hipError_t le = hipPeekAtLastError();
    if (le != hipSuccess) fprintf(stderr, "kernel_launch: launch failed: %s\n", hipGetErrorName(le));
}
```

```cpp
#include <hip/hip_runtime.h>
#include <hip/hip_bf16.h>
#include <cstdio>
#include <cstdint>

#ifndef USE_AGPR
#define USE_AGPR 0
#endif
#ifndef Z8
#define Z8 0
#endif
#ifndef MERGE8
#define MERGE8 0
#endif
#ifndef MK_MULTI
#define MK_MULTI 0
#endif

constexpr int D = 1024, NB = 16, SEQ = 4096, CTXL = 256, DEPTH = 4;
constexpr int TX = NB * SEQ, TC = NB * CTXL, T = TX + TC;
constexpr int DIN = 5120, DFF = 2816, DFE = 3584, NEXP = 8, NMODR = 17;
constexpr int NPX = TX / 256, NPA = T / 256;
constexpr int SROWS = 2 * T + 2048;
constexpr float EPS = 1e-6f;
constexpr float QSCALE = 0.125f * 1.4426950408889634f;
constexpr float A8_SCALE = 8.0f, W_GU_SCALE = 64.0f, H8_SCALE = 4.0f, W_D_SCALE = 128.0f, GP8_SCALE = 16.0f;

constexpr size_t al256(size_t x) { return (x + 255) & ~(size_t)255; }
constexpr size_t WS_CTL = 0, CTL_BYTES = 1u << 20;
constexpr size_t WS_MOD = WS_CTL + CTL_BYTES;
constexpr size_t WS_ROPE = WS_MOD + al256((size_t)DEPTH * NMODR * 6 * D * 4);
constexpr size_t WS_GWS = WS_ROPE + 8192;
constexpr size_t WS_SELE = WS_GWS + (size_t)DEPTH * 4 * 128 * 128 * 2;
constexpr size_t WS_SELW = WS_SELE + al256((size_t)T * 4);
constexpr size_t WS_CNT = WS_SELW + al256((size_t)T * 8);
constexpr size_t WS_META = WS_CNT + 8192;
constexpr size_t WS_RINFO = WS_META + 256;
constexpr size_t WS_XC = WS_RINFO + al256((size_t)SROWS * 4);
constexpr size_t WS_WIN = WS_XC + (size_t)TC * D * 4;
constexpr size_t WS_WG8 = WS_WIN + (size_t)DEPTH * 2048 * D * 2;
constexpr size_t WS_WO8 = WS_WG8 + (size_t)DEPTH * 3072 * D;
static_assert(WS_WO8 + (size_t)DEPTH * D * 3072 <= WS_WIN + (size_t)DEPTH * DIN * D * 2, "fp8 copies fit the w_in region");
constexpr size_t WS_WBR = WS_WIN + (size_t)DEPTH * DIN * D * 2;
constexpr size_t WS_WO = WS_WBR + (size_t)DEPTH * D * D * 2;
constexpr size_t WS_FGU = WS_WO + (size_t)DEPTH * D * D * 2;
constexpr size_t WS_FD = WS_FGU + (size_t)2 * 2 * DFF * D * 2;
constexpr size_t WS_MGU = WS_FD + (size_t)2 * D * DFF * 2;
constexpr size_t WS_MD = WS_MGU + (size_t)2 * NEXP * 2 * DFE * D;
constexpr size_t WS_RA = WS_MD + (size_t)2 * NEXP * D * DFE;
constexpr size_t RA_BYTES = (size_t)SROWS * D * 2;
constexpr size_t WS_RH = WS_RA + RA_BYTES;
constexpr size_t RH_BYTES = (size_t)SROWS * DFE * 2;
constexpr size_t WS_END = WS_RH + RH_BYTES;
static_assert((size_t)2 * T * D * 2 <= RA_BYTES, "Yslot fits region A");
static_assert(WS_END <= (size_t)1879048192, "d_ws map exceeds 4x largest tensor");
constexpr size_t RH_ZC = 0;
constexpr size_t RH_ZG = RH_ZC + (size_t)T * 768 * 2;
constexpr size_t RH_Q = RH_ZG + (size_t)T * 512 * 2;
constexpr size_t RH_K = RH_Q + (size_t)T * 512 * 2;
constexpr size_t RH_V = RH_K + (size_t)T * 128 * 2;
constexpr size_t RH_G = RH_V + (size_t)T * 128 * 2;
constexpr size_t RH_ZEND = RH_G + (size_t)T * 3072 * 2;
constexpr size_t RH_BUFA = RH_ZEND;
constexpr size_t RH_BUFB = RH_BUFA + (size_t)T * D * 2;
constexpr size_t RH_GP8 = 0;
static_assert((size_t)T * 3072 <= RH_G, "gated products fit below the gates");
constexpr size_t RH_HD = 0;
static_assert(RH_BUFB + (size_t)T * D * 2 <= RH_BYTES && (size_t)T * DFF * 2 <= RH_ZEND, "region H overlays");

#define LAS __attribute__((address_space(3)))
#define GAS __attribute__((address_space(1)))
typedef unsigned short bf16_t;
typedef short bf16x8 __attribute__((ext_vector_type(8)));
typedef float f32x4 __attribute__((ext_vector_type(4)));
typedef float f32x2 __attribute__((ext_vector_type(2)));
typedef float f32x16 __attribute__((ext_vector_type(16)));
typedef unsigned u32x4 __attribute__((ext_vector_type(4)));
typedef unsigned u32x2 __attribute__((ext_vector_type(2)));
#define LDS_WAIT() asm volatile("s_waitcnt lgkmcnt(0)" ::: "memory")
#define VM_WAIT() asm volatile("s_waitcnt vmcnt(0)" ::: "memory")

typedef __bf16 bf16x2_v __attribute__((ext_vector_type(2)));
__device__ __forceinline__ unsigned cvt_pk_bf16(float lo, float hi) { const f32x2 v = {lo, hi}; const bf16x2_v b = __builtin_convertvector(v, bf16x2_v); return __builtin_bit_cast(unsigned, b); }
__device__ __forceinline__ float clamp8(float v) { return __builtin_fminf(__builtin_fmaxf(v, -448.0f), 448.0f); }
__device__ __forceinline__ unsigned pk4_fp8(float a, float b, float c, float d) { int w = 0; w = __builtin_amdgcn_cvt_pk_fp8_f32(clamp8(a), clamp8(b), w, false); w = __builtin_amdgcn_cvt_pk_fp8_f32(clamp8(c), clamp8(d), w, true); return (unsigned)w; }
__device__ __forceinline__ float bf_lo(unsigned u) { return __uint_as_float(u << 16); }
__device__ __forceinline__ float bf_hi(unsigned u) { return __uint_as_float(u & 0xffff0000u); }
__device__ __forceinline__ u32x4 pack8(f32x4 a, f32x4 b) { u32x4 w; w.x = cvt_pk_bf16(a[0], a[1]); w.y = cvt_pk_bf16(a[2], a[3]); w.z = cvt_pk_bf16(b[0], b[1]); w.w = cvt_pk_bf16(b[2], b[3]); return w; }
__device__ __forceinline__ void unpack8(u32x4 w, f32x4& a, f32x4& b) { a = (f32x4){bf_lo(w.x), bf_hi(w.x), bf_lo(w.y), bf_hi(w.y)}; b = (f32x4){bf_lo(w.z), bf_hi(w.z), bf_lo(w.w), bf_hi(w.w)}; }
__device__ __forceinline__ float fast_sigmoid(float x) { return __builtin_amdgcn_rcpf(1.0f + __builtin_amdgcn_exp2f(-1.4426950408889634f * x)); }
__device__ __forceinline__ float fast_silu(float x) { return x * fast_sigmoid(x); }
__device__ __forceinline__ float gelu_tanh(float x) { const float t = x * (1.0f + 0.044715f * x * x); return x * __builtin_amdgcn_rcpf(1.0f + __builtin_amdgcn_exp2f(-2.302208198f * t)); }
template <class Tp> __device__ __forceinline__ Tp* as_global(GAS Tp* p) { return (Tp*)p; }
template <int K> __device__ __forceinline__ float xor_lane(float v) { return __int_as_float(__builtin_amdgcn_ds_swizzle(__float_as_int(v), (K << 10) | 0x1F)); }
__device__ __forceinline__ float wave_sum(float v) {
    v += xor_lane<1>(v); v += xor_lane<2>(v); v += xor_lane<4>(v); v += xor_lane<8>(v); v += xor_lane<16>(v);
    const auto rr = __builtin_amdgcn_permlane32_swap(__float_as_uint(v), __float_as_uint(v), false, false);
    return __uint_as_float(rr[0]) + __uint_as_float(rr[1]);
}
__device__ __forceinline__ int lane_read(int v, int srclane) { return __builtin_amdgcn_ds_bpermute(srclane << 2, v); }

constexpr int WAVEMAP_OFF = 131072 + 256;
__device__ __forceinline__ int hw_wave_key() { return (int)(__builtin_amdgcn_s_getreg((6 << 11) | 4) & 63u); }
__device__ __forceinline__ int opaque_tid() { int key_ = hw_wave_key(); asm volatile("" : "+s"(key_)); int w = *(volatile LAS int*)(unsigned long)(WAVEMAP_OFF + 4 * key_); unsigned z0 = 0u; asm volatile("" : "+v"(z0)); int l = (int)__builtin_amdgcn_mbcnt_hi(~0u, __builtin_amdgcn_mbcnt_lo(~0u, z0)); int t = (w << 6) | l; asm volatile("" : "+v"(t)); return t; }
#define XB_TMO      128
#define XB_XCNT(j)  (256  + 64 * (j))
#define XB_XSUB(j)  (1280 + 64 * (j))
#define XB_XGEN(j)  (2304 + 64 * (j))
#define XB_TOP      3328
#define XB_TOPGEN   3392
#define XCD_BAR_WORDS 3456
#define XB_SPIN_CAP (1u << 18)
__device__ __forceinline__ unsigned xb_ld(unsigned* p)              { return __hip_atomic_load(p, __ATOMIC_RELAXED, __HIP_MEMORY_SCOPE_AGENT); }
__device__ __forceinline__ unsigned xb_add(unsigned* p, unsigned v) { return __hip_atomic_fetch_add(p, v, __ATOMIC_RELAXED, __HIP_MEMORY_SCOPE_AGENT); }
__device__ __forceinline__ unsigned xb_xcc_id() { return (unsigned)__builtin_amdgcn_s_getreg((3 << 11) | 20) & 0xFu; }
#define XB_SPIN(cond, bar) do { unsigned _sp = 0; while (cond) { __builtin_amdgcn_s_sleep(1); \
    if ((++_sp & 255u) == 0u) { if (xb_ld(&(bar)[XB_TMO])) break; if (_sp > XB_SPIN_CAP) { atomicAdd(&(bar)[XB_TMO], 1u); break; } } } } while (0)
struct XcdBarrier { unsigned* bar; unsigned x; volatile LAS unsigned* st; };
__device__ __forceinline__ XcdBarrier xcd_barrier_post(unsigned* bar, volatile LAS unsigned* st) {
    XcdBarrier b; b.bar = bar; b.x = xb_xcc_id(); b.st = st;
    if (opaque_tid() == 0) (void)xb_add(&bar[XB_XCNT(b.x)], 1u);
    return b;
}
__device__ __forceinline__ void xcd_barrier_complete(unsigned* bar, unsigned x, unsigned& nloc, unsigned& nx) {
    const unsigned G = gridDim.x * gridDim.y * gridDim.z;
    unsigned sum, cnt, mine, sp = 0u;
    for (;;) {
        sum = 0u; cnt = 0u; mine = 0u;
#pragma unroll
        for (unsigned j = 0; j < 16; ++j) { const unsigned c = xb_ld(&bar[XB_XCNT(j)]); sum += c; cnt += (c > 0u) ? 1u : 0u; mine = (j == x) ? c : mine; }
        if (sum == G) break;
        __builtin_amdgcn_s_sleep(1);
        if ((++sp & 255u) == 0u) { if (xb_ld(&bar[XB_TMO])) break; if (sp > XB_SPIN_CAP) { atomicAdd(&bar[XB_TMO], 1u); break; } }
    }
    nloc = mine > 0u ? mine : 1u; nx = cnt > 0u ? cnt : 1u;
}
__device__ __forceinline__ void xcd_barrier(const XcdBarrier& b) {
    asm volatile("s_waitcnt vmcnt(0)" ::: "memory");
    __syncthreads();
    if (opaque_tid() == 0) {
        unsigned* bar = b.bar;
        __builtin_amdgcn_s_waitcnt(0);
        unsigned nloc = b.st[0], nx = b.st[1];
        if (nloc == 0u) { xcd_barrier_complete(bar, b.x, nloc, nx); b.st[0] = nloc; b.st[1] = nx; }
        const unsigned old = xb_add(&bar[XB_XSUB(b.x)], 1u);
        const unsigned gen = old / nloc;
        if (old + 1u == (gen + 1u) * nloc) {
            __builtin_amdgcn_fence(__ATOMIC_RELEASE, "agent");
            asm volatile("s_waitcnt vmcnt(0)" ::: "memory");
            const unsigned og = xb_add(&bar[XB_TOP], 1u);
            const unsigned tg = og / nx;
            if (og + 1u == (tg + 1u) * nx) xb_add(&bar[XB_TOPGEN], 1u);
            else XB_SPIN(xb_ld(&bar[XB_TOPGEN]) == tg, bar);
            __builtin_amdgcn_fence(__ATOMIC_ACQUIRE, "agent");
            xb_add(&bar[XB_XGEN(b.x)], 1u);
            asm volatile("s_waitcnt vmcnt(0)" ::: "memory");
        } else {
            XB_SPIN(xb_ld(&bar[XB_XGEN(b.x)]) == gen, bar);
            __builtin_amdgcn_fence(__ATOMIC_ACQUIRE, "agent");
            asm volatile("s_waitcnt vmcnt(0)" ::: "memory");
        }
    }
    __syncthreads();
}

namespace pg8 {
constexpr int BM = 256, BK = 64, HALF = 128, HTB = HALF * BK * 2, STAGE_BYTES = 8 * HTB;
__device__ __forceinline__ int lds_byte(int r, int c) { const int st = (r >> 4) * 2 + (c >> 5), rr = r & 15, cc = c & 31, ob = rr * 64 + cc * 2; return st * 1024 + (ob ^ (((ob >> 9) & 1) << 5)); }
__device__ __forceinline__ void stage_rc(int b, int& R, int& C) { const int st = b / 1024, sb = b % 1024, swz = sb ^ (((sb >> 9) & 1) << 5); R = (st >> 1) * 16 + swz / 64; C = (st & 1) * 32 + (swz % 64) / 2; }
__device__ __forceinline__ int perm32(int rho) { const int n = rho >> 4, i = rho & 15; return 8 * (i >> 2) + 4 * n + (i & 3); }

struct GUnit { const char* A; const char* B; int nt; int pm, pn, aux; };

__device__ __forceinline__ void tile_of(int L, int nM, int nN, int& pm, int& pn) {
    const int nwg = nM * nN; int wgid = L;
    { const int q = nwg / 8, r = nwg % 8, xcd = wgid % 8, off = wgid / 8; wgid = (xcd < r ? xcd * (q + 1) : r * (q + 1) + (xcd - r) * q) + off; }
    const int nig = 8 * nN, gid = wgid / nig, fm = gid * 8, gsz = (nM - fm) < 8 ? (nM - fm) : 8;
    pm = fm + ((wgid % nig) % gsz); pn = (wgid % nig) / gsz;
}

typedef int i32x8 __attribute__((ext_vector_type(8)));
__device__ __forceinline__ void glds_saddr(const char* gbase_, unsigned voff, unsigned ldsdst) { unsigned keep;
    const unsigned long long gb_ = (unsigned long long)gbase_; const unsigned long long gbase = ((unsigned long long)(unsigned)__builtin_amdgcn_readfirstlane((int)(gb_ >> 32)) << 32) | (unsigned)__builtin_amdgcn_readfirstlane((int)gb_);
    asm volatile("s_mov_b32 %0, m0\n\ts_mov_b32 m0, %2\n\ts_nop 0\n\tglobal_load_lds_dwordx4 %1, %3\n\ts_mov_b32 m0, %0" : "=&s"(keep) : "v"(voff), "s"(ldsdst), "s"(gbase) : "memory"); }
template <class Epi, class Sched, bool FP8 = false>
__device__ __forceinline__ void gemm_phase(LAS unsigned char* lds, const unsigned lda, const unsigned ldb, const Sched& S, const Epi& E) {
    const int tid = opaque_tid(), wid = __builtin_amdgcn_readfirstlane(tid >> 6), lane = tid & 63, wr = wid >> 2, wc = wid & 3, fr = lane & 15, fq = lane >> 4;
    unsigned voffA[2], voffB[2];
#pragma unroll
    for (int i = 0; i < 2; ++i) { int R, C; stage_rc(tid * 16 + i * 8192, R, C); const int Rb = (R & ~31) + perm32(R & 31);
        voffA[i] = (unsigned)R * lda + (unsigned)C * 2u; voffB[i] = (unsigned)Rb * ldb + (unsigned)C * 2u; }
    const size_t kstep = (size_t)(BK * 2);
    const size_t hstepA = (size_t)HALF * lda, hstepB = (size_t)HALF * ldb;
    const unsigned ldsw = (unsigned)wid * 1024u;
    const int aoff = lds_byte(wr * 64 + fr, fq * 8), boff = lds_byte(wc * 32 + fr, fq * 8);
#define PG8_SA(b, h) (((b) * 2 + (h)) * HTB)
#define PG8_SB(b, h) ((4 + (b) * 2 + (h)) * HTB)
    const unsigned ldsb = (unsigned)(unsigned long)lds + ldsw;
#define PG8_STAGE(bufoff, gbase, voff) do { _Pragma("unroll") for (int _i = 0; _i < 2; ++_i) { \
        if constexpr (FP8) glds_saddr((const char*)(gbase), (voff)[_i], (unsigned)__builtin_amdgcn_readfirstlane((int)(ldsb + (bufoff) + _i * 8192))); \
        else __builtin_amdgcn_global_load_lds((const unsigned*)((const char*)(gbase) + (voff)[_i]), (LAS unsigned*)(lds + (bufoff) + ldsw + _i * 8192), 16, 0, 0); } } while (0)
#define PG8_LDA(dst, b, h) do { _Pragma("unroll") for (int m = 0; m < 4; ++m) _Pragma("unroll") for (int k = 0; k < 2; ++k) dst[m][k] = *(const LAS bf16x8*)(lds + PG8_SA(b, h) + aoff + m * 2048 + k * 1024); } while (0)
#define PG8_LDB(dst, b, h) do { _Pragma("unroll") for (int n = 0; n < 2; ++n) _Pragma("unroll") for (int k = 0; k < 2; ++k) dst[n][k] = *(const LAS bf16x8*)(lds + PG8_SB(b, h) + boff + n * 2048 + k * 1024); } while (0)
#define PG8_CAT(x) (__builtin_bit_cast(i32x8, __builtin_shufflevector((x)[0], (x)[1], 0, 1, 2, 3, 4, 5, 6, 7, 8, 9, 10, 11, 12, 13, 14, 15)))
#define PG8_MMA(ai, bj, At, Bt) do { __builtin_amdgcn_s_setprio(1); _Pragma("unroll") for (int m = 0; m < 4; ++m) _Pragma("unroll") for (int n = 0; n < 2; ++n) { \
        if constexpr (FP8) acc[ai][bj][m][n] = __builtin_amdgcn_mfma_scale_f32_16x16x128_f8f6f4(PG8_CAT(Bt[n]), PG8_CAT(At[m]), acc[ai][bj][m][n], 0, 0, 0, 0x7F7F7F7F, 0, 0x7F7F7F7F); \
        else { _Pragma("unroll") for (int k = 0; k < 2; ++k) acc[ai][bj][m][n] = __builtin_amdgcn_mfma_f32_16x16x32_bf16(Bt[n][k], At[m][k], acc[ai][bj][m][n], 0, 0, 0); } } __builtin_amdgcn_s_setprio(0); } while (0)
#define PG8_WAIT_V(n) asm volatile("s_waitcnt vmcnt(" #n ")" ::: "memory")
#define PG8_WAIT_L(n) asm volatile("s_waitcnt lgkmcnt(" #n ")" ::: "memory")
#define PG8_BAR __builtin_amdgcn_s_barrier()
#define PG8_SCHED __builtin_amdgcn_sched_barrier(0)
    GUnit cur, nxt; int ui = 0;
    if (!S.next(0, cur)) return;
#if USE_AGPR
    { int z_ = 0; asm volatile("" : "+a"(z_)); }
#endif
    f32x4 acc[2][2][4][2];
#pragma unroll
    for (int a = 0; a < 2; ++a)
#pragma unroll
        for (int b = 0; b < 2; ++b)
#pragma unroll
            for (int m = 0; m < 4; ++m)
#pragma unroll
                for (int n = 0; n < 2; ++n) acc[a][b][m][n] = (f32x4){0.f, 0.f, 0.f, 0.f};
    bf16x8 At[4][2], B0[2][2], B1[2][2];
    const char* cA = cur.A; const char* cB = cur.B;
    PG8_STAGE(PG8_SB(0, 0), cB, voffB); PG8_STAGE(PG8_SB(0, 1), cB + hstepB, voffB); PG8_STAGE(PG8_SA(0, 0), cA, voffA); PG8_STAGE(PG8_SA(0, 1), cA + hstepA, voffA);
    if (wr == 1) PG8_BAR;
    PG8_WAIT_V(2); PG8_BAR;
    PG8_STAGE(PG8_SB(1, 0), cB + kstep, voffB); PG8_STAGE(PG8_SA(1, 0), cA + kstep, voffA); PG8_STAGE(PG8_SB(1, 1), cB + hstepB + kstep, voffB);
    PG8_WAIT_V(6); PG8_BAR;
    for (;;) {
        const bool has_next = S.next(ui + 1, nxt);
        const char* nA = has_next ? nxt.A : cA; const char* nB = has_next ? nxt.B : cB;
        const int nt = cur.nt;
        for (int t = 0; t < nt; t += 2) {
            const bool last = (t == nt - 2);
            const char* a1 = cA + (size_t)(t + 1) * kstep;
            const char* a2 = last ? nA : cA + (size_t)(t + 2) * kstep; const char* b2 = last ? nB : cB + (size_t)(t + 2) * kstep;
            const char* a3 = a2 + kstep; const char* b3 = b2 + kstep;
            PG8_LDB(B0, 0, 0); PG8_LDB(B1, 0, 1); PG8_SCHED; PG8_LDA(At, 0, 0); PG8_STAGE(PG8_SA(1, 1), a1 + hstepA, voffA);
            PG8_WAIT_V(8); PG8_WAIT_L(0); PG8_BAR; PG8_MMA(0, 0, At, B0); PG8_MMA(0, 1, At, B1); PG8_BAR; PG8_SCHED;
            PG8_LDA(At, 0, 1); PG8_STAGE(PG8_SB(0, 0), b2, voffB); PG8_STAGE(PG8_SB(0, 1), b2 + hstepB, voffB); PG8_STAGE(PG8_SA(0, 0), a2, voffA);
            PG8_WAIT_V(8); PG8_WAIT_L(0); PG8_BAR; PG8_MMA(1, 0, At, B0); PG8_MMA(1, 1, At, B1); PG8_BAR; PG8_SCHED;
            PG8_LDB(B0, 1, 0); PG8_LDB(B1, 1, 1); PG8_SCHED; PG8_LDA(At, 1, 0); PG8_STAGE(PG8_SA(0, 1), a2 + hstepA, voffA);
            PG8_WAIT_V(8); PG8_WAIT_L(0); PG8_BAR; PG8_MMA(0, 0, At, B0); PG8_MMA(0, 1, At, B1); PG8_BAR; PG8_SCHED;
            PG8_LDA(At, 1, 1); PG8_STAGE(PG8_SB(1, 0), b3, voffB); PG8_STAGE(PG8_SB(1, 1), b3 + hstepB, voffB); PG8_STAGE(PG8_SA(1, 0), a3, voffA);
            PG8_WAIT_V(8); PG8_WAIT_L(0); PG8_BAR; PG8_MMA(1, 0, At, B0); PG8_MMA(1, 1, At, B1); PG8_BAR; PG8_SCHED;
            if constexpr (Epi::HOOK) { if (E.want(t + 2)) { const int l2_ = opaque_tid() & 63; E.mid(acc, cur, t + 2, wr, wc, l2_ & 15, l2_ >> 4); } }
        }
        if (wr == 0) PG8_BAR;
        { const int l2_ = opaque_tid() & 63; E(acc, cur, wr, wc, l2_ & 15, l2_ >> 4); }
        if (!has_next) break;
#pragma unroll
        for (int a = 0; a < 2; ++a)
#pragma unroll
            for (int b = 0; b < 2; ++b)
#pragma unroll
                for (int m = 0; m < 4; ++m)
#pragma unroll
                    for (int n = 0; n < 2; ++n) acc[a][b][m][n] = (f32x4){0.f, 0.f, 0.f, 0.f};
        cur = nxt; cA = nA; cB = nB; ++ui;
        if (wr == 1) PG8_BAR;
    }
    PG8_WAIT_V(0);
    PG8_BAR;
#undef PG8_SA
#undef PG8_SB
#undef PG8_STAGE
#undef PG8_LDA
#undef PG8_LDB
#undef PG8_MMA
#undef PG8_CAT
#undef PG8_WAIT_V
#undef PG8_WAIT_L
#undef PG8_BAR
#undef PG8_SCHED
}

__device__ __forceinline__ const char* sgpr_ptr(const char* p) { const unsigned long long v = (unsigned long long)p; return (const char*)(((unsigned long long)(unsigned)__builtin_amdgcn_readfirstlane((int)(v >> 32)) << 32) | (unsigned)__builtin_amdgcn_readfirstlane((int)v)); }
struct DenseSched {
    const char* A; const char* B; unsigned lda, ldb; int nM, nN, nt, G, c, nExtra, exPm0, exPn;
    __device__ __forceinline__ bool next(int i, GUnit& u) const {
        const long L = (long)i * G + c; const int nwg = nM * nN; if (L >= nwg + nExtra) return false;
        int pm, pn; if (L < nwg) tile_of((int)L, nM, nN, pm, pn); else { pm = exPm0 + (int)(L - nwg); pn = exPn; }
        u.pm = pm; u.pn = pn; u.aux = 0; u.nt = nt; u.A = sgpr_ptr(A + (size_t)pm * 256 * lda); u.B = sgpr_ptr(B + (size_t)pn * 256 * ldb); return true;
    }
};
struct MergeSched {
    const char* A; const char* B; int nM, G, c;
    __device__ __forceinline__ bool next(int i, GUnit& u) const {
        const int tile = i / 3, seg = i - 3 * tile; const long L = (long)tile * G + c; if (L >= nM * 4) return false;
        int pm, pn; tile_of((int)L, nM, 4, pm, pn); const int koff = seg == 0 ? 0 : (seg == 1 ? 256 : 512);
        u.pm = pm; u.pn = pn; u.aux = seg; u.nt = seg == 2 ? 8 : 4; u.A = sgpr_ptr(A + (size_t)pm * 256 * 2048 + koff * 2); u.B = sgpr_ptr(B + (size_t)pn * 256 * 2048 + koff * 2); return true;
    }
};
struct MoeSched {
    const char* A; const char* B; unsigned lda, ldb; size_t estride; int nN, nt, G, c; int P[9];
    __device__ __forceinline__ bool next(int i, GUnit& u) const {
        const int nM = P[8]; const long L = (long)i * G + c; if (L >= (long)nM * nN) return false;
        int pm, pn; tile_of((int)L, nM, nN, pm, pn); int e = 0;
#pragma unroll
        for (int k = 1; k < 8; ++k) e += (pm >= P[k]) ? 1 : 0;
        u.pm = pm; u.pn = pn; u.aux = e; u.nt = nt; u.A = sgpr_ptr(A + (size_t)pm * 256 * lda); u.B = sgpr_ptr(B + (size_t)e * estride + (size_t)pn * 256 * ldb); return true;
    }
};

typedef f32x4 Acc[2][2][4][2];
struct EpiZ {
    static constexpr bool HOOK = false;
    bf16_t *ZC, *ZG, *Q, *K, *V, *G; const float* rope; float scz;
    __device__ __forceinline__ void operator()(const Acc& acc, const GUnit& u, int wr, int wc, int fr, int fq) const {
        const int pn = u.pn, row0 = u.pm * 256 + wr * 64 + fr, c8 = wc * 32 + fq * 8; const bool isx = u.pm < NPX; float sc_ = scz; asm volatile("" : "+s"(sc_));
#pragma unroll
        for (int ai = 0; ai < 2; ++ai)
#pragma unroll
            for (int m = 0; m < 4; ++m) { const int row = row0 + ai * 128 + m * 16;
                f32x4 a0 = acc[ai][0][m][0] * sc_, a1 = acc[ai][0][m][1] * sc_, b0 = acc[ai][1][m][0] * sc_, b1 = acc[ai][1][m][1] * sc_;
                if (pn < 3) { bf16_t* rp = ZC + (size_t)row * 768 + pn * 256 + c8; *(u32x4*)rp = pack8(a0, a1); *(u32x4*)(rp + 128) = pack8(b0, b1);
                } else if (pn < 5) { bf16_t* rp = ZG + (size_t)row * 512 + (pn - 3) * 256 + c8;
#pragma unroll
                    for (int j = 0; j < 4; ++j) { a0[j] = gelu_tanh(a0[j]); a1[j] = gelu_tanh(a1[j]); b0[j] = gelu_tanh(b0[j]); b1[j] = gelu_tanh(b1[j]); }
                    *(u32x4*)rp = pack8(a0, a1); *(u32x4*)(rp + 128) = pack8(b0, b1);
                } else if (pn < 8) {
                    if (pn == 7 && wc >= 2) {
                        bf16_t* vp = V + (size_t)row * 128 + (wc - 2) * 32 + fq * 8; *(u32x4*)vp = pack8(a0, a1); *(u32x4*)(vp + 64) = pack8(b0, b1);
                    } else {
                        if (isx) { const int s = row & (SEQ - 1), p = (fq < 2) ? (s >> 6) : (s & 63); const float* cs = rope + p * 16 + (fq & 1) * 8;
                            const f32x4 c0 = *(const f32x4*)cs, c1 = *(const f32x4*)(cs + 4), s0 = *(const f32x4*)(cs + 1024), s1 = *(const f32x4*)(cs + 1028);
                            const f32x4 oa0 = a0 * c0 - b0 * s0, oa1 = a1 * c1 - b1 * s1, ob0 = b0 * c0 + a0 * s0, ob1 = b1 * c1 + a1 * s1;
                            a0 = oa0; a1 = oa1; b0 = ob0; b1 = ob1; }
                        if (pn < 7) { a0 *= QSCALE; a1 *= QSCALE; b0 *= QSCALE; b1 *= QSCALE;
                            bf16_t* qp = Q + (size_t)row * 512 + ((pn - 5) * 4 + wc) * 64 + fq * 8; *(u32x4*)qp = pack8(a0, a1); *(u32x4*)(qp + 32) = pack8(b0, b1);
                        } else { bf16_t* kp = K + (size_t)row * 128 + wc * 64 + fq * 8; *(u32x4*)kp = pack8(a0, a1); *(u32x4*)(kp + 32) = pack8(b0, b1); }
                    }
                } else { bf16_t* rp = G + (size_t)row * 3072 + (pn - 8) * 256 + c8;
#pragma unroll
                    for (int j = 0; j < 4; ++j) { a0[j] = fast_sigmoid(a0[j]); a1[j] = fast_sigmoid(a1[j]); b0[j] = fast_sigmoid(b0[j]); b1[j] = fast_sigmoid(b1[j]); }
                    *(u32x4*)rp = pack8(a0, a1); *(u32x4*)(rp + 128) = pack8(b0, b1);
                }
                }
    }
};
struct EpiGate8 {
    static constexpr bool HOOK = false;
    bf16_t* G;
    __device__ __forceinline__ void operator()(const Acc& acc, const GUnit& u, int wr, int wc, int fr, int fq) const {
        const int row0 = u.pm * 256 + wr * 64 + fr, col = u.pn * 256 + wc * 32 + fq * 8; float sc = 1.0f / (A8_SCALE * W_GU_SCALE); asm volatile("" : "+s"(sc));
#pragma unroll
        for (int ai = 0; ai < 2; ++ai)
#pragma unroll
            for (int m = 0; m < 4; ++m) { bf16_t* rp = G + (size_t)(row0 + ai * 128 + m * 16) * 3072 + col;
#pragma unroll
                for (int bj = 0; bj < 2; ++bj) { f32x4 a = acc[ai][bj][m][0] * sc, b = acc[ai][bj][m][1] * sc;
#pragma unroll
                    for (int j = 0; j < 4; ++j) { a[j] = fast_sigmoid(a[j]); b[j] = fast_sigmoid(b[j]); }
                    *(u32x4*)(rp + bj * 128) = pack8(a, b); } }
    }
};
struct EpiMerge {
    static constexpr bool HOOK = false;
    const bf16_t* G; bf16_t* MIX;
    __device__ __forceinline__ void operator()(const Acc& acc, const GUnit& u, int wr, int wc, int fr, int fq) const {
        const int seg = u.aux, row0 = u.pm * 256 + wr * 64 + fr, col = u.pn * 256 + wc * 32 + fq * 8;
#pragma unroll
        for (int ai = 0; ai < 2; ++ai)
#pragma unroll
            for (int m = 0; m < 4; ++m) { const size_t row = (size_t)(row0 + ai * 128 + m * 16);
#pragma unroll
                for (int bj = 0; bj < 2; ++bj) { f32x4 g0, g1; unpack8(*(const u32x4*)(G + row * 3072 + seg * 1024 + col + bj * 128), g0, g1);
                    f32x4 v0 = g0 * acc[ai][bj][m][0], v1 = g1 * acc[ai][bj][m][1]; bf16_t* mp = MIX + row * 1024 + col + bj * 128;
                    if (seg) { f32x4 o0, o1; unpack8(*(const u32x4*)mp, o0, o1); v0 += o0; v1 += o1; }
                    *(u32x4*)mp = pack8(v0, v1); } }
    }
};
struct EpiMergeH {
    static constexpr bool HOOK = true;
    const bf16_t* G; bf16_t* MIX;
    __device__ __forceinline__ bool want(int kdone) const { return kdone == 4 || kdone == 8; }
    __device__ __forceinline__ void mid(Acc& acc, const GUnit& u, int kdone, int wr, int wc, int fr, int fq) const {
        const int seg = kdone == 4 ? 0 : 1, row0 = u.pm * 256 + wr * 64 + fr, col = u.pn * 256 + wc * 32 + fq * 8;
#pragma unroll
        for (int ai = 0; ai < 2; ++ai)
#pragma unroll
            for (int m = 0; m < 4; ++m) { const bf16_t* gp = G + (size_t)(row0 + ai * 128 + m * 16) * 3072 + seg * 1024 + col;
#pragma unroll
                for (int bj = 0; bj < 2; ++bj) { f32x4 p0, p1, n0, n1; unpack8(*(const u32x4*)(gp + bj * 128), p0, p1); unpack8(*(const u32x4*)(gp + 1024 + bj * 128), n0, n1);
#pragma unroll
                    for (int j = 0; j < 4; ++j) { acc[ai][bj][m][0][j] *= __builtin_fmaxf(p0[j], 1e-30f) * __builtin_amdgcn_rcpf(__builtin_fmaxf(n0[j], 1e-30f)); acc[ai][bj][m][1][j] *= __builtin_fmaxf(p1[j], 1e-30f) * __builtin_amdgcn_rcpf(__builtin_fmaxf(n1[j], 1e-30f)); } }
                asm volatile("" ::: "memory"); }
    }
    __device__ __forceinline__ void operator()(const Acc& acc, const GUnit& u, int wr, int wc, int fr, int fq) const {
        const int row0 = u.pm * 256 + wr * 64 + fr, col = u.pn * 256 + wc * 32 + fq * 8;
#pragma unroll
        for (int ai = 0; ai < 2; ++ai)
#pragma unroll
            for (int m = 0; m < 4; ++m) { const size_t row = (size_t)(row0 + ai * 128 + m * 16);
#pragma unroll
                for (int bj = 0; bj < 2; ++bj) { f32x4 g0, g1; unpack8(*(const u32x4*)(G + row * 3072 + 2048 + col + bj * 128), g0, g1);
#pragma unroll
                    for (int j = 0; j < 4; ++j) { g0[j] = __builtin_fmaxf(g0[j], 1e-30f); g1[j] = __builtin_fmaxf(g1[j], 1e-30f); }
                    *(u32x4*)(MIX + row * 1024 + col + bj * 128) = pack8(g0 * acc[ai][bj][m][0], g1 * acc[ai][bj][m][1]); }
                asm volatile("" ::: "memory"); }
    }
};
struct Merge12Sched {
    const char* A; const char* B; int nM, G, c;
    __device__ __forceinline__ bool next(int i, GUnit& u) const {
        const long L = (long)i * G + c; if (L >= (long)nM * 12) return false;
        int pm, pn; tile_of((int)L, nM, 12, pm, pn); const int j = pn >> 2, koff = j == 0 ? 0 : (j == 1 ? 256 : 512);
        u.pm = pm; u.pn = pn; u.aux = j; u.nt = j == 2 ? 8 : 4; u.A = sgpr_ptr(A + (size_t)pm * 256 * 2048 + koff * 2); u.B = sgpr_ptr(B + (size_t)(pn & 3) * 256 * 2048 + koff * 2); return true;
    }
};
struct EpiMerge8 {
    static constexpr bool HOOK = false;
    const bf16_t* G; unsigned char* GP;
    __device__ __forceinline__ void operator()(const Acc& acc, const GUnit& u, int wr, int wc, int fr, int fq) const {
        const int row0 = u.pm * 256 + wr * 64 + fr, col = u.pn * 256 + wc * 32 + fq * 8; float sc = GP8_SCALE; asm volatile("" : "+s"(sc));
#pragma unroll
        for (int ai = 0; ai < 2; ++ai)
#pragma unroll
            for (int m = 0; m < 4; ++m) { const unsigned row = (unsigned)(row0 + ai * 128 + m * 16);
#pragma unroll
                for (int bj = 0; bj < 2; ++bj) { f32x4 g0, g1; unpack8(*(const u32x4*)(G + (size_t)row * 3072 + col + bj * 128), g0, g1);
                    const f32x4 v0 = g0 * acc[ai][bj][m][0] * sc, v1 = g1 * acc[ai][bj][m][1] * sc;
                    u32x2 o; o.x = pk4_fp8(v0[0], v0[1], v0[2], v0[3]); o.y = pk4_fp8(v1[0], v1[1], v1[2], v1[3]);
                    *(u32x2*)(GP + row * 3072u + (unsigned)(col + bj * 128)) = o; } }
    }
};
struct EpiResid {
    static constexpr bool HOOK = false;
    const float* xin_x; const float* xin_c; float* xout_x; float* xout_c; const float* gate; float sc;
    __device__ __forceinline__ void operator()(const Acc& acc, const GUnit& u, int wr, int wc, int fr, int fq) const {
        const bool isx = u.pm < NPX; const int b = isx ? (u.pm >> 4) : 16;
        const float* xi = isx ? xin_x + (size_t)u.pm * 256 * D : xin_c + (size_t)(u.pm - NPX) * 256 * D;
        float* xo = isx ? xout_x + (size_t)u.pm * 256 * D : xout_c + (size_t)(u.pm - NPX) * 256 * D;
        const int col = u.pn * 256 + wc * 32 + fq * 8; const float* gp = gate + (size_t)b * 6 * D + col;
        f32x4 gv[2][2];
#pragma unroll
        for (int bj = 0; bj < 2; ++bj) { gv[bj][0] = *(const f32x4*)(gp + bj * 128) * sc; gv[bj][1] = *(const f32x4*)(gp + bj * 128 + 4) * sc; }
#pragma unroll
        for (int ai = 0; ai < 2; ++ai)
#pragma unroll
            for (int m = 0; m < 4; ++m) { const size_t off = (size_t)(wr * 64 + fr + ai * 128 + m * 16) * D + col;
#pragma unroll
                for (int bj = 0; bj < 2; ++bj) { const f32x4 x0 = *(const f32x4*)(xi + off + bj * 128), x1 = *(const f32x4*)(xi + off + bj * 128 + 4);
                    *(f32x4*)(xo + off + bj * 128) = x0 + gv[bj][0] * acc[ai][bj][m][0]; *(f32x4*)(xo + off + bj * 128 + 4) = x1 + gv[bj][1] * acc[ai][bj][m][1]; } }
    }
};
struct EpiGU {
    static constexpr bool HOOK = false;
    bf16_t* H; int ldh;
    __device__ __forceinline__ void operator()(const Acc& acc, const GUnit& u, int wr, int wc, int fr, int fq) const {
        const int row0 = u.pm * 256 + wr * 64 + fr, col = u.pn * 128 + wc * 32 + fq * 8;
#pragma unroll
        for (int ai = 0; ai < 2; ++ai)
#pragma unroll
            for (int m = 0; m < 4; ++m) { f32x4 a = acc[ai][0][m][0], b = acc[ai][0][m][1]; const f32x4 c = acc[ai][1][m][0], d = acc[ai][1][m][1];
#pragma unroll
                for (int j = 0; j < 4; ++j) { a[j] = fast_silu(a[j]) * c[j]; b[j] = fast_silu(b[j]) * d[j]; }
                *(u32x4*)(H + (size_t)(row0 + ai * 128 + m * 16) * ldh + col) = pack8(a, b); }
    }
};
struct EpiGU8 {
    static constexpr bool HOOK = false;
    unsigned char* H; int ldh;
    __device__ __forceinline__ void operator()(const Acc& acc, const GUnit& u, int wr, int wc, int fr, int fq) const {
        const int row0 = u.pm * 256 + wr * 64 + fr, col = u.pn * 128 + wc * 32 + fq * 8; float sc = 1.0f / (A8_SCALE * W_GU_SCALE), sch = H8_SCALE / (A8_SCALE * W_GU_SCALE);
        asm volatile("" : "+s"(sc), "+s"(sch));
#pragma unroll
        for (int ai = 0; ai < 2; ++ai)
#pragma unroll
            for (int m = 0; m < 4; ++m) { f32x4 a = acc[ai][0][m][0] * sc, b = acc[ai][0][m][1] * sc; const f32x4 c = acc[ai][1][m][0] * sch, d = acc[ai][1][m][1] * sch;
#pragma unroll
                for (int j = 0; j < 4; ++j) { a[j] = fast_silu(a[j]) * c[j]; b[j] = fast_silu(b[j]) * d[j]; }
                u32x2 o; o.x = pk4_fp8(a[0], a[1], a[2], a[3]); o.y = pk4_fp8(b[0], b[1], b[2], b[3]);
                const unsigned off = (unsigned)(row0 + ai * 128 + m * 16) * (unsigned)ldh + (unsigned)col;
                *(u32x2*)(H + off) = o; }
    }
};
struct EpiMoeDown {
    static constexpr bool HOOK = false;
    const int* rinfo; bf16_t* Y; float sc;
    __device__ __forceinline__ void operator()(const Acc& acc, const GUnit& u, int wr, int wc, int fr, int fq) const {
        const int row0 = u.pm * 256 + wr * 64 + fr, col = u.pn * 256 + wc * 32 + fq * 8;
#pragma unroll
        for (int ai = 0; ai < 2; ++ai)
#pragma unroll
            for (int m = 0; m < 4; ++m) { const int info = rinfo[row0 + ai * 128 + m * 16];
                if (info >= 0) { const unsigned t = (unsigned)info & 0xfffffu, k = ((unsigned)info >> 20) & 1u; const unsigned off = ((k * (unsigned)T + t) * (unsigned)D + (unsigned)col) * 2u;
#pragma unroll
                    for (int bj = 0; bj < 2; ++bj) *(u32x4*)((unsigned char*)Y + off + bj * 256) = pack8(acc[ai][bj][m][0] * sc, acc[ai][bj][m][1] * sc); } }
    }
};
}

namespace attn_body {
using bf16=__hip_bfloat16;
using s16x4=__attribute__((ext_vector_type(4)))short;
constexpr int D64=64,NW=8,QBLK=32,KVBLK=64;
constexpr int QP=512,KP=128,OP=1024;
__device__ __forceinline__ int crow(int r,int hi){return (r&3)+8*(r>>2)+4*hi;}
#define SBAR() __builtin_amdgcn_sched_barrier(0)
__device__ __forceinline__ void wmask(f32x16&p0,f32x16&p1,int base,int hi){
  const float NEG=-INFINITY; const int kb=base+4*hi;
  #pragma unroll
  for(int r=0;r<16;++r){const int d=kb+(r&3)+8*(r>>2); if(d>128||d<-128)p0[r]=NEG; if(d+32>128||d+32<-128)p1[r]=NEG;}
}
constexpr int NSLOT=3, SLOTB=8192;
constexpr int LDS_K=0, LDS_V=NSLOT*SLOTB, LDS_WS=2*NSLOT*SLOTB, LDS_OST=LDS_WS+NW*64*4, LDS_BYTES=LDS_OST+NW*4096;
__device__ __forceinline__ void glds16(const void*gsrc,unsigned lds_dst){unsigned keep;
  asm volatile("s_mov_b32 %0, m0\n\ts_mov_b32 m0, %2\n\ts_nop 0\n\tglobal_load_lds_dwordx4 %1, off\n\ts_mov_b32 m0, %0":"=&s"(keep):"v"(gsrc),"s"(lds_dst):"memory");}
__device__ __forceinline__ float max3f(float a,float b,float c){float r;asm("v_max3_f32 %0, %1, %2, %3":"=v"(r):"v"(a),"v"(b),"v"(c));return r;}
__device__ __forceinline__ float max2f(float a,float b){float r;asm("v_max_f32_e32 %0, %1, %2":"=v"(r):"v"(a),"v"(b));return r;}
__device__ __forceinline__ float fadd_s(float a,float b){float r;asm("v_add_f32_e32 %0, %1, %2":"=v"(r):"v"(a),"v"(b));return r;}
__device__ __forceinline__ float fsub_s(float a,float b){float r;asm("v_sub_f32_e32 %0, %1, %2":"=v"(r):"v"(a),"v"(b));return r;}
typedef float f32x2_t __attribute__((ext_vector_type(2))); typedef __bf16 bf16x2_t __attribute__((ext_vector_type(2)));
__device__ __forceinline__ unsigned cvtpk_s(float lo,float hi){f32x2_t v={lo,hi};bf16x2_t b=__builtin_convertvector(v,bf16x2_t);return __builtin_bit_cast(unsigned,b);}
#define WAIT_BAR(N) asm volatile("s_waitcnt vmcnt(" #N ") lgkmcnt(0)\n\ts_barrier":::"memory")
__device__ __forceinline__ void qkt(f32x16&p0,f32x16&p1,const char*Kslot,const bf16x8*qr,const f32x16&negm,int r32,int hi){
  const char*kb=Kslot+hi*1024+r32*16;
  #pragma unroll
  for(int d0=0;d0<4;++d0){
    const bf16x8 b0=*reinterpret_cast<const bf16x8*>(kb+d0*2048);
    const bf16x8 b1=*reinterpret_cast<const bf16x8*>(kb+d0*2048+512);
    if(d0==0){p0=__builtin_amdgcn_mfma_f32_32x32x16_bf16(b0,qr[0],negm,0,0,0);p1=__builtin_amdgcn_mfma_f32_32x32x16_bf16(b1,qr[0],negm,0,0,0);}
    else{p0=__builtin_amdgcn_mfma_f32_32x32x16_bf16(b0,qr[d0],p0,0,0,0);p1=__builtin_amdgcn_mfma_f32_32x32x16_bf16(b1,qr[d0],p1,0,0,0);}}
}
typedef __attribute__((address_space(3))) const char* lds_cptr;
typedef short v4i16_t __attribute__((ext_vector_type(4)));
__device__ __forceinline__ void kload8(bf16x8*kf,lds_cptr kp){
  kf[0]=*(const __attribute__((address_space(3))) bf16x8*)(kp);      kf[1]=*(const __attribute__((address_space(3))) bf16x8*)(kp+512);
  kf[2]=*(const __attribute__((address_space(3))) bf16x8*)(kp+2048); kf[3]=*(const __attribute__((address_space(3))) bf16x8*)(kp+2560);
  kf[4]=*(const __attribute__((address_space(3))) bf16x8*)(kp+4096); kf[5]=*(const __attribute__((address_space(3))) bf16x8*)(kp+4608);
  kf[6]=*(const __attribute__((address_space(3))) bf16x8*)(kp+6144); kf[7]=*(const __attribute__((address_space(3))) bf16x8*)(kp+6656);
}
__device__ __forceinline__ void kload2(bf16x8*kf,lds_cptr kp,int j){ kf[2*j]=*(const __attribute__((address_space(3))) bf16x8*)(kp+j*2048); kf[2*j+1]=*(const __attribute__((address_space(3))) bf16x8*)(kp+j*2048+512); }
__device__ __forceinline__ s16x4 vtr(lds_cptr p){ return __builtin_bit_cast(s16x4,__builtin_amdgcn_ds_read_tr16_b64_v4i16((__attribute__((address_space(3))) v4i16_t*)p)); }
__device__ __forceinline__ float rowmax(const f32x16&p0,const f32x16&p1){
  float a=max3f(p0[0],p0[1],p1[0]),b=max3f(p0[2],p0[3],p1[1]);a=max3f(a,p1[2],p1[3]);
  #pragma unroll
  for(int r=4;r<16;r+=4){a=max3f(a,p0[r],p0[r+1]);b=max3f(b,p0[r+2],p0[r+3]);a=max3f(a,p1[r],p1[r+1]);b=max3f(b,p1[r+2],p1[r+3]);}
  const float m=max2f(a,b);
  auto rr=__builtin_amdgcn_permlane32_swap(__float_as_uint(m),__float_as_uint(m),false,false);
  return max2f(__uint_as_float(rr[0]),__uint_as_float(rr[1]));
}
__device__ __forceinline__ void pv(f32x16*o,int vb,bf16x8 pa0,bf16x8 pa1,bf16x8 pa2,bf16x8 pa3){
  #pragma unroll
  for(int d0=0;d0<2;++d0){s16x4 lo[4],hi[4];
    #pragma unroll
    for(int ks=0;ks<4;++ks){
      asm volatile("ds_read_b64_tr_b16 %0,%1 offset:%c2":"=&v"(lo[ks]):"v"(vb),"i"(d0*4096+ks*1024):"memory");
      asm volatile("ds_read_b64_tr_b16 %0,%1 offset:%c2":"=&v"(hi[ks]):"v"(vb),"i"(d0*4096+ks*1024+512):"memory");}
    asm volatile("s_waitcnt lgkmcnt(0)":::"memory");SBAR();
    #define PK(k) (bf16x8){lo[k][0],lo[k][1],lo[k][2],lo[k][3],hi[k][0],hi[k][1],hi[k][2],hi[k][3]}
    o[d0]=__builtin_amdgcn_mfma_f32_32x32x16_bf16(pa0,PK(0),o[d0],0,0,0);
    o[d0]=__builtin_amdgcn_mfma_f32_32x32x16_bf16(pa1,PK(1),o[d0],0,0,0);
    o[d0]=__builtin_amdgcn_mfma_f32_32x32x16_bf16(pa2,PK(2),o[d0],0,0,0);
    o[d0]=__builtin_amdgcn_mfma_f32_32x32x16_bf16(pa3,PK(3),o[d0],0,0,0);
    #undef PK
  }
}
template<int THRL> __device__ __forceinline__ void attn_unit(const bf16*Qw,const bf16*__restrict__ Kc,const bf16*__restrict__ Vc,bf16*Ow,int crow0,int lrow0,int NT,int qoff0,float sink_l2,char*shm){
  const int tid=opaque_tid(),lane=tid&63,r32=lane&31,hi=lane>>5; const int wid=__builtin_amdgcn_readfirstlane(tid>>6);
  const unsigned lds0=(unsigned)(uintptr_t)shm;
  float*wsf=(float*)(shm+LDS_WS)+wid*64;
  const bf16*ksrc=Kc+(long)lane*KP+wid*8;
  const bf16*vsrc=Vc+(long)(16*(wid&3)+(lane>>2))*KP+(wid>>2)*32+(lane&3)*8;
  const unsigned kdst=lds0+LDS_K+wid*1024, vdst=lds0+LDS_V+wid*1024;
  #define TROW(t) ((long)(((t)<4)?(crow0+64*(t)):(lrow0+64*((t)-4)))*KP)
  #define DMA_K(t,slot) glds16(ksrc+TROW(t),(unsigned)__builtin_amdgcn_readfirstlane(kdst+(slot)))
  #define DMA_V(t,slot) glds16(vsrc+TROW(t),(unsigned)__builtin_amdgcn_readfirstlane(vdst+(slot)))
  const int vb0=(int)(lds0+LDS_V)+((lane>>4)&1)*32+(lane&3)*8+(4*hi+((lane&15)>>2))*64;
  const char*Kbase=shm+LDS_K; bf16x8 kf[8];
  const lds_cptr shm3=(lds_cptr)shm; const lds_cptr kp0=shm3+LDS_K+hi*1024+r32*16; const lds_cptr vp0=shm3+LDS_V+((lane>>4)&1)*32+(lane&3)*8+(4*hi+((lane&15)>>2))*64;
  DMA_K(0,0);DMA_V(0,0);DMA_K(1,SLOTB);
  bf16x8 qr[4];
  #pragma unroll
  for(int d0=0;d0<4;++d0)qr[d0]=*reinterpret_cast<const bf16x8*>(&Qw[(long)r32*QP+d0*16+hi*8]);
  float mhat=0.f,l_reg=0.f;f32x16 o[2];o[0]=f32x16{};o[1]=f32x16{};const f32x16 negm=f32x16{};
  const int qoff=qoff0+r32;
  #define CMASK(P0,P1,t) do{ if((t)>=4){ const int kb_=64*((t)-4); if(kb_-(qoff0+31)<-128||kb_+63-qoff0>128) wmask(P0,P1,kb_-qoff,hi);} }while(0)
  bool resc=false;
  #define START(P0,P1) do{ const float rm=rowmax(P0,P1); resc=false; mhat=rm; \
    _Pragma("unroll") for(int r=0;r<16;++r){P0[r]=fsub_s(P0[r],mhat);P1[r]=fsub_s(P1[r],mhat);} \
    _Pragma("unroll") for(int r=0;r<16;++r)P0[r]=__builtin_amdgcn_exp2f(P0[r]); }while(0)
  #define RESC() do{ if(resc){ asm volatile("s_waitcnt lgkmcnt(0)":::"memory"); \
      _Pragma("unroll") for(int d_=0;d_<2;++d_) _Pragma("unroll") for(int r=0;r<16;++r)o[d_][r]*=wsf[crow(r,hi)]; } }while(0)
  f32x16 pA0,pA1,pB0,pB1;
  int sl_prev=0,sl_cur=0,sl_next=SLOTB;
  #define ROT() do{sl_prev=sl_cur;sl_cur=sl_next;sl_next=(sl_next==(NSLOT-1)*SLOTB)?0:sl_next+SLOTB;}while(0)
  DMA_K(2,2*SLOTB);
  WAIT_BAR(3);
  qkt(pA0,pA1,Kbase,qr,negm,r32,hi);asm volatile("s_nop 15\n\ts_nop 7":"+v"(pA0),"+v"(pA1));
  START(pA0,pA1);
  _Pragma("unroll") for(int r=0;r<16;++r)pA1[r]=__builtin_amdgcn_exp2f(pA1[r]);
  WAIT_BAR(0);
  DMA_K(3,0);DMA_V(1,SLOTB);
  ROT();
  kload8(kf,kp0+sl_cur);
  WAIT_BAR(2);
  s16x4 vlo[8],vhi[8]; u32x4 pw0,pw1,pw2,pw3;
  #define PKW(P,B) cvtpk_s(P[B],P[B+1])
  #define PAF(k) __builtin_bit_cast(bf16x8,pw##k)
  #define VFR(i) (bf16x8){vlo[i][0],vlo[i][1],vlo[i][2],vlo[i][3],vhi[i][0],vhi[i][1],vhi[i][2],vhi[i][3]}
  #define PIN(x) asm volatile("":"+v"(x))
  #define MX3(a,b,c) __builtin_fmaxf(__builtin_fmaxf((a),(b)),(c))
  #define GAPA(MF,A0,A1,A2,A3,W0,W1,PW) do{ MF; sacc+=A0; sacc+=A1; sacc+=A2; sacc+=A3; PIN(sacc); W0; W1; PIN(PW); SBAR(); }while(0)
  #define EX(v) __builtin_amdgcn_exp2f(v)
  #define GAPB(MF,X,B) do{ MF; X[B]=EX(X[B]-mhat); X[B+1]=EX(X[B+1]-mhat); X[B+2]=EX(X[B+2]-mhat); X[B+3]=EX(X[B+3]-mhat); PIN(X); SBAR(); }while(0)
  #define VRD(i) do{ vlo[i]=vtr(vp_+(((i)>>2)*4096+((i)&3)*1024)); vhi[i]=vtr(vp_+(((i)>>2)*4096+((i)&3)*1024+512)); }while(0)
  #define KRD(G,j) do{ if(G){ kload2(kf,kp0+sl_next,j); SBAR(); } }while(0)
  #define STEP(C0,C1,P0,P1,t,GK,GV,GL) do{ SBAR(); \
    const lds_cptr vp_=vp0+sl_prev; \
    VRD(0); SBAR(); float sacc=(P0[0]+P0[1]); \
    GAPA(C0=__builtin_amdgcn_mfma_f32_32x32x16_bf16(kf[0],qr[0],negm,0,0,0), P0[2],P0[3],P0[4],P0[5],     pw0[0]=PKW(P0,0), pw0[1]=PKW(P0,2), pw0); \
    VRD(4); SBAR(); GAPA(C1=__builtin_amdgcn_mfma_f32_32x32x16_bf16(kf[1],qr[0],negm,0,0,0), P0[6],P0[7],P0[8],P0[9],     pw0[2]=PKW(P0,4), pw0[3]=PKW(P0,6), pw0); \
    VRD(1); SBAR(); GAPA(C0=__builtin_amdgcn_mfma_f32_32x32x16_bf16(kf[2],qr[1],C0,0,0,0),   P0[10],P0[11],P0[12],P0[13], pw1[0]=PKW(P0,8), pw1[1]=PKW(P0,10), pw1); \
    VRD(5); SBAR(); GAPA(C1=__builtin_amdgcn_mfma_f32_32x32x16_bf16(kf[3],qr[1],C1,0,0,0),   P0[14],P0[15],P1[0],P1[1],   pw1[2]=PKW(P0,12),pw1[3]=PKW(P0,14), pw1); \
    VRD(2); SBAR(); GAPA(C0=__builtin_amdgcn_mfma_f32_32x32x16_bf16(kf[4],qr[2],C0,0,0,0),   P1[2],P1[3],P1[4],P1[5],     pw2[0]=PKW(P1,0), pw2[1]=PKW(P1,2), pw2); \
    VRD(6); SBAR(); GAPA(C1=__builtin_amdgcn_mfma_f32_32x32x16_bf16(kf[5],qr[2],C1,0,0,0),   P1[6],P1[7],P1[8],P1[9],     pw2[2]=PKW(P1,4), pw2[3]=PKW(P1,6), pw2); \
    VRD(3); SBAR(); GAPA(C0=__builtin_amdgcn_mfma_f32_32x32x16_bf16(kf[6],qr[3],C0,0,0,0),   P1[10],P1[11],P1[12],P1[13], pw3[0]=PKW(P1,8), pw3[1]=PKW(P1,10), pw3); \
    VRD(7); SBAR(); GAPA(C1=__builtin_amdgcn_mfma_f32_32x32x16_bf16(kf[7],qr[3],C1,0,0,0),   P1[14],P1[15],0.f,0.f,       pw3[2]=PKW(P1,12),pw3[3]=PKW(P1,14), pw3); \
    l_reg+=sacc; \
    if(GK){DMA_K((t)+3,sl_cur);} if(GV){DMA_V((t)+1,sl_next);} \
    CMASK(C0,C1,t); \
    { float a=MX3(C0[0],C0[1],C1[0]),b=MX3(C0[2],C0[3],C1[1]); a=MX3(a,C1[2],C1[3]); \
      _Pragma("unroll") for(int r=4;r<16;r+=4){a=MX3(a,C0[r],C0[r+1]);b=MX3(b,C0[r+2],C0[r+3]);a=MX3(a,C1[r],C1[r+1]);b=MX3(b,C1[r+2],C1[r+3]);} \
      float rm=__builtin_fmaxf(a,b); { auto rr=__builtin_amdgcn_permlane32_swap(__float_as_uint(rm),__float_as_uint(rm),false,false); rm=__builtin_fmaxf(__uint_as_float(rr[0]),__uint_as_float(rr[1])); } \
      resc=false; \
      rm-=mhat; \
      if(__builtin_expect(__any(rm>(float)THRL),0)){ const float dl=__builtin_fmaxf(rm,0.f); mhat+=dl; \
        const float f=__builtin_amdgcn_exp2f(-dl); l_reg*=f; if(hi==0)wsf[r32]=f; resc=true; } } \
    SBAR(); \
    GAPB(o[0]=__builtin_amdgcn_mfma_f32_32x32x16_bf16(PAF(0),VFR(0),o[0],0,0,0), C0,0); \
    GAPB(o[1]=__builtin_amdgcn_mfma_f32_32x32x16_bf16(PAF(0),VFR(4),o[1],0,0,0), C0,4); \
    KRD(GL,0); GAPB(o[0]=__builtin_amdgcn_mfma_f32_32x32x16_bf16(PAF(1),VFR(1),o[0],0,0,0), C0,8); \
    KRD(GL,1); GAPB(o[1]=__builtin_amdgcn_mfma_f32_32x32x16_bf16(PAF(1),VFR(5),o[1],0,0,0), C0,12); \
    KRD(GL,2); GAPB(o[0]=__builtin_amdgcn_mfma_f32_32x32x16_bf16(PAF(2),VFR(2),o[0],0,0,0), C1,0); \
    KRD(GL,3); GAPB(o[1]=__builtin_amdgcn_mfma_f32_32x32x16_bf16(PAF(2),VFR(6),o[1],0,0,0), C1,4); \
    GAPB(o[0]=__builtin_amdgcn_mfma_f32_32x32x16_bf16(PAF(3),VFR(3),o[0],0,0,0), C1,8); \
    GAPB(o[1]=__builtin_amdgcn_mfma_f32_32x32x16_bf16(PAF(3),VFR(7),o[1],0,0,0), C1,12); \
    }while(0)
  int t=1;
  #define ENDW(tt) do{ if((tt)+3<NT){WAIT_BAR(2);} else if((tt)+2<NT){WAIT_BAR(1);} else {WAIT_BAR(0);} }while(0)
  for(;t+1<NT;t+=2){
    STEP(pB0,pB1,pA0,pA1,t,(t+3<NT),(t+1<NT),(t+1<NT));       ENDW(t);   RESC(); ROT();
    STEP(pA0,pA1,pB0,pB1,t+1,(t+4<NT),(t+2<NT),(t+2<NT));     ENDW(t+1); RESC(); ROT();
  }
  STEP(pB0,pB1,pA0,pA1,NT-1,false,false,false); RESC();
  { float sacc=pB0[0]+pB0[1]; _Pragma("unroll") for(int r=2;r<16;++r)sacc+=pB0[r]; _Pragma("unroll") for(int r=0;r<16;++r)sacc+=pB1[r]; l_reg+=sacc;
    pw0=(u32x4){PKW(pB0,0),PKW(pB0,2),PKW(pB0,4),PKW(pB0,6)};pw1=(u32x4){PKW(pB0,8),PKW(pB0,10),PKW(pB0,12),PKW(pB0,14)};pw2=(u32x4){PKW(pB1,0),PKW(pB1,2),PKW(pB1,4),PKW(pB1,6)};pw3=(u32x4){PKW(pB1,8),PKW(pB1,10),PKW(pB1,12),PKW(pB1,14)};
    SBAR(); pv(o,vb0+sl_cur,PAF(0),PAF(1),PAF(2),PAF(3)); }
  #undef PKW
  #undef PAF
  #undef VFR
  #undef PIN
  #undef MX3
  #undef GAPA
  #undef GAPB
  #undef EX
  #undef VRD
  #undef KRD
  #undef STEP
  #undef ENDW
  {auto rr=__builtin_amdgcn_permlane32_swap(__float_as_uint(l_reg),__float_as_uint(l_reg),false,false);l_reg=__uint_as_float(rr[0])+__uint_as_float(rr[1]);}
  l_reg+=__builtin_amdgcn_exp2f(sink_l2-mhat);
  if(hi==0)wsf[32+r32]=l_reg;asm volatile("s_waitcnt lgkmcnt(0)":::"memory");
  float rli[16];
  #pragma unroll
  for(int r=0;r<16;++r)rli[r]=__builtin_amdgcn_rcpf(wsf[32+crow(r,hi)]);
  { bf16*stg=(bf16*)(shm+LDS_OST)+wid*2048;
    #pragma unroll
    for(int r=0;r<16;++r){const int orow=crow(r,hi);
      #pragma unroll
      for(int d0=0;d0<2;++d0)stg[orow*64+d0*32+r32]=__float2bfloat16(o[d0][r]*rli[r]);}
    asm volatile("s_waitcnt lgkmcnt(0)":::"memory");
    #pragma unroll
    for(int i=0;i<4;++i){const int row=i*8+(lane>>3),ch=lane&7; const u32x4 v=*(const u32x4*)(stg+row*64+ch*8); *(u32x4*)(Ow+(long)row*OP+ch*8)=v;} }
  asm volatile("s_waitcnt lgkmcnt(0)\n\ts_barrier":::"memory");
  #undef TROW
  #undef DMA_K
  #undef DMA_V
  #undef CMASK
  #undef START
  #undef RESC
  #undef ROT
}
#undef SBAR
#undef WAIT_BAR
}

constexpr int NWAVES = 8, NTHREADS = 512;
constexpr int RING_BYTES = 131072;
constexpr int MISC_OFF = RING_BYTES;
constexpr int LDS_BYTES = 147456;
constexpr int CW_BAR = 4096;

struct Args { GAS const float* in[23]; GAS float* out; GAS unsigned char* ws; int ph_lo, ph_hi; };
enum { I_X = 0, I_C, I_CTX, I_CCTX, I_WMOD, I_BMOD, I_N1G, I_N2G, I_WIN, I_CONVW, I_GWS, I_GB, I_SINK, I_WBC, I_WBG, I_WBA, I_WOUT, I_FGU, I_FD, I_ROUTER, I_MGU, I_MD, I_FNG };

struct Ctx {
    LAS unsigned char* lds; int tid, lane, wave, G, wg;
    const Args __attribute__((address_space(4)))* a; GAS unsigned char* ws;
};

__device__ __forceinline__ int zmap(int n) {
    const int pn = n >> 8;
    if (pn < 5 || pn > 7) return n;
    const int half = (n >> 7) & 1, hc = n & 127, idx = hc & 31, d = (idx < 16 ? idx : idx + 16) + 16 * half;
    if (pn < 7) return 1280 + (((pn - 5) * 4 + (hc >> 5)) * 64) + d;
    if (hc < 64) return 1792 + (hc >> 5) * 64 + d;
    return 1920 + half * 64 + (hc - 64);
}
__device__ __forceinline__ int gumap(int n, int ff) { const int p = n >> 8, half = (n >> 7) & 1, hc = n & 127; return half * ff + p * 128 + hc; }
template <int MAP> __device__ __forceinline__ void transpose_item(const float* W, int Nsrc, int Ndst, bf16_t* WT, int ldwt, int koff, int ff, LAS float* scr, int item, int lane) {
    const int nblk = Ndst / 32, kb = item / nblk, nb = item % nblk, k0 = 64 * kb, n0 = 32 * nb;
    const int nd = n0 + (lane & 31); const int sc = MAP == 0 ? nd : (MAP == 1 ? zmap(nd) : gumap(nd, ff));
#pragma unroll 8
    for (int i = 0; i < 32; ++i) { const int kk = 2 * i + (lane >> 5); scr[kk * 33 + (lane & 31)] = W[(size_t)(k0 + kk) * Nsrc + sc]; }
    LDS_WAIT(); asm volatile("" ::: "memory");
    const int c = lane & 7;
#pragma unroll
    for (int j = 0; j < 4; ++j) { const int n = (lane >> 3) + 8 * j; const LAS float* s = scr + (8 * c) * 33 + n;
        u32x4 o; o.x = cvt_pk_bf16(s[0 * 33], s[1 * 33]); o.y = cvt_pk_bf16(s[2 * 33], s[3 * 33]); o.z = cvt_pk_bf16(s[4 * 33], s[5 * 33]); o.w = cvt_pk_bf16(s[6 * 33], s[7 * 33]);
        *(u32x4*)(WT + (size_t)(n0 + n) * ldwt + koff + k0 + 8 * c) = o; }
    LDS_WAIT(); asm volatile("" ::: "memory");
}
template <int MAP> __device__ __forceinline__ void transpose_item8(const float* W, int Nsrc, int Ndst, unsigned char* WT, int ldwt, int ff, float scale, LAS float* scr, int item, int lane, int koff = 0) {
    const int nblk = Ndst / 32, kb = item / nblk, nb = item % nblk, k0 = 64 * kb, n0 = 32 * nb;
    const int nd = n0 + (lane & 31); const int sc = MAP == 0 ? nd : (MAP == 1 ? zmap(nd) : gumap(nd, ff));
#pragma unroll 8
    for (int i = 0; i < 32; ++i) { const int kk = 2 * i + (lane >> 5); scr[kk * 33 + (lane & 31)] = W[(size_t)(k0 + kk) * Nsrc + sc] * scale; }
    LDS_WAIT(); asm volatile("" ::: "memory");
    const int c = lane & 3;
#pragma unroll
    for (int j = 0; j < 2; ++j) { const int n = (lane >> 2) + 16 * j; const LAS float* s = scr + (16 * c) * 33 + n;
        u32x4 o; o.x = pk4_fp8(s[0 * 33], s[1 * 33], s[2 * 33], s[3 * 33]); o.y = pk4_fp8(s[4 * 33], s[5 * 33], s[6 * 33], s[7 * 33]); o.z = pk4_fp8(s[8 * 33], s[9 * 33], s[10 * 33], s[11 * 33]); o.w = pk4_fp8(s[12 * 33], s[13 * 33], s[14 * 33], s[15 * 33]);
        *(u32x4*)(WT + (size_t)(n0 + n) * ldwt + koff + k0 + 16 * c) = o; }
    LDS_WAIT(); asm volatile("" ::: "memory");
}
template <int MAP> __device__ __forceinline__ void transpose_class8(const Ctx& F, const float* W, size_t wstride, int K, int Nsrc, int Ndst, unsigned char* WT, size_t wtstride, int ldwt, int ff, float scale, int nmat, int koff = 0) {
    LAS float* scr = (LAS float*)(F.lds + F.wave * 16384);
    const int per = (K / 64) * (Ndst / 32), total = per * nmat, gw = F.wg * NWAVES + F.wave, NGW = F.G * NWAVES;
    for (int it = gw; it < total; it += NGW) { const int mi = it / per, r = it - mi * per;
        transpose_item8<MAP>(W + (size_t)mi * wstride, Nsrc, Ndst, WT + (size_t)mi * wtstride, ldwt, ff, scale, scr, r, F.lane, koff); }
}
template <int MAP> __device__ __forceinline__ void transpose_class(const Ctx& F, const float* W, size_t wstride, int K, int Nsrc, int Ndst, bf16_t* WT, size_t wtstride, int ldwt, int koff, int ff, int nmat) {
    LAS float* scr = (LAS float*)(F.lds + F.wave * 16384);
    const int per = (K / 64) * (Ndst / 32), total = per * nmat, gw = F.wg * NWAVES + F.wave, NGW = F.G * NWAVES;
    for (int it = gw; it < total; it += NGW) { const int mi = it / per, r = it - mi * per;
        transpose_item<MAP>(W + (size_t)mi * wstride, Nsrc, Ndst, WT + (size_t)mi * wtstride, ldwt, koff, ff, scr, r, F.lane); }
}
__device__ __forceinline__ void ada_tasks(const Ctx& F) {
    LAS float* St = (LAS float*)F.lds;
    LAS float* red = (LAS float*)(F.lds + 1024 * 20 * 4);
    const float* c = as_global(F.a->in[I_C]); const float* cc = as_global(F.a->in[I_CCTX]);
    bool have = false;
    for (int task = F.wg; task < DEPTH * 96; task += F.G) {
        if (!have) { for (int i = F.tid; i < NMODR * 1024; i += NTHREADS) { const int r = i >> 10, k = i & 1023; const float v = r < 16 ? c[r * 1024 + k] : cc[k]; St[k * 20 + r] = fast_silu(v); }
            LDS_WAIT(); __syncthreads(); have = true; }
        const int layer = task / 96, n0 = (task % 96) * 64; const float* W = as_global(F.a->in[I_WMOD]) + (size_t)layer * 1024 * 6144 + n0 + F.lane;
        float accv[NMODR];
#pragma unroll
        for (int r = 0; r < NMODR; ++r) accv[r] = 0.f;
        const int kb = F.wave * 128;
#pragma unroll 4
        for (int k = 0; k < 128; ++k) { const float w = W[(size_t)(kb + k) * 6144]; const LAS float* s = St + (kb + k) * 20;
            const f32x4 s0 = *(const LAS f32x4*)s, s1 = *(const LAS f32x4*)(s + 4), s2 = *(const LAS f32x4*)(s + 8), s3 = *(const LAS f32x4*)(s + 12); const float s4 = s[16];
#pragma unroll
            for (int j = 0; j < 4; ++j) { accv[j] += s0[j] * w; accv[4 + j] += s1[j] * w; accv[8 + j] += s2[j] * w; accv[12 + j] += s3[j] * w; }
            accv[16] += s4 * w; }
#pragma unroll
        for (int r = 0; r < NMODR; ++r) red[(F.wave * NMODR + r) * 64 + F.lane] = accv[r];
        LDS_WAIT(); __syncthreads();
        for (int i = F.tid; i < NMODR * 64; i += NTHREADS) { const int r = i >> 6, l = i & 63; float s = as_global(F.a->in[I_BMOD])[layer * 6144 + n0 + l];
#pragma unroll
            for (int w = 0; w < 8; ++w) s += red[(w * NMODR + r) * 64 + l];
            ((float*)(F.ws + WS_MOD))[((size_t)layer * NMODR + r) * 6144 + n0 + l] = s; }
        LDS_WAIT(); __syncthreads();
    }
    __syncthreads();
}
__device__ __forceinline__ void prologue_phase(const Ctx& F) {
    ada_tasks(F);
    const int gt = F.wg * NTHREADS + F.tid, NGT = F.G * NTHREADS;
    if (gt < 1024) { const int pos = gt >> 4, f = gt & 15; const double ang = (double)pos * pow(10000.0, -(double)f / 16.0);
        float* rp = (float*)(F.ws + WS_ROPE); rp[gt] = (float)cos(ang); rp[1024 + gt] = (float)sin(ang); }
    { const float* s = as_global(F.a->in[I_GWS]); bf16_t* d = (bf16_t*)(F.ws + WS_GWS);
      for (int i = gt; i < DEPTH * 4 * 128 * 128 / 2; i += NGT) ((unsigned*)d)[i] = cvt_pk_bf16(s[2 * i], s[2 * i + 1]); }
#if Z8
    transpose_class8<1>(F, as_global(F.a->in[I_WIN]), (size_t)D * DIN, D, DIN, 2048, (unsigned char*)(F.ws + WS_WIN), (size_t)2048 * D, D, 0, W_GU_SCALE, DEPTH);
#else
    transpose_class<1>(F, as_global(F.a->in[I_WIN]), (size_t)D * DIN, D, DIN, 2048, (bf16_t*)(F.ws + WS_WIN), (size_t)2048 * D, D, 0, 0, DEPTH);
#endif
    transpose_class8<0>(F, as_global(F.a->in[I_WIN]) + 2048, (size_t)D * DIN, D, DIN, 3072, (unsigned char*)(F.ws + WS_WG8), (size_t)3072 * D, D, 0, W_GU_SCALE, DEPTH);
    transpose_class<0>(F, as_global(F.a->in[I_WBC]), (size_t)256 * D, 256, D, D, (bf16_t*)(F.ws + WS_WBR), (size_t)D * D, D, 0, 0, DEPTH);
    transpose_class<0>(F, as_global(F.a->in[I_WBG]), (size_t)256 * D, 256, D, D, (bf16_t*)(F.ws + WS_WBR), (size_t)D * D, D, 256, 0, DEPTH);
    transpose_class<0>(F, as_global(F.a->in[I_WBA]), (size_t)512 * D, 512, D, D, (bf16_t*)(F.ws + WS_WBR), (size_t)D * D, D, 512, 0, DEPTH);
#if MERGE8
    for (int rep3 = 0; rep3 < 3; ++rep3) transpose_class8<0>(F, as_global(F.a->in[I_WOUT]), (size_t)D * D, D, D, D, (unsigned char*)(F.ws + WS_WO8), (size_t)D * 3072, 3072, 0, W_GU_SCALE, DEPTH, rep3 * 1024);
#else
    transpose_class<0>(F, as_global(F.a->in[I_WOUT]), (size_t)D * D, D, D, D, (bf16_t*)(F.ws + WS_WO), (size_t)D * D, D, 0, 0, DEPTH);
#endif
    transpose_class<2>(F, as_global(F.a->in[I_FGU]), (size_t)D * 2 * DFF, D, 2 * DFF, 2 * DFF, (bf16_t*)(F.ws + WS_FGU), (size_t)2 * DFF * D, D, 0, DFF, 1);
    transpose_class8<2>(F, as_global(F.a->in[I_FGU]) + (size_t)D * 2 * DFF, (size_t)D * 2 * DFF, D, 2 * DFF, 2 * DFF, (unsigned char*)(F.ws + WS_FGU) + (size_t)2 * DFF * D * 2, (size_t)2 * DFF * D, D, DFF, W_GU_SCALE, 1);
    transpose_class<0>(F, as_global(F.a->in[I_FD]), (size_t)DFF * D, DFF, D, D, (bf16_t*)(F.ws + WS_FD), (size_t)D * DFF, DFF, 0, 0, 1);
    transpose_class8<0>(F, as_global(F.a->in[I_FD]) + (size_t)DFF * D, (size_t)DFF * D, DFF, D, D, (unsigned char*)(F.ws + WS_FD) + (size_t)D * DFF * 2, (size_t)D * DFF, DFF, 0, W_D_SCALE, 1);
    transpose_class8<2>(F, as_global(F.a->in[I_MGU]), (size_t)D * 2 * DFE, D, 2 * DFE, 2 * DFE, (unsigned char*)(F.ws + WS_MGU), (size_t)2 * DFE * D, D, DFE, W_GU_SCALE, 2 * NEXP);
    transpose_class8<0>(F, as_global(F.a->in[I_MD]), (size_t)DFE * D, DFE, D, D, (unsigned char*)(F.ws + WS_MD), (size_t)D * DFE, DFE, 0, W_D_SCALE, 2 * NEXP);
    __syncthreads();
}

struct NormP {
    int M, layer;
    const float* xin_x; const float* xin_c; float* xout_x; float* xout_c;
    const float* gain; int chunk;
    bf16_t* HX; unsigned char* HX8;
    const float* g2prev;
    const float* router;
};
template <bool COMBINE, bool ROUTER, bool FINAL, bool OUT8 = false, bool DUAL = false> __device__ __forceinline__ void norm_phase(const Ctx& F, const NormP& P) {
    const float* MOD = (const float*)(F.ws + WS_MOD) + (size_t)P.layer * NMODR * 6144;
    const bf16_t* Y = (const bf16_t*)(F.ws + WS_RA); const f32x2* selw = (const f32x2*)(F.ws + WS_SELW);
    int* sel_e = (int*)(F.ws + WS_SELE); f32x2* selw_o = (f32x2*)(F.ws + WS_SELW);
    LAS float* RT = (LAS float*)F.lds; LAS int* cl = (LAS int*)(F.lds + 32768);
    if (ROUTER) { for (int i = F.tid; i < 8192; i += NTHREADS) RT[i] = P.router[i]; if (F.tid < 8) cl[F.tid] = 0; LDS_WAIT(); __syncthreads(); }
    const int nr = (P.M + F.G - 1) / F.G;
    const int r0 = ROUTER ? F.wg * nr : F.wg * NWAVES, r1 = ROUTER ? ((r0 + nr < P.M) ? r0 + nr : P.M) : P.M; const int rstep = ROUTER ? NWAVES : F.G * NWAVES;
    const int l4 = F.lane * 4;
    f32x4 gn[4], sh[4], sc[4], g2[4];
#pragma unroll
    for (int j = 0; j < 4; ++j) { gn[j] = *(const f32x4*)(P.gain + 256 * j + l4); sh[j] = sc[j] = g2[j] = (f32x4){0.f, 0.f, 0.f, 0.f}; }
    int curb = -1;
    f32x4 vn[4];
    { const int row = r0 + F.wave; if (row < r1) { const float* xr = row < TX ? P.xin_x + (size_t)row * D : P.xin_c + (size_t)(row - TX) * D;
#pragma unroll
        for (int j = 0; j < 4; ++j) vn[j] = *(const f32x4*)(xr + 256 * j + l4); } }
    for (int row = r0 + F.wave; row < r1; row += rstep) {
        const bool isx = row < TX; const int b = isx ? (row >> 12) : 16;
        if (b != curb) { curb = b;
#pragma unroll
            for (int j = 0; j < 4; ++j) { if (!FINAL) { sh[j] = *(const f32x4*)(MOD + (size_t)b * 6144 + P.chunk * 1024 + 256 * j + l4); sc[j] = *(const f32x4*)(MOD + (size_t)b * 6144 + (P.chunk + 1) * 1024 + 256 * j + l4); }
                if (COMBINE) g2[j] = *(const f32x4*)(P.g2prev + (size_t)b * 6144 + 256 * j + l4); } }
        f32x4 v[4];
#pragma unroll
        for (int j = 0; j < 4; ++j) v[j] = vn[j];
        { const int nrow = row + rstep; if (nrow < r1) { const float* xr = nrow < TX ? P.xin_x + (size_t)nrow * D : P.xin_c + (size_t)(nrow - TX) * D;
#pragma unroll
            for (int j = 0; j < 4; ++j) vn[j] = *(const f32x4*)(xr + 256 * j + l4); } }
        if (COMBINE) { const f32x2 w = selw[row]; float* xo = isx ? P.xout_x + (size_t)row * D : P.xout_c + (size_t)(row - TX) * D;
#pragma unroll
            for (int j = 0; j < 4; ++j) { const u32x2 y0 = *(const u32x2*)(Y + (size_t)row * D + 256 * j + l4), y1 = *(const u32x2*)(Y + ((size_t)T + row) * D + 256 * j + l4);
                const f32x4 a = (f32x4){bf_lo(y0.x), bf_hi(y0.x), bf_lo(y0.y), bf_hi(y0.y)}, c = (f32x4){bf_lo(y1.x), bf_hi(y1.x), bf_lo(y1.y), bf_hi(y1.y)};
                v[j] += g2[j] * (a * w.x + c * w.y); if (!FINAL) *(f32x4*)(xo + 256 * j + l4) = v[j]; } }
        float ss = 0.f;
#pragma unroll
        for (int j = 0; j < 4; ++j) ss += (v[j].x * v[j].x + v[j].y * v[j].y) + (v[j].z * v[j].z + v[j].w * v[j].w);
        const float rs = 1.0f / sqrtf(wave_sum(ss) * (1.0f / D) + EPS);
        if (FINAL) { float* xo = P.xout_x + (size_t)row * D;
#pragma unroll
            for (int j = 0; j < 4; ++j) *(f32x4*)(xo + 256 * j + l4) = v[j] * rs * gn[j];
        } else {
#pragma unroll
            for (int j = 0; j < 4; ++j) { v[j] = v[j] * rs * gn[j] * (sc[j] + 1.0f) + sh[j];
                if (OUT8) *(unsigned*)((unsigned char*)P.HX + (size_t)row * D + 256 * j + l4) = pk4_fp8(v[j].x * A8_SCALE, v[j].y * A8_SCALE, v[j].z * A8_SCALE, v[j].w * A8_SCALE);
                else { u32x2 o; o.x = cvt_pk_bf16(v[j].x, v[j].y); o.y = cvt_pk_bf16(v[j].z, v[j].w); *(u32x2*)(P.HX + (size_t)row * D + 256 * j + l4) = o;
                    if (DUAL) *(unsigned*)(P.HX8 + (size_t)row * D + 256 * j + l4) = pk4_fp8(v[j].x * A8_SCALE, v[j].y * A8_SCALE, v[j].z * A8_SCALE, v[j].w * A8_SCALE); } }
            if (ROUTER) { float lg[8];
#pragma unroll
                for (int e = 0; e < 8; ++e) lg[e] = 0.f;
#pragma unroll
                for (int j = 0; j < 4; ++j)
#pragma unroll
                    for (int q = 0; q < 4; ++q) { const LAS float* rp = RT + (256 * j + l4 + q) * 8; const f32x4 ra = *(const LAS f32x4*)rp, rb = *(const LAS f32x4*)(rp + 4); const float hv = v[j][q];
#pragma unroll
                        for (int e = 0; e < 4; ++e) { lg[e] += hv * ra[e]; lg[4 + e] += hv * rb[e]; } }
#pragma unroll
                for (int e = 0; e < 8; ++e) lg[e] = wave_sum(lg[e]);
                int e0 = 0; float v0 = lg[0];
#pragma unroll
                for (int e = 1; e < 8; ++e) if (lg[e] > v0) { v0 = lg[e]; e0 = e; }
                int e1 = -1; float v1 = -INFINITY;
#pragma unroll
                for (int e = 0; e < 8; ++e) if (e != e0 && lg[e] > v1) { v1 = lg[e]; e1 = e; }
                if (F.lane == 0) { const float w0 = 1.0f / (1.0f + expf(v1 - v0)); sel_e[row] = e0 | (e1 << 8); selw_o[row] = (f32x2){w0, 1.0f - w0};
                    __hip_atomic_fetch_add(cl + e0, 1, __ATOMIC_RELAXED, __HIP_MEMORY_SCOPE_WORKGROUP); __hip_atomic_fetch_add(cl + e1, 1, __ATOMIC_RELAXED, __HIP_MEMORY_SCOPE_WORKGROUP); } }
        }
    }
    if (ROUTER) { LDS_WAIT(); __syncthreads(); if (F.tid < 8) ((int*)(F.ws + WS_CNT))[F.wg * 8 + F.tid] = cl[F.tid]; }
    __syncthreads();
}

__device__ __forceinline__ void moe_gather_phase(const Ctx& F, int M, const bf16_t* HX) {
    LAS int* sm = (LAS int*)F.lds;
    const int* cnt = (const int*)(F.ws + WS_CNT); const int* sel_e = (const int*)(F.ws + WS_SELE);
    int* rinfo = (int*)(F.ws + WS_RINFO); unsigned char* AS = (unsigned char*)(F.ws + WS_RA);
    const int nr = (M + F.G - 1) / F.G, r0 = F.wg * nr, r1 = (r0 + nr < M) ? r0 + nr : M;
    { const int e = F.wave;
      int c4[4]; int s = 0;
#pragma unroll
      for (int j = 0; j < 4; ++j) { const int w = 4 * F.lane + j; c4[j] = (w < F.G) ? cnt[w * 8 + e] : 0; s += c4[j]; }
      int incl = s;
#pragma unroll
      for (int o = 1; o < 64; o <<= 1) { const int t = lane_read(incl, F.lane >= o ? F.lane - o : F.lane); if (F.lane >= o) incl += t; }
      const int tot = __builtin_amdgcn_readlane(incl, 63); int excl = incl - s;
      if (F.lane == (F.wg >> 2)) { for (int j = 0; j < (F.wg & 3); ++j) excl += c4[j]; sm[8 + e] = excl; }
      if (F.lane == 0) sm[e] = tot; }
    LDS_WAIT(); __syncthreads();
    if (F.tid == 0) { int s = 0; for (int e = 0; e < 8; ++e) { sm[16 + e] = s; s += (sm[e] + 255) & ~255; } sm[24] = s; }
    LDS_WAIT(); __syncthreads();
    if (F.wg == 0 && F.tid < 9) ((int*)(F.ws + WS_META))[F.tid] = sm[16 + F.tid] >> 8;
    if (F.wg < 8) { const int e = F.wg, lo = sm[16 + e] + sm[e], hi = sm[17 + e]; for (int i = lo + F.tid; i < hi; i += NTHREADS) rinfo[i] = -1; }
    LAS int* pos0 = sm + 64; LAS int* pos1 = pos0 + nr;
    if (F.wave == 0) { int run[8];
#pragma unroll
        for (int e = 0; e < 8; ++e) run[e] = sm[16 + e] + sm[8 + e];
        for (int base = r0; base < r1; base += 64) { const int t = base + F.lane; const bool valid = t < r1; const int ee = valid ? sel_e[t] : 0xffff; const int e0 = ee & 0xff, e1 = (ee >> 8) & 0xff;
            int p0 = 0, p1 = 0; const unsigned long long lt = (1ull << F.lane) - 1ull;
#pragma unroll
            for (int e = 0; e < 8; ++e) { const unsigned long long m = __ballot(valid && (e0 == e || e1 == e)); const int pc = __popcll(m & lt);
                if (e0 == e) p0 = run[e] + pc; if (e1 == e) p1 = run[e] + pc; run[e] += __popcll(m); }
            if (valid) { pos0[t - r0] = p0; pos1[t - r0] = p1; rinfo[p0] = t; rinfo[p1] = t | (1 << 20); } } }
    LDS_WAIT(); __syncthreads();
    for (int p = F.wave; p < 2 * (r1 - r0); p += NWAVES) { const int tl = p >> 1, k = p & 1; const int dst = k ? pos1[tl] : pos0[tl];
        const u32x4* s = (const u32x4*)((const unsigned char*)HX + (size_t)(r0 + tl) * D); u32x4* d = (u32x4*)(AS + (size_t)dst * D);
        d[F.lane] = s[F.lane]; }
    __syncthreads();
}

constexpr int GM_PITCH = 272;
__device__ __forceinline__ void gmlp_units(const Ctx& F, int layer, int M, const bf16_t* ZG, bf16_t* Y) {
    const bf16_t* GWS = (const bf16_t*)(F.ws + WS_GWS) + (size_t)layer * 4 * 128 * 128; const float* GB = as_global(F.a->in[I_GB]) + layer * 512;
    const int g = F.wave >> 1, ph = F.wave & 1, r = F.lane & 31, h = F.lane >> 5;
    bf16x8 wf[2][8];
#pragma unroll
    for (int pt = 0; pt < 2; ++pt)
#pragma unroll
        for (int s = 0; s < 8; ++s) wf[pt][s] = *(const bf16x8*)(GWS + ((size_t)g * 128 + ph * 64 + 32 * pt + r) * 128 + 16 * s + 8 * h);
    float bsv[2];
#pragma unroll
    for (int pt = 0; pt < 2; ++pt) bsv[pt] = GB[g * 128 + ph * 64 + 32 * pt + r];
    LAS unsigned char* VT = F.lds;
    const int nchunk = M / 128;
    for (int ch = F.wg; ch < nchunk; ch += F.G) {
        const int r0 = ch * 128;
#pragma unroll
        for (int i = 0; i < 8; ++i) { const int q = 16 * F.wave + 2 * i;
            const u32x2 wa = *(const u32x2*)(ZG + (size_t)(r0 + q) * 512 + 256 + 4 * F.lane), wb = *(const u32x2*)(ZG + (size_t)(r0 + q + 1) * 512 + 256 + 4 * F.lane);
            f32x4 a = (f32x4){bf_lo(wa.x), bf_hi(wa.x), bf_lo(wa.y), bf_hi(wa.y)}, b = (f32x4){bf_lo(wb.x), bf_hi(wb.x), bf_lo(wb.y), bf_hi(wb.y)};
            const float ma = wave_sum((a.x + a.y) + (a.z + a.w)) * (1.0f / 256.0f), mb = wave_sum((b.x + b.y) + (b.z + b.w)) * (1.0f / 256.0f);
            a = a - ma; b = b - mb;
            const float va = wave_sum((a.x * a.x + a.y * a.y) + (a.z * a.z + a.w * a.w)) * (1.0f / 256.0f), vb = wave_sum((b.x * b.x + b.y * b.y) + (b.z * b.z + b.w * b.w)) * (1.0f / 256.0f);
            const float ra = 1.0f / sqrtf(va + EPS), rb = 1.0f / sqrtf(vb + EPS);
#pragma unroll
            for (int j = 0; j < 4; ++j) *(LAS unsigned*)(VT + (4 * F.lane + j) * GM_PITCH + 2 * q) = cvt_pk_bf16(a[j] * ra, b[j] * rb); }
        LDS_WAIT(); __syncthreads();
        f32x16 acc[2][2];
#pragma unroll
        for (int ct = 0; ct < 2; ++ct)
#pragma unroll
            for (int pt = 0; pt < 2; ++pt) acc[ct][pt] = f32x16{};
#pragma unroll
        for (int s = 0; s < 8; ++s)
#pragma unroll
            for (int ct = 0; ct < 2; ++ct) { const bf16x8 af = *(const LAS bf16x8*)(VT + (g * 64 + 32 * ct + r) * GM_PITCH + 32 * s + 16 * h);
#pragma unroll
                for (int pt = 0; pt < 2; ++pt) acc[ct][pt] = __builtin_amdgcn_mfma_f32_32x32x16_bf16(af, wf[pt][s], acc[ct][pt], 0, 0, 0); }
#pragma unroll
        for (int pt = 0; pt < 2; ++pt) { const size_t row = (size_t)(r0 + ph * 64 + 32 * pt + r);
#pragma unroll
            for (int ct = 0; ct < 2; ++ct)
#pragma unroll
                for (int rg = 0; rg < 4; ++rg) { const int c0 = g * 64 + 32 * ct + 8 * rg + 4 * h; const u32x2 uw = *(const u32x2*)(ZG + row * 512 + c0);
                    const float y0 = bf_lo(uw.x) * (acc[ct][pt][4 * rg + 0] + bsv[pt]), y1 = bf_hi(uw.x) * (acc[ct][pt][4 * rg + 1] + bsv[pt]);
                    const float y2 = bf_lo(uw.y) * (acc[ct][pt][4 * rg + 2] + bsv[pt]), y3 = bf_hi(uw.y) * (acc[ct][pt][4 * rg + 3] + bsv[pt]);
                    u32x2 o; o.x = cvt_pk_bf16(y0, y1); o.y = cvt_pk_bf16(y2, y3); *(u32x2*)(Y + row * D + 256 + c0) = o; } }
        LDS_WAIT(); __syncthreads();
    }
}
__device__ __forceinline__ void conv_units(const Ctx& F, int layer, int M, const bf16_t* ZC, bf16_t* Y) {
    const float* CW = as_global(F.a->in[I_CONVW]) + layer * 768;
    const int gt = F.wg * NTHREADS + F.tid, NGT = F.G * NTHREADS;
    for (int it = gt; it < M * 32; it += NGT) { const int row = it >> 5, c0 = (it & 31) * 8;
        const int s = row < TX ? (row & (SEQ - 1)) : ((row - TX) & (CTXL - 1)), L = row < TX ? SEQ : CTXL;
        const bf16_t* zp = ZC + (size_t)row * 768 + c0;
        f32x4 bg0, bg1, c0a, c0b, h0a, h0b; unpack8(*(const u32x4*)zp, bg0, bg1); unpack8(*(const u32x4*)(zp + 256), c0a, c0b); unpack8(*(const u32x4*)(zp + 512), h0a, h0b);
        const f32x4 w0a = *(const f32x4*)(CW + c0), w0b = *(const f32x4*)(CW + c0 + 4), w1a = *(const f32x4*)(CW + 256 + c0), w1b = *(const f32x4*)(CW + 256 + c0 + 4), w2a = *(const f32x4*)(CW + 512 + c0), w2b = *(const f32x4*)(CW + 512 + c0 + 4);
        f32x4 sa = w1a * (c0a * h0a), sb = w1b * (c0b * h0b);
        if (s > 0) { f32x4 ca, cb, ha, hb; unpack8(*(const u32x4*)(zp - 768 + 256), ca, cb); unpack8(*(const u32x4*)(zp - 768 + 512), ha, hb); sa += w0a * (ca * ha); sb += w0b * (cb * hb); }
        if (s < L - 1) { f32x4 ca, cb, ha, hb; unpack8(*(const u32x4*)(zp + 768 + 256), ca, cb); unpack8(*(const u32x4*)(zp + 768 + 512), ha, hb); sa += w2a * (ca * ha); sb += w2b * (cb * hb); }
        *(u32x4*)(Y + (size_t)row * D + c0) = pack8(bg0 * sa, bg1 * sb); }
}
__device__ __forceinline__ void mixer_phase(const Ctx& F, int layer, bool ctx_out) {
    GAS unsigned char* rh = F.ws + WS_RH;
    const attn_body::bf16* Q = (const attn_body::bf16*)(rh + RH_Q); const attn_body::bf16* K = (const attn_body::bf16*)(rh + RH_K); const attn_body::bf16* V = (const attn_body::bf16*)(rh + RH_V);
    attn_body::bf16* Y = (attn_body::bf16*)(rh + RH_BUFA);
    const float* sink = as_global(F.a->in[I_SINK]) + layer * 8;
    char* shm = (char*)F.lds;
    for (int uid = F.wg; uid < NB * 32 * 4; uid += F.G) {
        const int hp = uid & 3, n = (uid >> 2) & 31, b = uid >> 7, kvh = hp >> 1, head = 2 * hp + (F.wave >> 2);
        const int i_lo = n == 0 ? 2 : 0, i_hi = n == 31 ? 3 : 5, NT = 4 + (i_hi - i_lo + 1);
        const int qrow = b * SEQ + n * 128 + 32 * (F.wave & 3), lrow0 = b * SEQ + n * 128 - 128 + 64 * i_lo, crow0 = TX + b * CTXL;
        const int qoff0 = 32 * (F.wave & 3) + 128 - 64 * i_lo;
        attn_body::attn_unit<8>(Q + (size_t)qrow * 512 + head * 64, K + kvh * 64, V + kvh * 64, Y + (size_t)qrow * D + 512 + head * 64, crow0, lrow0, NT, qoff0, sink[head] * 1.4426950408889634f, shm);
    }
    if (ctx_out) for (int uid = F.wg; uid < NB * 4 * 2; uid += F.G) {
        const int hp = uid & 3, half = (uid >> 2) & 1, b = uid >> 3, kvh = hp >> 1, head = 2 * hp + (F.wave >> 2);
        const int qrow = TX + b * CTXL + half * 128 + 32 * (F.wave & 3), crow0 = TX + b * CTXL;
        attn_body::attn_unit<8>(Q + (size_t)qrow * 512 + head * 64, K + kvh * 64, V + kvh * 64, Y + (size_t)qrow * D + 512 + head * 64, crow0, 0, 4, 0, sink[head] * 1.4426950408889634f, shm);
    }
    __syncthreads();
    const int M = ctx_out ? T : TX;
#ifndef REP_GC
#define REP_GC 0
#endif
    _Pragma("nounroll") for (int rep_ = 0; rep_ < 1 + ((REP_GC >> 0) & 1); ++rep_) gmlp_units(F, layer, M, (const bf16_t*)(rh + RH_ZG), (bf16_t*)(rh + RH_BUFA));
    _Pragma("nounroll") for (int rep_ = 0; rep_ < 1 + ((REP_GC >> 1) & 1); ++rep_) conv_units(F, layer, M, (const bf16_t*)(rh + RH_ZC), (bf16_t*)(rh + RH_BUFA));
}

constexpr int NPHASES = 38;
__global__ void __launch_bounds__(NTHREADS, 2) fwd(Args args) {
    extern __shared__ __attribute__((aligned(16))) unsigned char lds_[];
    Ctx F; F.lds = (LAS unsigned char*)lds_; F.tid = threadIdx.x; F.lane = F.tid & 63; F.wave = __builtin_amdgcn_readfirstlane(F.tid >> 6); F.G = gridDim.x; F.wg = blockIdx.x; F.a = (const Args __attribute__((address_space(4)))*)__builtin_amdgcn_kernarg_segment_ptr(); F.ws = F.a->ws;
    volatile LAS unsigned* MISC = (volatile LAS unsigned*)(F.lds + MISC_OFF);
    for (int u = F.tid; u < (LDS_BYTES - MISC_OFF) / 4; u += NTHREADS) ((LAS unsigned*)(F.lds + MISC_OFF))[u] = 0u;
    __syncthreads();
    if (F.lane == 0) *(volatile LAS int*)(unsigned long)(WAVEMAP_OFF + 4 * hw_wave_key()) = F.wave;
    __syncthreads();
    XcdBarrier bar = xcd_barrier_post((unsigned*)(F.ws + WS_CTL) + CW_BAR, MISC + 8);
    const int lo = F.a->ph_lo, hi = F.a->ph_hi;
#ifndef PHMASK
#define PHMASK 0xffff
#endif
#define EN(b) ((PHMASK >> (b)) & 1)
#ifndef REP_MASK
#define REP_MASK 0
#endif
#define REPS(b) _Pragma("nounroll") for (int rep_ = 0; rep_ < (((REP_MASK >> (b)) & 1) ? 2 : 1); ++rep_)
#define IN(k) (lo <= (k) && (k) < hi)
#define SEAM(a, b) do { if (IN(a) && IN(b)) xcd_barrier(bar); } while (0)
#define REFRESH_G() do { const Args __attribute__((address_space(4)))* a_ = (const Args __attribute__((address_space(4)))*)__builtin_amdgcn_kernarg_segment_ptr(); asm volatile("" : "+s"(a_)); F.a = a_; GAS unsigned char* w_ = a_->ws; asm volatile("" : "+s"(w_)); F.ws = w_; } while (0)
#define REFRESH() do { F.tid = opaque_tid(); F.lane = F.tid & 63; F.wave = __builtin_amdgcn_readfirstlane(F.tid >> 6); const Args __attribute__((address_space(4)))* a_ = (const Args __attribute__((address_space(4)))*)__builtin_amdgcn_kernarg_segment_ptr(); asm volatile("" : "+s"(a_)); F.a = a_; GAS unsigned char* w_ = a_->ws; asm volatile("" : "+s"(w_)); F.ws = w_; } while (0)
#define rh (F.ws + WS_RH)
#define BUFA ((bf16_t*)(F.ws + WS_RH + RH_BUFA))
#define BUFB ((bf16_t*)(F.ws + WS_RH + RH_BUFB))
#define XC ((float*)(F.ws + WS_XC))
#define MODALL ((const float*)(F.ws + WS_MOD))

    if (EN(0) && IN(0)) REPS(0) { REFRESH(); prologue_phase(F); }
    SEAM(0, 1);
#pragma nounroll
    for (int i = 0; i < DEPTH; ++i) {
        const int pb = 1 + 9 * i; const bool moe = (i & 1) != 0, last = (i == DEPTH - 1); const int j = i >> 1;
        const int Mact = last ? TX : T, nMact = Mact / 256;
#define MODL (MODALL + (size_t)i * NMODR * 6144)
        if (EN(1) && IN(pb + 0)) REPS(1) { REFRESH(); NormP P; P.M = T; P.layer = i; P.xin_x = i == 0 ? as_global(F.a->in[I_X]) : as_global(F.a->out); P.xin_c = i == 0 ? as_global(F.a->in[I_CTX]) : XC; P.xout_x = as_global(F.a->out); P.xout_c = XC;
            P.gain = as_global(F.a->in[I_N1G]) + i * D; P.chunk = 0; P.HX = BUFA; P.g2prev = MODALL + (size_t)(i - 1) * NMODR * 6144 + 5 * D; P.router = nullptr;
            P.HX8 = (unsigned char*)BUFB;
            if (i == 2) norm_phase<true, false, false, false, true>(F, P); else norm_phase<false, false, false, false, true>(F, P); }
        SEAM(pb + 0, pb + 1);
        if (EN(2) && IN(pb + 1)) REPS(2) { REFRESH_G();
#if Z8
            { pg8::DenseSched S{(const char*)BUFB, (const char*)(F.ws + WS_WIN) + (size_t)i * 2048 * D, 1024u, 1024u, nMact, 8, D / 128, F.G, F.wg, last ? TC / 256 : 0, NPX, 7};
              pg8::EpiZ E{(bf16_t*)(rh + RH_ZC), (bf16_t*)(rh + RH_ZG), (bf16_t*)(rh + RH_Q), (bf16_t*)(rh + RH_K), (bf16_t*)(rh + RH_V), (bf16_t*)(rh + RH_G), (const float*)(F.ws + WS_ROPE), 1.0f / (A8_SCALE * W_GU_SCALE)};
              pg8::gemm_phase<pg8::EpiZ, pg8::DenseSched, true>(F.lds, 1024u, 1024u, S, E); }
#else
            { pg8::DenseSched S{(const char*)BUFA, (const char*)(F.ws + WS_WIN) + (size_t)i * 2048 * D * 2, 2048u, 2048u, nMact, 8, 16, F.G, F.wg, last ? TC / 256 : 0, NPX, 7};
              pg8::EpiZ E{(bf16_t*)(rh + RH_ZC), (bf16_t*)(rh + RH_ZG), (bf16_t*)(rh + RH_Q), (bf16_t*)(rh + RH_K), (bf16_t*)(rh + RH_V), (bf16_t*)(rh + RH_G), (const float*)(F.ws + WS_ROPE), 1.0f};
              pg8::gemm_phase(F.lds, 2048u, 2048u, S, E); }
#endif
            { pg8::DenseSched S{(const char*)BUFB, (const char*)(F.ws + WS_WG8) + (size_t)i * 3072 * D, 1024u, 1024u, nMact, 12, D / 128, F.G, F.wg, 0, 0, 0};
              pg8::EpiGate8 E{(bf16_t*)(rh + RH_G)};
              pg8::gemm_phase<pg8::EpiGate8, pg8::DenseSched, true>(F.lds, 1024u, 1024u, S, E); } }
        SEAM(pb + 1, pb + 2);
        if (EN(3) && IN(pb + 2)) REPS(3) { REFRESH(); mixer_phase(F, i, !last); }
        SEAM(pb + 2, pb + 3);
#if MERGE8
        if (EN(4) && IN(pb + 3)) REPS(4) { REFRESH_G(); pg8::Merge12Sched S{(const char*)BUFA, (const char*)(F.ws + WS_WBR) + (size_t)i * D * D * 2, nMact, F.G, F.wg};
            pg8::EpiMerge8 E{(const bf16_t*)(rh + RH_G), (unsigned char*)(rh + RH_GP8)};
            pg8::gemm_phase(F.lds, 2048u, 2048u, S, E); }
#else
        if (EN(4) && IN(pb + 3)) REPS(4) { REFRESH_G(); pg8::MergeSched S{(const char*)BUFA, (const char*)(F.ws + WS_WBR) + (size_t)i * D * D * 2, nMact, F.G, F.wg};
            pg8::EpiMerge E{(const bf16_t*)(rh + RH_G), BUFB};
            pg8::gemm_phase(F.lds, 2048u, 2048u, S, E); }
#endif
        SEAM(pb + 3, pb + 4);
#if MERGE8
        if (EN(5) && IN(pb + 4)) REPS(5) { REFRESH_G(); pg8::DenseSched S{(const char*)(rh + RH_GP8), (const char*)(F.ws + WS_WO8) + (size_t)i * D * 3072, 3072u, 3072u, nMact, 4, 3072 / 128, F.G, F.wg, 0, 0, 0};
            pg8::EpiResid E{i == 0 ? as_global(F.a->in[I_X]) : as_global(F.a->out), i == 0 ? as_global(F.a->in[I_CTX]) : XC, as_global(F.a->out), XC, MODL + 2 * D, 1.0f / (GP8_SCALE * W_GU_SCALE)};
            pg8::gemm_phase<pg8::EpiResid, pg8::DenseSched, true>(F.lds, 3072u, 3072u, S, E); }
#else
        if (EN(5) && IN(pb + 4)) REPS(5) { REFRESH_G(); pg8::DenseSched S{(const char*)BUFB, (const char*)(F.ws + WS_WO) + (size_t)i * D * D * 2, 2048u, 2048u, nMact, 4, 16, F.G, F.wg, 0, 0, 0};
            pg8::EpiResid E{i == 0 ? as_global(F.a->in[I_X]) : as_global(F.a->out), i == 0 ? as_global(F.a->in[I_CTX]) : XC, as_global(F.a->out), XC, MODL + 2 * D, 1.0f};
            pg8::gemm_phase(F.lds, 2048u, 2048u, S, E); }
#endif
        SEAM(pb + 4, pb + 5);
        if (EN(6) && IN(pb + 5)) REPS(6) { REFRESH(); NormP P; P.M = Mact; P.layer = i; P.xin_x = as_global(F.a->out); P.xin_c = XC; P.xout_x = as_global(F.a->out); P.xout_c = XC; P.gain = as_global(F.a->in[I_N2G]) + i * D; P.chunk = 3; P.HX = BUFA; P.g2prev = nullptr;
            P.router = as_global(F.a->in[I_ROUTER]) + (size_t)j * D * NEXP;
            if (moe) norm_phase<false, true, false, true>(F, P); else if (i == 0) norm_phase<false, false, false>(F, P); else norm_phase<false, false, false, true>(F, P); }
        if (moe) {
            SEAM(pb + 5, pb + 6);
            if (EN(7) && IN(pb + 6)) REPS(7) { REFRESH(); moe_gather_phase(F, Mact, BUFA); }
            SEAM(pb + 6, pb + 7);
            if (EN(8) && IN(pb + 7)) REPS(8) { REFRESH_G(); pg8::MoeSched S; S.A = (const char*)(F.ws + WS_RA); S.B = (const char*)(F.ws + WS_MGU) + (size_t)j * NEXP * 2 * DFE * D; S.lda = 1024u; S.ldb = 1024u; S.estride = (size_t)2 * DFE * D;
                S.nN = 2 * DFE / 256; S.nt = D / 128; S.G = F.G; S.c = F.wg;
#pragma unroll
                for (int k = 0; k < 9; ++k) S.P[k] = __builtin_amdgcn_readfirstlane(((const int*)(F.ws + WS_META))[k]);
                pg8::EpiGU8 E{(unsigned char*)rh, DFE};
                pg8::gemm_phase<pg8::EpiGU8, pg8::MoeSched, true>(F.lds, 1024u, 1024u, S, E); }
            SEAM(pb + 7, pb + 8);
            if (EN(9) && IN(pb + 8)) REPS(9) { REFRESH_G(); pg8::MoeSched S; S.A = (const char*)rh; S.B = (const char*)(F.ws + WS_MD) + (size_t)j * NEXP * D * DFE; S.lda = (unsigned)DFE; S.ldb = (unsigned)DFE; S.estride = (size_t)D * DFE;
                S.nN = 4; S.nt = DFE / 128; S.G = F.G; S.c = F.wg;
#pragma unroll
                for (int k = 0; k < 9; ++k) S.P[k] = __builtin_amdgcn_readfirstlane(((const int*)(F.ws + WS_META))[k]);
                pg8::EpiMoeDown E{(const int*)(F.ws + WS_RINFO), (bf16_t*)(F.ws + WS_RA), 1.0f / (H8_SCALE * W_D_SCALE)};
                pg8::gemm_phase<pg8::EpiMoeDown, pg8::MoeSched, true>(F.lds, (unsigned)DFE, (unsigned)DFE, S, E); }
        } else {
            SEAM(pb + 5, pb + 7);
            if (EN(10) && IN(pb + 7)) REPS(10) { REFRESH_G();
                if (i == 0) { pg8::DenseSched S{(const char*)BUFA, (const char*)(F.ws + WS_FGU), 2048u, 2048u, nMact, 2 * DFF / 256, 16, F.G, F.wg, 0, 0, 0};
                    pg8::EpiGU E{(bf16_t*)(rh + RH_HD), DFF};
                    pg8::gemm_phase(F.lds, 2048u, 2048u, S, E); }
                else { pg8::DenseSched S{(const char*)BUFA, (const char*)(F.ws + WS_FGU) + (size_t)2 * DFF * D * 2, 1024u, 1024u, nMact, 2 * DFF / 256, D / 128, F.G, F.wg, 0, 0, 0};
                    pg8::EpiGU8 E{(unsigned char*)(rh + RH_HD), DFF};
                    pg8::gemm_phase<pg8::EpiGU8, pg8::DenseSched, true>(F.lds, 1024u, 1024u, S, E); } }
            SEAM(pb + 7, pb + 8);
            if (EN(11) && IN(pb + 8)) REPS(11) { REFRESH_G();
                if (i == 0) { pg8::DenseSched S{(const char*)(rh + RH_HD), (const char*)(F.ws + WS_FD), 2u * DFF, 2u * DFF, nMact, 4, DFF / 64, F.G, F.wg, 0, 0, 0};
                    pg8::EpiResid E{as_global(F.a->out), XC, as_global(F.a->out), XC, MODL + 5 * D, 1.0f};
                    pg8::gemm_phase(F.lds, 2u * DFF, 2u * DFF, S, E); }
                else { pg8::DenseSched S{(const char*)(rh + RH_HD), (const char*)(F.ws + WS_FD) + (size_t)D * DFF * 2, (unsigned)DFF, (unsigned)DFF, nMact, 4, DFF / 128, F.G, F.wg, 0, 0, 0};
                    pg8::EpiResid E{as_global(F.a->out), XC, as_global(F.a->out), XC, MODL + 5 * D, 1.0f / (H8_SCALE * W_D_SCALE)};
                    pg8::gemm_phase<pg8::EpiResid, pg8::DenseSched, true>(F.lds, (unsigned)DFF, (unsigned)DFF, S, E); } }
        }
        SEAM(pb + 8, pb + 9);
    }
    if (EN(12) && IN(37)) REPS(12) { REFRESH(); NormP P; P.M = TX; P.layer = DEPTH - 1; P.xin_x = as_global(F.a->out); P.xin_c = XC; P.xout_x = as_global(F.a->out); P.xout_c = XC; P.gain = as_global(F.a->in[I_FNG]); P.chunk = 0; P.HX = nullptr;
        P.g2prev = MODALL + (size_t)(DEPTH - 1) * NMODR * 6144 + 5 * D; P.router = nullptr;
        norm_phase<true, false, true>(F, P); }
#undef IN
#undef SEAM
#undef rh
#undef BUFA
#undef BUFB
#undef XC
#undef MODALL
#undef MODL
}


extern "C" void kernel_launch(void* const* d_in, const int* in_sizes, int n_in, void* d_out, int out_size, void* d_ws, size_t ws_size, hipStream_t stream) {
    static int grid = 0;
    if (grid == 0) {
        if (n_in != 23 || out_size != TX * D || ws_size < WS_END) { fprintf(stderr, "kernel_launch: unexpected shapes (n_in %d, out %d, ws %zu < %zu)\n", n_in, out_size, ws_size, (size_t)WS_END); grid = -1; return; }
        int dev = 0, cus = 0, per_cu = 0;
        if (hipGetDevice(&dev) != hipSuccess || hipDeviceGetAttribute(&cus, hipDeviceAttributeMultiprocessorCount, dev) != hipSuccess) { grid = -1; return; }
        if (hipFuncSetAttribute((const void*)fwd, hipFuncAttributeMaxDynamicSharedMemorySize, LDS_BYTES) != hipSuccess) { fprintf(stderr, "kernel_launch: hipFuncSetAttribute failed\n"); grid = -1; return; }
        if (hipOccupancyMaxActiveBlocksPerMultiprocessor(&per_cu, (const void*)fwd, NTHREADS, LDS_BYTES) != hipSuccess || per_cu < 1) fprintf(stderr, "kernel_launch: occupancy query says %d\n", per_cu);
        (void)hipGetLastError();
        grid = cus > 256 ? 256 : cus;
    }
    if (grid < 0) return;
    (void)hipMemsetAsync((char*)d_ws + WS_CTL, 0, CTL_BYTES, stream);
    Args a{};
    for (int i = 0; i < 23; ++i) a.in[i] = (GAS const float*)d_in[i];
    a.out = (GAS float*)d_out; a.ws = (GAS unsigned char*)d_ws;
#if MK_MULTI
    for (int p = 0; p < NPHASES; ++p) { if (p >= 1 && p < 37) { const int i = (p - 1) / 9, k = (p - 1) % 9; if (k == 6 && !(i & 1)) continue; }
        a.ph_lo = p; a.ph_hi = p + 1; hipLaunchKernelGGL(fwd, dim3(grid), dim3(NTHREADS), LDS_BYTES, stream, a); }
#else
    a.ph_lo = 0; a.ph_hi = NPHASES;
    hipLaunchKernelGGL(fwd, dim3(grid), dim3(NTHREADS), LDS_BYTES, stream, a);
#endif
    const hipError_t le = hipPeekAtLastError();
    if (le != hipSuccess) fprintf(stderr, "kernel_launch: launch failed: %s\n", hipGetErrorName(le));
}
```

```cpp
#include <hip/hip_runtime.h>
#include <hip/hip_bf16.h>
#include <cstdio>
#include <cstdint>

#ifndef USE_AGPR
#define USE_AGPR 0
#endif
#ifndef Z8
#define Z8 0
#endif
#ifndef MERGE8
#define MERGE8 0
#endif
#ifndef MK_MULTI
#define MK_MULTI 0
#endif

constexpr int D = 1024, NB = 16, SEQ = 4096, CTXL = 256, DEPTH = 4;
constexpr int TX = NB * SEQ, TC = NB * CTXL, T = TX + TC;
constexpr int DIN = 5120, DFF = 2816, DFE = 3584, NEXP = 8, NMODR = 17;
constexpr int NPX = TX / 256, NPA = T / 256;
constexpr int SROWS = 2 * T + 2048;
constexpr float EPS = 1e-6f;
constexpr float QSCALE = 0.125f * 1.4426950408889634f;
constexpr float A8_SCALE = 8.0f, W_GU_SCALE = 64.0f, H8_SCALE = 4.0f, W_D_SCALE = 128.0f, GP8_SCALE = 16.0f;

constexpr size_t al256(size_t x) { return (x + 255) & ~(size_t)255; }
constexpr size_t WS_CTL = 0, CTL_BYTES = 1u << 20;
constexpr size_t WS_MOD = WS_CTL + CTL_BYTES;
constexpr size_t WS_ROPE = WS_MOD + al256((size_t)DEPTH * NMODR * 6 * D * 4);
constexpr size_t WS_GWS = WS_ROPE + 8192;
constexpr size_t WS_SELE = WS_GWS + (size_t)DEPTH * 4 * 128 * 128 * 2;
constexpr size_t WS_SELW = WS_SELE + al256((size_t)T * 4);
constexpr size_t WS_CNT = WS_SELW + al256((size_t)T * 8);
constexpr size_t WS_META = WS_CNT + 8192;
constexpr size_t WS_RINFO = WS_META + 256;
constexpr size_t WS_XC = WS_RINFO + al256((size_t)SROWS * 4);
constexpr size_t WS_WIN = WS_XC + (size_t)TC * D * 4;
constexpr size_t WS_WG8 = WS_WIN + (size_t)DEPTH * 2048 * D * 2;
constexpr size_t WS_WO8 = WS_WG8 + (size_t)DEPTH * 3072 * D;
static_assert(WS_WO8 + (size_t)DEPTH * D * 3072 <= WS_WIN + (size_t)DEPTH * DIN * D * 2, "fp8 copies fit the w_in region");
constexpr size_t WS_WBR = WS_WIN + (size_t)DEPTH * DIN * D * 2;
constexpr size_t WS_WO = WS_WBR + (size_t)DEPTH * D * D * 2;
constexpr size_t WS_FGU = WS_WO + (size_t)DEPTH * D * D * 2;
constexpr size_t WS_FD = WS_FGU + (size_t)2 * 2 * DFF * D * 2;
constexpr size_t WS_MGU = WS_FD + (size_t)2 * D * DFF * 2;
constexpr size_t WS_MD = WS_MGU + (size_t)2 * NEXP * 2 * DFE * D;
constexpr size_t WS_RA = WS_MD + (size_t)2 * NEXP * D * DFE;
constexpr size_t RA_BYTES = (size_t)SROWS * D * 2;
constexpr size_t WS_RH = WS_RA + RA_BYTES;
constexpr size_t RH_BYTES = (size_t)SROWS * DFE * 2;
constexpr size_t WS_END = WS_RH + RH_BYTES;
static_assert((size_t)2 * T * D * 2 <= RA_BYTES, "Yslot fits region A");
static_assert(WS_END <= (size_t)1879048192, "d_ws map exceeds 4x largest tensor");
constexpr size_t RH_ZC = 0;
constexpr size_t RH_ZG = RH_ZC + (size_t)T * 768 * 2;
constexpr size_t RH_Q = RH_ZG + (size_t)T * 512 * 2;
constexpr size_t RH_K = RH_Q + (size_t)T * 512 * 2;
constexpr size_t RH_V = RH_K + (size_t)T * 128 * 2;
constexpr size_t RH_G = RH_V + (size_t)T * 128 * 2;
constexpr size_t RH_ZEND = RH_G + (size_t)T * 3072 * 2;
constexpr size_t RH_BUFA = RH_ZEND;
constexpr size_t RH_BUFB = RH_BUFA + (size_t)T * D * 2;
constexpr size_t RH_GP8 = 0;
static_assert((size_t)T * 3072 <= RH_G, "gated products fit below the gates");
constexpr size_t RH_HD = 0;
static_assert(RH_BUFB + (size_t)T * D * 2 <= RH_BYTES && (size_t)T * DFF * 2 <= RH_ZEND, "region H overlays");

#define LAS __attribute__((address_space(3)))
#define GAS __attribute__((address_space(1)))
typedef unsigned short bf16_t;
typedef short bf16x8 __attribute__((ext_vector_type(8)));
typedef float f32x4 __attribute__((ext_vector_type(4)));
typedef float f32x2 __attribute__((ext_vector_type(2)));
typedef float f32x16 __attribute__((ext_vector_type(16)));
typedef unsigned u32x4 __attribute__((ext_vector_type(4)));
typedef unsigned u32x2 __attribute__((ext_vector_type(2)));
#define LDS_WAIT() asm volatile("s_waitcnt lgkmcnt(0)" ::: "memory")
#define VM_WAIT() asm volatile("s_waitcnt vmcnt(0)" ::: "memory")

typedef __bf16 bf16x2_v __attribute__((ext_vector_type(2)));
__device__ __forceinline__ unsigned cvt_pk_bf16(float lo, float hi) { const f32x2 v = {lo, hi}; const bf16x2_v b = __builtin_convertvector(v, bf16x2_v); return __builtin_bit_cast(unsigned, b); }
__device__ __forceinline__ float clamp8(float v) { return __builtin_fminf(__builtin_fmaxf(v, -448.0f), 448.0f); }
__device__ __forceinline__ unsigned pk4_fp8(float a, float b, float c, float d) { int w = 0; w = __builtin_amdgcn_cvt_pk_fp8_f32(clamp8(a), clamp8(b), w, false); w = __builtin_amdgcn_cvt_pk_fp8_f32(clamp8(c), clamp8(d), w, true); return (unsigned)w; }
__device__ __forceinline__ float bf_lo(unsigned u) { return __uint_as_float(u << 16); }
__device__ __forceinline__ float bf_hi(unsigned u) { return __uint_as_float(u & 0xffff0000u); }
__device__ __forceinline__ u32x4 pack8(f32x4 a, f32x4 b) { u32x4 w; w.x = cvt_pk_bf16(a[0], a[1]); w.y = cvt_pk_bf16(a[2], a[3]); w.z = cvt_pk_bf16(b[0], b[1]); w.w = cvt_pk_bf16(b[2], b[3]); return w; }
__device__ __forceinline__ void unpack8(u32x4 w, f32x4& a, f32x4& b) { a = (f32x4){bf_lo(w.x), bf_hi(w.x), bf_lo(w.y), bf_hi(w.y)}; b = (f32x4){bf_lo(w.z), bf_hi(w.z), bf_lo(w.w), bf_hi(w.w)}; }
__device__ __forceinline__ float fast_sigmoid(float x) { return __builtin_amdgcn_rcpf(1.0f + __builtin_amdgcn_exp2f(-1.4426950408889634f * x)); }
__device__ __forceinline__ float fast_silu(float x) { return x * fast_sigmoid(x); }
__device__ __forceinline__ float gelu_tanh(float x) { const float t = x * (1.0f + 0.044715f * x * x); return x * __builtin_amdgcn_rcpf(1.0f + __builtin_amdgcn_exp2f(-2.302208198f * t)); }
template <class Tp> __device__ __forceinline__ Tp* as_global(GAS Tp* p) { return (Tp*)p; }
template <int K> __device__ __forceinline__ float xor_lane(float v) { return __int_as_float(__builtin_amdgcn_ds_swizzle(__float_as_int(v), (K << 10) | 0x1F)); }
__device__ __forceinline__ float wave_sum(float v) {
    v += xor_lane<1>(v); v += xor_lane<2>(v); v += xor_lane<4>(v); v += xor_lane<8>(v); v += xor_lane<16>(v);
    const auto rr = __builtin_amdgcn_permlane32_swap(__float_as_uint(v), __float_as_uint(v), false, false);
    return __uint_as_float(rr[0]) + __uint_as_float(rr[1]);
}
__device__ __forceinline__ int lane_read(int v, int srclane) { return __builtin_amdgcn_ds_bpermute(srclane << 2, v); }

constexpr int WAVEMAP_OFF = 131072 + 256;
__device__ __forceinline__ int hw_wave_key() { return (int)(__builtin_amdgcn_s_getreg((6 << 11) | 4) & 63u); }
__device__ __forceinline__ int opaque_tid() { int key_ = hw_wave_key(); asm volatile("" : "+s"(key_)); int w = *(volatile LAS int*)(unsigned long)(WAVEMAP_OFF + 4 * key_); unsigned z0 = 0u; asm volatile("" : "+v"(z0)); int l = (int)__builtin_amdgcn_mbcnt_hi(~0u, __builtin_amdgcn_mbcnt_lo(~0u, z0)); int t = (w << 6) | l; asm volatile("" : "+v"(t)); return t; }
#define XB_TMO      128
#define XB_XCNT(j)  (256  + 64 * (j))
#define XB_XSUB(j)  (1280 + 64 * (j))
#define XB_XGEN(j)  (2304 + 64 * (j))
#define XB_TOP      3328
#define XB_TOPGEN   3392
#define XCD_BAR_WORDS 3456
#define XB_SPIN_CAP (1u << 18)
__device__ __forceinline__ unsigned xb_ld(unsigned* p)              { return __hip_atomic_load(p, __ATOMIC_RELAXED, __HIP_MEMORY_SCOPE_AGENT); }
__device__ __forceinline__ unsigned xb_add(unsigned* p, unsigned v) { return __hip_atomic_fetch_add(p, v, __ATOMIC_RELAXED, __HIP_MEMORY_SCOPE_AGENT); }
__device__ __forceinline__ unsigned xb_xcc_id() { return (unsigned)__builtin_amdgcn_s_getreg((3 << 11) | 20) & 0xFu; }
#define XB_SPIN(cond, bar) do { unsigned _sp = 0; while (cond) { __builtin_amdgcn_s_sleep(1); \
    if ((++_sp & 255u) == 0u) { if (xb_ld(&(bar)[XB_TMO])) break; if (_sp > XB_SPIN_CAP) { atomicAdd(&(bar)[XB_TMO], 1u); break; } } } } while (0)
struct XcdBarrier { unsigned* bar; unsigned x; volatile LAS unsigned* st; };
__device__ __forceinline__ XcdBarrier xcd_barrier_post(unsigned* bar, volatile LAS unsigned* st) {
    XcdBarrier b; b.bar = bar; b.x = xb_xcc_id(); b.st = st;
    if (opaque_tid() == 0) (void)xb_add(&bar[XB_XCNT(b.x)], 1u);
    return b;
}
__device__ __forceinline__ void xcd_barrier_complete(unsigned* bar, unsigned x, unsigned& nloc, unsigned& nx) {
    const unsigned G = gridDim.x * gridDim.y * gridDim.z;
    unsigned sum, cnt, mine, sp = 0u;
    for (;;) {
        sum = 0u; cnt = 0u; mine = 0u;
#pragma unroll
        for (unsigned j = 0; j < 16; ++j) { const unsigned c = xb_ld(&bar[XB_XCNT(j)]); sum += c; cnt += (c > 0u) ? 1u : 0u; mine = (j == x) ? c : mine; }
        if (sum == G) break;
        __builtin_amdgcn_s_sleep(1);
        if ((++sp & 255u) == 0u) { if (xb_ld(&bar[XB_TMO])) break; if (sp > XB_SPIN_CAP) { atomicAdd(&bar[XB_TMO], 1u); break; } }
    }
    nloc = mine > 0u ? mine : 1u; nx = cnt > 0u ? cnt : 1u;
}
__device__ __forceinline__ void xcd_barrier(const XcdBarrier& b) {
    asm volatile("s_waitcnt vmcnt(0)" ::: "memory");
    __syncthreads();
    if (opaque_tid() == 0) {
        unsigned* bar = b.bar;
        __builtin_amdgcn_s_waitcnt(0);
        unsigned nloc = b.st[0], nx = b.st[1];
        if (nloc == 0u) { xcd_barrier_complete(bar, b.x, nloc, nx); b.st[0] = nloc; b.st[1] = nx; }
        const unsigned old = xb_add(&bar[XB_XSUB(b.x)], 1u);
        const unsigned gen = old / nloc;
        if (old + 1u == (gen + 1u) * nloc) {
            __builtin_amdgcn_fence(__ATOMIC_RELEASE, "agent");
            asm volatile("s_waitcnt vmcnt(0)" ::: "memory");
            const unsigned og = xb_add(&bar[XB_TOP], 1u);
            const unsigned tg = og / nx;
            if (og + 1u == (tg + 1u) * nx) xb_add(&bar[XB_TOPGEN], 1u);
            else XB_SPIN(xb_ld(&bar[XB_TOPGEN]) == tg, bar);
            __builtin_amdgcn_fence(__ATOMIC_ACQUIRE, "agent");
            xb_add(&bar[XB_XGEN(b.x)], 1u);
            asm volatile("s_waitcnt vmcnt(0)" ::: "memory");
        } else {
            XB_SPIN(xb_ld(&bar[XB_XGEN(b.x)]) == gen, bar);
            __builtin_amdgcn_fence(__ATOMIC_ACQUIRE, "agent");
            asm volatile("s_waitcnt vmcnt(0)" ::: "memory");
        }
    }
    __syncthreads();
}

namespace pg8 {
constexpr int BM = 256, BK = 64, HALF = 128, HTB = HALF * BK * 2, STAGE_BYTES = 8 * HTB;
__device__ __forceinline__ int lds_byte(int r, int c) { const int st = (r >> 4) * 2 + (c >> 5), rr = r & 15, cc = c & 31, ob = rr * 64 + cc * 2; return st * 1024 + (ob ^ (((ob >> 9) & 1) << 5)); }
__device__ __forceinline__ void stage_rc(int b, int& R, int& C) { const int st = b / 1024, sb = b % 1024, swz = sb ^ (((sb >> 9) & 1) << 5); R = (st >> 1) * 16 + swz / 64; C = (st & 1) * 32 + (swz % 64) / 2; }
__device__ __forceinline__ int perm32(int rho) { const int n = rho >> 4, i = rho & 15; return 8 * (i >> 2) + 4 * n + (i & 3); }

struct GUnit { const char* A; const char* B; int nt; int pm, pn, aux; };

__device__ __forceinline__ void tile_of(int L, int nM, int nN, int& pm, int& pn) {
    const int nwg = nM * nN; int wgid = L;
    { const int q = nwg / 8, r = nwg % 8, xcd = wgid % 8, off = wgid / 8; wgid = (xcd < r ? xcd * (q + 1) : r * (q + 1) + (xcd - r) * q) + off; }
    const int nig = 8 * nN, gid = wgid / nig, fm = gid * 8, gsz = (nM - fm) < 8 ? (nM - fm) : 8;
    pm = fm + ((wgid % nig) % gsz); pn = (wgid % nig) / gsz;
}

typedef int i32x8 __attribute__((ext_vector_type(8)));
__device__ __forceinline__ void glds_saddr(const char* gbase_, unsigned voff, unsigned ldsdst) { unsigned keep;
    const unsigned long long gb_ = (unsigned long long)gbase_; const unsigned long long gbase = ((unsigned long long)(unsigned)__builtin_amdgcn_readfirstlane((int)(gb_ >> 32)) << 32) | (unsigned)__builtin_amdgcn_readfirstlane((int)gb_);
    asm volatile("s_mov_b32 %0, m0\n\ts_mov_b32 m0, %2\n\ts_nop 0\n\tglobal_load_lds_dwordx4 %1, %3\n\ts_mov_b32 m0, %0" : "=&s"(keep) : "v"(voff), "s"(ldsdst), "s"(gbase) : "memory"); }
template <class Epi, class Sched, bool FP8 = false>
__device__ __forceinline__ void gemm_phase(LAS unsigned char* lds, const unsigned lda, const unsigned ldb, const Sched& S, const Epi& E) {
    const int tid = opaque_tid(), wid = __builtin_amdgcn_readfirstlane(tid >> 6), lane = tid & 63, wr = wid >> 2, wc = wid & 3, fr = lane & 15, fq = lane >> 4;
    unsigned voffA[2], voffB[2];
#pragma unroll
    for (int i = 0; i < 2; ++i) { int R, C; stage_rc(tid * 16 + i * 8192, R, C); const int Rb = (R & ~31) + perm32(R & 31);
        voffA[i] = (unsigned)R * lda + (unsigned)C * 2u; voffB[i] = (unsigned)Rb * ldb + (unsigned)C * 2u; }
    const size_t kstep = (size_t)(BK * 2);
    const size_t hstepA = (size_t)HALF * lda, hstepB = (size_t)HALF * ldb;
    const unsigned ldsw = (unsigned)wid * 1024u;
    const int aoff = lds_byte(wr * 64 + fr, fq * 8), boff = lds_byte(wc * 32 + fr, fq * 8);
#define PG8_SA(b, h) (((b) * 2 + (h)) * HTB)
#define PG8_SB(b, h) ((4 + (b) * 2 + (h)) * HTB)
    const unsigned ldsb = (unsigned)(unsigned long)lds + ldsw;
#define PG8_STAGE(bufoff, gbase, voff) do { _Pragma("unroll") for (int _i = 0; _i < 2; ++_i) { \
        if constexpr (FP8) glds_saddr((const char*)(gbase), (voff)[_i], (unsigned)__builtin_amdgcn_readfirstlane((int)(ldsb + (bufoff) + _i * 8192))); \
        else __builtin_amdgcn_global_load_lds((const unsigned*)((const char*)(gbase) + (voff)[_i]), (LAS unsigned*)(lds + (bufoff) + ldsw + _i * 8192), 16, 0, 0); } } while (0)
#define PG8_LDA(dst, b, h) do { _Pragma("unroll") for (int m = 0; m < 4; ++m) _Pragma("unroll") for (int k = 0; k < 2; ++k) dst[m][k] = *(const LAS bf16x8*)(lds + PG8_SA(b, h) + aoff + m * 2048 + k * 1024); } while (0)
#define PG8_LDB(dst, b, h) do { _Pragma("unroll") for (int n = 0; n < 2; ++n) _Pragma("unroll") for (int k = 0; k < 2; ++k) dst[n][k] = *(const LAS bf16x8*)(lds + PG8_SB(b, h) + boff + n * 2048 + k * 1024); } while (0)
#define PG8_CAT(x) (__builtin_bit_cast(i32x8, __builtin_shufflevector((x)[0], (x)[1], 0, 1, 2, 3, 4, 5, 6, 7, 8, 9, 10, 11, 12, 13, 14, 15)))
#define PG8_MMA(ai, bj, At, Bt) do { __builtin_amdgcn_s_setprio(1); _Pragma("unroll") for (int m = 0; m < 4; ++m) _Pragma("unroll") for (int n = 0; n < 2; ++n) { \
        if constexpr (FP8) acc[ai][bj][m][n] = __builtin_amdgcn_mfma_scale_f32_16x16x128_f8f6f4(PG8_CAT(Bt[n]), PG8_CAT(At[m]), acc[ai][bj][m][n], 0, 0, 0, 0x7F7F7F7F, 0, 0x7F7F7F7F); \
        else { _Pragma("unroll") for (int k = 0; k < 2; ++k) acc[ai][bj][m][n] = __builtin_amdgcn_mfma_f32_16x16x32_bf16(Bt[n][k], At[m][k], acc[ai][bj][m][n], 0, 0, 0); } } __builtin_amdgcn_s_setprio(0); } while (0)
#define PG8_WAIT_V(n) asm volatile("s_waitcnt vmcnt(" #n ")" ::: "memory")
#define PG8_WAIT_L(n) asm volatile("s_waitcnt lgkmcnt(" #n ")" ::: "memory")
#define PG8_BAR __builtin_amdgcn_s_barrier()
#define PG8_SCHED __builtin_amdgcn_sched_barrier(0)
    GUnit cur, nxt; int ui = 0;
    if (!S.next(0, cur)) return;
#if USE_AGPR
    { int z_ = 0; asm volatile("" : "+a"(z_)); }
#endif
    f32x4 acc[2][2][4][2];
#pragma unroll
    for (int a = 0; a < 2; ++a)
#pragma unroll
        for (int b = 0; b < 2; ++b)
#pragma unroll
            for (int m = 0; m < 4; ++m)
#pragma unroll
                for (int n = 0; n < 2; ++n) acc[a][b][m][n] = (f32x4){0.f, 0.f, 0.f, 0.f};
    bf16x8 At[4][2], B0[2][2], B1[2][2];
    const char* cA = cur.A; const char* cB = cur.B;
    PG8_STAGE(PG8_SB(0, 0), cB, voffB); PG8_STAGE(PG8_SB(0, 1), cB + hstepB, voffB); PG8_STAGE(PG8_SA(0, 0), cA, voffA); PG8_STAGE(PG8_SA(0, 1), cA + hstepA, voffA);
    if (wr == 1) PG8_BAR;
    PG8_WAIT_V(2); PG8_BAR;
    PG8_STAGE(PG8_SB(1, 0), cB + kstep, voffB); PG8_STAGE(PG8_SA(1, 0), cA + kstep, voffA); PG8_STAGE(PG8_SB(1, 1), cB + hstepB + kstep, voffB);
    PG8_WAIT_V(6); PG8_BAR;
    for (;;) {
        const bool has_next = S.next(ui + 1, nxt);
        const char* nA = has_next ? nxt.A : cA; const char* nB = has_next ? nxt.B : cB;
        const int nt = cur.nt;
        for (int t = 0; t < nt; t += 2) {
            const bool last = (t == nt - 2);
            const char* a1 = cA + (size_t)(t + 1) * kstep;
            const char* a2 = last ? nA : cA + (size_t)(t + 2) * kstep; const char* b2 = last ? nB : cB + (size_t)(t + 2) * kstep;
            const char* a3 = a2 + kstep; const char* b3 = b2 + kstep;
            PG8_LDB(B0, 0, 0); PG8_LDB(B1, 0, 1); PG8_SCHED; PG8_LDA(At, 0, 0); PG8_STAGE(PG8_SA(1, 1), a1 + hstepA, voffA);
            PG8_WAIT_V(8); PG8_WAIT_L(0); PG8_BAR; PG8_MMA(0, 0, At, B0); PG8_MMA(0, 1, At, B1); PG8_BAR; PG8_SCHED;
            PG8_LDA(At, 0, 1); PG8_STAGE(PG8_SB(0, 0), b2, voffB); PG8_STAGE(PG8_SB(0, 1), b2 + hstepB, voffB); PG8_STAGE(PG8_SA(0, 0), a2, voffA);
            PG8_WAIT_V(8); PG8_WAIT_L(0); PG8_BAR; PG8_MMA(1, 0, At, B0); PG8_MMA(1, 1, At, B1); PG8_BAR; PG8_SCHED;
            PG8_LDB(B0, 1, 0); PG8_LDB(B1, 1, 1); PG8_SCHED; PG8_LDA(At, 1, 0); PG8_STAGE(PG8_SA(0, 1), a2 + hstepA, voffA);
            PG8_WAIT_V(8); PG8_WAIT_L(0); PG8_BAR; PG8_MMA(0, 0, At, B0); PG8_MMA(0, 1, At, B1); PG8_BAR; PG8_SCHED;
            PG8_LDA(At, 1, 1); PG8_STAGE(PG8_SB(1, 0), b3, voffB); PG8_STAGE(PG8_SB(1, 1), b3 + hstepB, voffB); PG8_STAGE(PG8_SA(1, 0), a3, voffA);
            PG8_WAIT_V(8); PG8_WAIT_L(0); PG8_BAR; PG8_MMA(1, 0, At, B0); PG8_MMA(1, 1, At, B1); PG8_BAR; PG8_SCHED;
            if constexpr (Epi::HOOK) { if (E.want(t + 2)) { const int l2_ = opaque_tid() & 63; E.mid(acc, cur, t + 2, wr, wc, l2_ & 15, l2_ >> 4); } }
        }
        if (wr == 0) PG8_BAR;
        { const int l2_ = opaque_tid() & 63; E(acc, cur, wr, wc, l2_ & 15, l2_ >> 4); }
        if (!has_next) break;
#pragma unroll
        for (int a = 0; a < 2; ++a)
#pragma unroll
            for (int b = 0; b < 2; ++b)
#pragma unroll
                for (int m = 0; m < 4; ++m)
#pragma unroll
                    for (int n = 0; n < 2; ++n) acc[a][b][m][n] = (f32x4){0.f, 0.f, 0.f, 0.f};
        cur = nxt; cA = nA; cB = nB; ++ui;
        if (wr == 1) PG8_BAR;
    }
    PG8_WAIT_V(0);
    PG8_BAR;
#undef PG8_SA
#undef PG8_SB
#undef PG8_STAGE
#undef PG8_LDA
#undef PG8_LDB
#undef PG8_MMA
#undef PG8_CAT
#undef PG8_WAIT_V
#undef PG8_WAIT_L
#undef PG8_BAR
#undef PG8_SCHED
}

__device__ __forceinline__ const char* sgpr_ptr(const char* p) { const unsigned long long v = (unsigned long long)p; return (const char*)(((unsigned long long)(unsigned)__builtin_amdgcn_readfirstlane((int)(v >> 32)) << 32) | (unsigned)__builtin_amdgcn_readfirstlane((int)v)); }
struct DenseSched {
    const char* A; const char* B; unsigned lda, ldb; int nM, nN, nt, G, c, nExtra, exPm0, exPn;
    __device__ __forceinline__ bool next(int i, GUnit& u) const {
        const long L = (long)i * G + c; const int nwg = nM * nN; if (L >= nwg + nExtra) return false;
        int pm, pn; if (L < nwg) tile_of((int)L, nM, nN, pm, pn); else { pm = exPm0 + (int)(L - nwg); pn = exPn; }
        u.pm = pm; u.pn = pn; u.aux = 0; u.nt = nt; u.A = sgpr_ptr(A + (size_t)pm * 256 * lda); u.B = sgpr_ptr(B + (size_t)pn * 256 * ldb); return true;
    }
};
struct MergeSched {
    const char* A; const char* B; int nM, G, c;
    __device__ __forceinline__ bool next(int i, GUnit& u) const {
        const int tile = i / 3, seg = i - 3 * tile; const long L = (long)tile * G + c; if (L >= nM * 4) return false;
        int pm, pn; tile_of((int)L, nM, 4, pm, pn); const int koff = seg == 0 ? 0 : (seg == 1 ? 256 : 512);
        u.pm = pm; u.pn = pn; u.aux = seg; u.nt = seg == 2 ? 8 : 4; u.A = sgpr_ptr(A + (size_t)pm * 256 * 2048 + koff * 2); u.B = sgpr_ptr(B + (size_t)pn * 256 * 2048 + koff * 2); return true;
    }
};
struct MoeSched {
    const char* A; const char* B; unsigned lda, ldb; size_t estride; int nN, nt, G, c; int P[9];
    __device__ __forceinline__ bool next(int i, GUnit& u) const {
        const int nM = P[8]; const long L = (long)i * G + c; if (L >= (long)nM * nN) return false;
        int pm, pn; tile_of((int)L, nM, nN, pm, pn); int e = 0;
#pragma unroll
        for (int k = 1; k < 8; ++k) e += (pm >= P[k]) ? 1 : 0;
        u.pm = pm; u.pn = pn; u.aux = e; u.nt = nt; u.A = sgpr_ptr(A + (size_t)pm * 256 * lda); u.B = sgpr_ptr(B + (size_t)e * estride + (size_t)pn * 256 * ldb); return true;
    }
};

typedef f32x4 Acc[2][2][4][2];
struct EpiZ {
    static constexpr bool HOOK = false;
    bf16_t *ZC, *ZG, *Q, *K, *V, *G; const float* rope; float scz;
    __device__ __forceinline__ void operator()(const Acc& acc, const GUnit& u, int wr, int wc, int fr, int fq) const {
        const int pn = u.pn, row0 = u.pm * 256 + wr * 64 + fr, c8 = wc * 32 + fq * 8; const bool isx = u.pm < NPX; float sc_ = scz; asm volatile("" : "+s"(sc_));
#pragma unroll
        for (int ai = 0; ai < 2; ++ai)
#pragma unroll
            for (int m = 0; m < 4; ++m) { const int row = row0 + ai * 128 + m * 16;
                f32x4 a0 = acc[ai][0][m][0] * sc_, a1 = acc[ai][0][m][1] * sc_, b0 = acc[ai][1][m][0] * sc_, b1 = acc[ai][1][m][1] * sc_;
                if (pn < 3) { bf16_t* rp = ZC + (size_t)row * 768 + pn * 256 + c8; *(u32x4*)rp = pack8(a0, a1); *(u32x4*)(rp + 128) = pack8(b0, b1);
                } else if (pn < 5) { bf16_t* rp = ZG + (size_t)row * 512 + (pn - 3) * 256 + c8;
#pragma unroll
                    for (int j = 0; j < 4; ++j) { a0[j] = gelu_tanh(a0[j]); a1[j] = gelu_tanh(a1[j]); b0[j] = gelu_tanh(b0[j]); b1[j] = gelu_tanh(b1[j]); }
                    *(u32x4*)rp = pack8(a0, a1); *(u32x4*)(rp + 128) = pack8(b0, b1);
                } else if (pn < 8) {
                    if (pn == 7 && wc >= 2) {
                        bf16_t* vp = V + (size_t)row * 128 + (wc - 2) * 32 + fq * 8; *(u32x4*)vp = pack8(a0, a1); *(u32x4*)(vp + 64) = pack8(b0, b1);
                    } else {
                        if (isx) { const int s = row & (SEQ - 1), p = (fq < 2) ? (s >> 6) : (s & 63); const float* cs = rope + p * 16 + (fq & 1) * 8;
                            const f32x4 c0 = *(const f32x4*)cs, c1 = *(const f32x4*)(cs + 4), s0 = *(const f32x4*)(cs + 1024), s1 = *(const f32x4*)(cs + 1028);
                            const f32x4 oa0 = a0 * c0 - b0 * s0, oa1 = a1 * c1 - b1 * s1, ob0 = b0 * c0 + a0 * s0, ob1 = b1 * c1 + a1 * s1;
                            a0 = oa0; a1 = oa1; b0 = ob0; b1 = ob1; }
                        if (pn < 7) { a0 *= QSCALE; a1 *= QSCALE; b0 *= QSCALE; b1 *= QSCALE;
                            bf16_t* qp = Q + (size_t)row * 512 + ((pn - 5) * 4 + wc) * 64 + fq * 8; *(u32x4*)qp = pack8(a0, a1); *(u32x4*)(qp + 32) = pack8(b0, b1);
                        } else { bf16_t* kp = K + (size_t)row * 128 + wc * 64 + fq * 8; *(u32x4*)kp = pack8(a0, a1); *(u32x4*)(kp + 32) = pack8(b0, b1); }
                    }
                } else { bf16_t* rp = G + (size_t)row * 3072 + (pn - 8) * 256 + c8;
#pragma unroll
                    for (int j = 0; j < 4; ++j) { a0[j] = fast_sigmoid(a0[j]); a1[j] = fast_sigmoid(a1[j]); b0[j] = fast_sigmoid(b0[j]); b1[j] = fast_sigmoid(b1[j]); }
                    *(u32x4*)rp = pack8(a0, a1); *(u32x4*)(rp + 128) = pack8(b0, b1);
                }
                }
    }
};
struct EpiGate8 {
    static constexpr bool HOOK = false;
    bf16_t* G;
    __device__ __forceinline__ void operator()(const Acc& acc, const GUnit& u, int wr, int wc, int fr, int fq) const {
        const int row0 = u.pm * 256 + wr * 64 + fr, col = u.pn * 256 + wc * 32 + fq * 8; float sc = 1.0f / (A8_SCALE * W_GU_SCALE); asm volatile("" : "+s"(sc));
#pragma unroll
        for (int ai = 0; ai < 2; ++ai)
#pragma unroll
            for (int m = 0; m < 4; ++m) { bf16_t* rp = G + (size_t)(row0 + ai * 128 + m * 16) * 3072 + col;
#pragma unroll
                for (int bj = 0; bj < 2; ++bj) { f32x4 a = acc[ai][bj][m][0] * sc, b = acc[ai][bj][m][1] * sc;
#pragma unroll
                    for (int j = 0; j < 4; ++j) { a[j] = fast_sigmoid(a[j]); b[j] = fast_sigmoid(b[j]); }
                    *(u32x4*)(rp + bj * 128) = pack8(a, b); } }
    }
};
struct EpiMerge {
    static constexpr bool HOOK = false;
    const bf16_t* G; bf16_t* MIX;
    template <bool RMW> __device__ __forceinline__ void run(const Acc& acc, const GUnit& u, int wr, int wc, int fr, int fq) const {
        const int seg = u.aux, row0 = u.pm * 256 + wr * 64 + fr, col = u.pn * 256 + wc * 32 + fq * 8;
#pragma unroll
        for (int ai = 0; ai < 2; ++ai) { u32x4 gq[4][2], mq[4][2];
#pragma unroll
            for (int m = 0; m < 4; ++m)
#pragma unroll
                for (int bj = 0; bj < 2; ++bj) { const size_t row = (size_t)(row0 + ai * 128 + m * 16); gq[m][bj] = *(const u32x4*)(G + row * 3072 + seg * 1024 + col + bj * 128);
                    if (RMW) mq[m][bj] = *(const u32x4*)(MIX + row * 1024 + col + bj * 128); }
#pragma unroll
            for (int m = 0; m < 4; ++m)
#pragma unroll
                for (int bj = 0; bj < 2; ++bj) { const size_t row = (size_t)(row0 + ai * 128 + m * 16); f32x4 g0, g1; unpack8(gq[m][bj], g0, g1);
                    f32x4 v0 = g0 * acc[ai][bj][m][0], v1 = g1 * acc[ai][bj][m][1];
                    if (RMW) { f32x4 o0, o1; unpack8(mq[m][bj], o0, o1); v0 += o0; v1 += o1; }
                    *(u32x4*)(MIX + row * 1024 + col + bj * 128) = pack8(v0, v1); } }
    }
    __device__ __forceinline__ void operator()(const Acc& acc, const GUnit& u, int wr, int wc, int fr, int fq) const { if (u.aux) run<true>(acc, u, wr, wc, fr, fq); else run<false>(acc, u, wr, wc, fr, fq); }
};
struct EpiMergeH {
    static constexpr bool HOOK = true;
    const bf16_t* G; bf16_t* MIX;
    __device__ __forceinline__ bool want(int kdone) const { return kdone == 4 || kdone == 8; }
    __device__ __forceinline__ void mid(Acc& acc, const GUnit& u, int kdone, int wr, int wc, int fr, int fq) const {
        const int seg = kdone == 4 ? 0 : 1, row0 = u.pm * 256 + wr * 64 + fr, col = u.pn * 256 + wc * 32 + fq * 8;
#pragma unroll
        for (int ai = 0; ai < 2; ++ai)
#pragma unroll
            for (int m = 0; m < 4; ++m) { const bf16_t* gp = G + (size_t)(row0 + ai * 128 + m * 16) * 3072 + seg * 1024 + col;
#pragma unroll
                for (int bj = 0; bj < 2; ++bj) { f32x4 p0, p1, n0, n1; unpack8(*(const u32x4*)(gp + bj * 128), p0, p1); unpack8(*(const u32x4*)(gp + 1024 + bj * 128), n0, n1);
#pragma unroll
                    for (int j = 0; j < 4; ++j) { acc[ai][bj][m][0][j] *= __builtin_fmaxf(p0[j], 1e-30f) * __builtin_amdgcn_rcpf(__builtin_fmaxf(n0[j], 1e-30f)); acc[ai][bj][m][1][j] *= __builtin_fmaxf(p1[j], 1e-30f) * __builtin_amdgcn_rcpf(__builtin_fmaxf(n1[j], 1e-30f)); } }
                asm volatile("" ::: "memory"); }
    }
    __device__ __forceinline__ void operator()(const Acc& acc, const GUnit& u, int wr, int wc, int fr, int fq) const {
        const int row0 = u.pm * 256 + wr * 64 + fr, col = u.pn * 256 + wc * 32 + fq * 8;
#pragma unroll
        for (int ai = 0; ai < 2; ++ai)
#pragma unroll
            for (int m = 0; m < 4; ++m) { const size_t row = (size_t)(row0 + ai * 128 + m * 16);
#pragma unroll
                for (int bj = 0; bj < 2; ++bj) { f32x4 g0, g1; unpack8(*(const u32x4*)(G + row * 3072 + 2048 + col + bj * 128), g0, g1);
#pragma unroll
                    for (int j = 0; j < 4; ++j) { g0[j] = __builtin_fmaxf(g0[j], 1e-30f); g1[j] = __builtin_fmaxf(g1[j], 1e-30f); }
                    *(u32x4*)(MIX + row * 1024 + col + bj * 128) = pack8(g0 * acc[ai][bj][m][0], g1 * acc[ai][bj][m][1]); }
                asm volatile("" ::: "memory"); }
    }
};
struct Merge12Sched {
    const char* A; const char* B; int nM, G, c;
    __device__ __forceinline__ bool next(int i, GUnit& u) const {
        const long L = (long)i * G + c; if (L >= (long)nM * 12) return false;
        int pm, pn; tile_of((int)L, nM, 12, pm, pn); const int j = pn >> 2, koff = j == 0 ? 0 : (j == 1 ? 256 : 512);
        u.pm = pm; u.pn = pn; u.aux = j; u.nt = j == 2 ? 8 : 4; u.A = sgpr_ptr(A + (size_t)pm * 256 * 2048 + koff * 2); u.B = sgpr_ptr(B + (size_t)(pn & 3) * 256 * 2048 + koff * 2); return true;
    }
};
struct EpiMerge8 {
    static constexpr bool HOOK = false;
    const bf16_t* G; unsigned char* GP;
    __device__ __forceinline__ void operator()(const Acc& acc, const GUnit& u, int wr, int wc, int fr, int fq) const {
        const int row0 = u.pm * 256 + wr * 64 + fr, col = u.pn * 256 + wc * 32 + fq * 8; float sc = GP8_SCALE; asm volatile("" : "+s"(sc));
#pragma unroll
        for (int ai = 0; ai < 2; ++ai)
#pragma unroll
            for (int m = 0; m < 4; ++m) { const unsigned row = (unsigned)(row0 + ai * 128 + m * 16);
#pragma unroll
                for (int bj = 0; bj < 2; ++bj) { f32x4 g0, g1; unpack8(*(const u32x4*)(G + (size_t)row * 3072 + col + bj * 128), g0, g1);
                    const f32x4 v0 = g0 * acc[ai][bj][m][0] * sc, v1 = g1 * acc[ai][bj][m][1] * sc;
                    u32x2 o; o.x = pk4_fp8(v0[0], v0[1], v0[2], v0[3]); o.y = pk4_fp8(v1[0], v1[1], v1[2], v1[3]);
                    *(u32x2*)(GP + row * 3072u + (unsigned)(col + bj * 128)) = o; } }
    }
};
struct EpiResid {
    static constexpr bool HOOK = false;
    const float* xin_x; const float* xin_c; float* xout_x; float* xout_c; const float* gate; float sc;
    __device__ __forceinline__ void operator()(const Acc& acc, const GUnit& u, int wr, int wc, int fr, int fq) const {
        const bool isx = u.pm < NPX; const int b = isx ? (u.pm >> 4) : 16;
        const float* xi = isx ? xin_x + (size_t)u.pm * 256 * D : xin_c + (size_t)(u.pm - NPX) * 256 * D;
        float* xo = isx ? xout_x + (size_t)u.pm * 256 * D : xout_c + (size_t)(u.pm - NPX) * 256 * D;
        const int col = u.pn * 256 + wc * 32 + fq * 8; const float* gp = gate + (size_t)b * 6 * D + col;
        f32x4 gv[2][2];
#pragma unroll
        for (int bj = 0; bj < 2; ++bj) { gv[bj][0] = *(const f32x4*)(gp + bj * 128) * sc; gv[bj][1] = *(const f32x4*)(gp + bj * 128 + 4) * sc; }
#pragma unroll
        for (int ai = 0; ai < 2; ++ai) { f32x4 xq[4][2][2];
#pragma unroll
            for (int m = 0; m < 4; ++m) { const size_t off = (size_t)(wr * 64 + fr + ai * 128 + m * 16) * D + col;
#pragma unroll
                for (int bj = 0; bj < 2; ++bj) { xq[m][bj][0] = *(const f32x4*)(xi + off + bj * 128); xq[m][bj][1] = *(const f32x4*)(xi + off + bj * 128 + 4); } }
#pragma unroll
            for (int m = 0; m < 4; ++m) { const size_t off = (size_t)(wr * 64 + fr + ai * 128 + m * 16) * D + col;
#pragma unroll
                for (int bj = 0; bj < 2; ++bj) { *(f32x4*)(xo + off + bj * 128) = xq[m][bj][0] + gv[bj][0] * acc[ai][bj][m][0]; *(f32x4*)(xo + off + bj * 128 + 4) = xq[m][bj][1] + gv[bj][1] * acc[ai][bj][m][1]; } } }
    }
};
struct EpiGU {
    static constexpr bool HOOK = false;
    bf16_t* H; int ldh;
    __device__ __forceinline__ void operator()(const Acc& acc, const GUnit& u, int wr, int wc, int fr, int fq) const {
        const int row0 = u.pm * 256 + wr * 64 + fr, col = u.pn * 128 + wc * 32 + fq * 8;
#pragma unroll
        for (int ai = 0; ai < 2; ++ai)
#pragma unroll
            for (int m = 0; m < 4; ++m) { f32x4 a = acc[ai][0][m][0], b = acc[ai][0][m][1]; const f32x4 c = acc[ai][1][m][0], d = acc[ai][1][m][1];
#pragma unroll
                for (int j = 0; j < 4; ++j) { a[j] = fast_silu(a[j]) * c[j]; b[j] = fast_silu(b[j]) * d[j]; }
                *(u32x4*)(H + (size_t)(row0 + ai * 128 + m * 16) * ldh + col) = pack8(a, b); }
    }
};
struct EpiGU8 {
    static constexpr bool HOOK = false;
    unsigned char* H; int ldh;
    __device__ __forceinline__ void operator()(const Acc& acc, const GUnit& u, int wr, int wc, int fr, int fq) const {
        const int row0 = u.pm * 256 + wr * 64 + fr, col = u.pn * 128 + wc * 32 + fq * 8; float sc = 1.0f / (A8_SCALE * W_GU_SCALE), sch = H8_SCALE / (A8_SCALE * W_GU_SCALE);
        asm volatile("" : "+s"(sc), "+s"(sch));
#pragma unroll
        for (int ai = 0; ai < 2; ++ai)
#pragma unroll
            for (int m = 0; m < 4; ++m) { f32x4 a = acc[ai][0][m][0] * sc, b = acc[ai][0][m][1] * sc; const f32x4 c = acc[ai][1][m][0] * sch, d = acc[ai][1][m][1] * sch;
#pragma unroll
                for (int j = 0; j < 4; ++j) { a[j] = fast_silu(a[j]) * c[j]; b[j] = fast_silu(b[j]) * d[j]; }
                u32x2 o; o.x = pk4_fp8(a[0], a[1], a[2], a[3]); o.y = pk4_fp8(b[0], b[1], b[2], b[3]);
                const unsigned off = (unsigned)(row0 + ai * 128 + m * 16) * (unsigned)ldh + (unsigned)col;
                *(u32x2*)(H + off) = o; }
    }
};
struct EpiMoeDown {
    static constexpr bool HOOK = false;
    const int* rinfo; bf16_t* Y; float sc;
    __device__ __forceinline__ void operator()(const Acc& acc, const GUnit& u, int wr, int wc, int fr, int fq) const {
        const int row0 = u.pm * 256 + wr * 64 + fr, col = u.pn * 256 + wc * 32 + fq * 8;
        int infos[2][4];
#pragma unroll
        for (int ai = 0; ai < 2; ++ai)
#pragma unroll
            for (int m = 0; m < 4; ++m) infos[ai][m] = rinfo[row0 + ai * 128 + m * 16];
#pragma unroll
        for (int ai = 0; ai < 2; ++ai)
#pragma unroll
            for (int m = 0; m < 4; ++m) { const int info = infos[ai][m];
                if (info >= 0) { const unsigned t = (unsigned)info & 0xfffffu, k = ((unsigned)info >> 20) & 1u; const unsigned off = ((k * (unsigned)T + t) * (unsigned)D + (unsigned)col) * 2u;
#pragma unroll
                    for (int bj = 0; bj < 2; ++bj) *(u32x4*)((unsigned char*)Y + off + bj * 256) = pack8(acc[ai][bj][m][0] * sc, acc[ai][bj][m][1] * sc); } }
    }
};
}

namespace attn_body {
using bf16=__hip_bfloat16;
using s16x4=__attribute__((ext_vector_type(4)))short;
constexpr int D64=64,NW=8,QBLK=32,KVBLK=64;
constexpr int QP=512,KP=128,OP=1024;
__device__ __forceinline__ int crow(int r,int hi){return (r&3)+8*(r>>2)+4*hi;}
#define SBAR() __builtin_amdgcn_sched_barrier(0)
__device__ __forceinline__ void wmask(f32x16&p0,f32x16&p1,int base,int hi){
  const float NEG=-INFINITY; const int kb=base+4*hi;
  #pragma unroll
  for(int r=0;r<16;++r){const int d=kb+(r&3)+8*(r>>2); if(d>128||d<-128)p0[r]=NEG; if(d+32>128||d+32<-128)p1[r]=NEG;}
}
constexpr int NSLOT=3, SLOTB=8192;
constexpr int LDS_K=0, LDS_V=NSLOT*SLOTB, LDS_WS=2*NSLOT*SLOTB, LDS_OST=LDS_WS+NW*64*4, LDS_BYTES=LDS_OST+NW*4096;
__device__ __forceinline__ void glds16(const void*gsrc,unsigned lds_dst){unsigned keep;
  asm volatile("s_mov_b32 %0, m0\n\ts_mov_b32 m0, %2\n\ts_nop 0\n\tglobal_load_lds_dwordx4 %1, off\n\ts_mov_b32 m0, %0":"=&s"(keep):"v"(gsrc),"s"(lds_dst):"memory");}
__device__ __forceinline__ float max3f(float a,float b,float c){float r;asm("v_max3_f32 %0, %1, %2, %3":"=v"(r):"v"(a),"v"(b),"v"(c));return r;}
__device__ __forceinline__ float max2f(float a,float b){float r;asm("v_max_f32_e32 %0, %1, %2":"=v"(r):"v"(a),"v"(b));return r;}
__device__ __forceinline__ float fadd_s(float a,float b){float r;asm("v_add_f32_e32 %0, %1, %2":"=v"(r):"v"(a),"v"(b));return r;}
__device__ __forceinline__ float fsub_s(float a,float b){float r;asm("v_sub_f32_e32 %0, %1, %2":"=v"(r):"v"(a),"v"(b));return r;}
typedef float f32x2_t __attribute__((ext_vector_type(2))); typedef __bf16 bf16x2_t __attribute__((ext_vector_type(2)));
__device__ __forceinline__ unsigned cvtpk_s(float lo,float hi){f32x2_t v={lo,hi};bf16x2_t b=__builtin_convertvector(v,bf16x2_t);return __builtin_bit_cast(unsigned,b);}
#define WAIT_BAR(N) asm volatile("s_waitcnt vmcnt(" #N ") lgkmcnt(0)\n\ts_barrier":::"memory")
__device__ __forceinline__ void qkt(f32x16&p0,f32x16&p1,const char*Kslot,const bf16x8*qr,const f32x16&negm,int r32,int hi){
  const char*kb=Kslot+hi*1024+r32*16;
  #pragma unroll
  for(int d0=0;d0<4;++d0){
    const bf16x8 b0=*reinterpret_cast<const bf16x8*>(kb+d0*2048);
    const bf16x8 b1=*reinterpret_cast<const bf16x8*>(kb+d0*2048+512);
    if(d0==0){p0=__builtin_amdgcn_mfma_f32_32x32x16_bf16(b0,qr[0],negm,0,0,0);p1=__builtin_amdgcn_mfma_f32_32x32x16_bf16(b1,qr[0],negm,0,0,0);}
    else{p0=__builtin_amdgcn_mfma_f32_32x32x16_bf16(b0,qr[d0],p0,0,0,0);p1=__builtin_amdgcn_mfma_f32_32x32x16_bf16(b1,qr[d0],p1,0,0,0);}}
}
typedef __attribute__((address_space(3))) const char* lds_cptr;
typedef short v4i16_t __attribute__((ext_vector_type(4)));
__device__ __forceinline__ void kload8(bf16x8*kf,lds_cptr kp){
  kf[0]=*(const __attribute__((address_space(3))) bf16x8*)(kp);      kf[1]=*(const __attribute__((address_space(3))) bf16x8*)(kp+512);
  kf[2]=*(const __attribute__((address_space(3))) bf16x8*)(kp+2048); kf[3]=*(const __attribute__((address_space(3))) bf16x8*)(kp+2560);
  kf[4]=*(const __attribute__((address_space(3))) bf16x8*)(kp+4096); kf[5]=*(const __attribute__((address_space(3))) bf16x8*)(kp+4608);
  kf[6]=*(const __attribute__((address_space(3))) bf16x8*)(kp+6144); kf[7]=*(const __attribute__((address_space(3))) bf16x8*)(kp+6656);
}
__device__ __forceinline__ void kload2(bf16x8*kf,lds_cptr kp,int j){ kf[2*j]=*(const __attribute__((address_space(3))) bf16x8*)(kp+j*2048); kf[2*j+1]=*(const __attribute__((address_space(3))) bf16x8*)(kp+j*2048+512); }
__device__ __forceinline__ s16x4 vtr(lds_cptr p){ return __builtin_bit_cast(s16x4,__builtin_amdgcn_ds_read_tr16_b64_v4i16((__attribute__((address_space(3))) v4i16_t*)p)); }
__device__ __forceinline__ float rowmax(const f32x16&p0,const f32x16&p1){
  float a=max3f(p0[0],p0[1],p1[0]),b=max3f(p0[2],p0[3],p1[1]);a=max3f(a,p1[2],p1[3]);
  #pragma unroll
  for(int r=4;r<16;r+=4){a=max3f(a,p0[r],p0[r+1]);b=max3f(b,p0[r+2],p0[r+3]);a=max3f(a,p1[r],p1[r+1]);b=max3f(b,p1[r+2],p1[r+3]);}
  const float m=max2f(a,b);
  auto rr=__builtin_amdgcn_permlane32_swap(__float_as_uint(m),__float_as_uint(m),false,false);
  return max2f(__uint_as_float(rr[0]),__uint_as_float(rr[1]));
}
__device__ __forceinline__ void pv(f32x16*o,int vb,bf16x8 pa0,bf16x8 pa1,bf16x8 pa2,bf16x8 pa3){
  #pragma unroll
  for(int d0=0;d0<2;++d0){s16x4 lo[4],hi[4];
    #pragma unroll
    for(int ks=0;ks<4;++ks){
      asm volatile("ds_read_b64_tr_b16 %0,%1 offset:%c2":"=&v"(lo[ks]):"v"(vb),"i"(d0*4096+ks*1024):"memory");
      asm volatile("ds_read_b64_tr_b16 %0,%1 offset:%c2":"=&v"(hi[ks]):"v"(vb),"i"(d0*4096+ks*1024+512):"memory");}
    asm volatile("s_waitcnt lgkmcnt(0)":::"memory");SBAR();
    #define PK(k) (bf16x8){lo[k][0],lo[k][1],lo[k][2],lo[k][3],hi[k][0],hi[k][1],hi[k][2],hi[k][3]}
    o[d0]=__builtin_amdgcn_mfma_f32_32x32x16_bf16(pa0,PK(0),o[d0],0,0,0);
    o[d0]=__builtin_amdgcn_mfma_f32_32x32x16_bf16(pa1,PK(1),o[d0],0,0,0);
    o[d0]=__builtin_amdgcn_mfma_f32_32x32x16_bf16(pa2,PK(2),o[d0],0,0,0);
    o[d0]=__builtin_amdgcn_mfma_f32_32x32x16_bf16(pa3,PK(3),o[d0],0,0,0);
    #undef PK
  }
}
template<int THRL> __device__ __forceinline__ void attn_unit(const bf16*Qw,const bf16*__restrict__ Kc,const bf16*__restrict__ Vc,bf16*Ow,int crow0,int lrow0,int NT,int qoff0,float sink_l2,char*shm){
  const int tid=opaque_tid(),lane=tid&63,r32=lane&31,hi=lane>>5; const int wid=__builtin_amdgcn_readfirstlane(tid>>6);
  const unsigned lds0=(unsigned)(uintptr_t)shm;
  float*wsf=(float*)(shm+LDS_WS)+wid*64;
  const bf16*ksrc=Kc+(long)lane*KP+wid*8;
  const bf16*vsrc=Vc+(long)(16*(wid&3)+(lane>>2))*KP+(wid>>2)*32+(lane&3)*8;
  const unsigned kdst=lds0+LDS_K+wid*1024, vdst=lds0+LDS_V+wid*1024;
  #define TROW(t) ((long)(((t)<4)?(crow0+64*(t)):(lrow0+64*((t)-4)))*KP)
  #define DMA_K(t,slot) glds16(ksrc+TROW(t),(unsigned)__builtin_amdgcn_readfirstlane(kdst+(slot)))
  #define DMA_V(t,slot) glds16(vsrc+TROW(t),(unsigned)__builtin_amdgcn_readfirstlane(vdst+(slot)))
  const int vb0=(int)(lds0+LDS_V)+((lane>>4)&1)*32+(lane&3)*8+(4*hi+((lane&15)>>2))*64;
  const char*Kbase=shm+LDS_K; bf16x8 kf[8];
  const lds_cptr shm3=(lds_cptr)shm; const lds_cptr kp0=shm3+LDS_K+hi*1024+r32*16; const lds_cptr vp0=shm3+LDS_V+((lane>>4)&1)*32+(lane&3)*8+(4*hi+((lane&15)>>2))*64;
  DMA_K(0,0);DMA_V(0,0);DMA_K(1,SLOTB);
  bf16x8 qr[4];
  #pragma unroll
  for(int d0=0;d0<4;++d0)qr[d0]=*reinterpret_cast<const bf16x8*>(&Qw[(long)r32*QP+d0*16+hi*8]);
  float mhat=0.f,l_reg=0.f;f32x16 o[2];o[0]=f32x16{};o[1]=f32x16{};const f32x16 negm=f32x16{};
  const int qoff=qoff0+r32;
  #define CMASK(P0,P1,t) do{ if((t)>=4){ const int kb_=64*((t)-4); if(kb_-(qoff0+31)<-128||kb_+63-qoff0>128) wmask(P0,P1,kb_-qoff,hi);} }while(0)
  bool resc=false;
  #define START(P0,P1) do{ const float rm=rowmax(P0,P1); resc=false; mhat=rm; \
    _Pragma("unroll") for(int r=0;r<16;++r){P0[r]=fsub_s(P0[r],mhat);P1[r]=fsub_s(P1[r],mhat);} \
    _Pragma("unroll") for(int r=0;r<16;++r)P0[r]=__builtin_amdgcn_exp2f(P0[r]); }while(0)
  #define RESC() do{ if(resc){ asm volatile("s_waitcnt lgkmcnt(0)":::"memory"); \
      _Pragma("unroll") for(int d_=0;d_<2;++d_) _Pragma("unroll") for(int r=0;r<16;++r)o[d_][r]*=wsf[crow(r,hi)]; } }while(0)
  f32x16 pA0,pA1,pB0,pB1;
  int sl_prev=0,sl_cur=0,sl_next=SLOTB;
  #define ROT() do{sl_prev=sl_cur;sl_cur=sl_next;sl_next=(sl_next==(NSLOT-1)*SLOTB)?0:sl_next+SLOTB;}while(0)
  DMA_K(2,2*SLOTB);
  WAIT_BAR(3);
  qkt(pA0,pA1,Kbase,qr,negm,r32,hi);asm volatile("s_nop 15\n\ts_nop 7":"+v"(pA0),"+v"(pA1));
  START(pA0,pA1);
  _Pragma("unroll") for(int r=0;r<16;++r)pA1[r]=__builtin_amdgcn_exp2f(pA1[r]);
  WAIT_BAR(0);
  DMA_K(3,0);DMA_V(1,SLOTB);
  ROT();
  kload8(kf,kp0+sl_cur);
  WAIT_BAR(2);
  s16x4 vlo[8],vhi[8]; u32x4 pw0,pw1,pw2,pw3;
  #define PKW(P,B) cvtpk_s(P[B],P[B+1])
  #define PAF(k) __builtin_bit_cast(bf16x8,pw##k)
  #define VFR(i) (bf16x8){vlo[i][0],vlo[i][1],vlo[i][2],vlo[i][3],vhi[i][0],vhi[i][1],vhi[i][2],vhi[i][3]}
  #define PIN(x) asm volatile("":"+v"(x))
  #define MX3(a,b,c) __builtin_fmaxf(__builtin_fmaxf((a),(b)),(c))
  #define GAPA(MF,A0,A1,A2,A3,W0,W1,PW) do{ MF; sacc+=A0; sacc+=A1; sacc+=A2; sacc+=A3; PIN(sacc); W0; W1; PIN(PW); SBAR(); }while(0)
  #define EX(v) __builtin_amdgcn_exp2f(v)
  #define GAPB(MF,X,B) do{ MF; X[B]=EX(X[B]-mhat); X[B+1]=EX(X[B+1]-mhat); X[B+2]=EX(X[B+2]-mhat); X[B+3]=EX(X[B+3]-mhat); PIN(X); SBAR(); }while(0)
  #define VRD(i) do{ vlo[i]=vtr(vp_+(((i)>>2)*4096+((i)&3)*1024)); vhi[i]=vtr(vp_+(((i)>>2)*4096+((i)&3)*1024+512)); }while(0)
  #define KRD(G,j) do{ if(G){ kload2(kf,kp0+sl_next,j); SBAR(); } }while(0)
  #define STEP(C0,C1,P0,P1,t,GK,GV,GL) do{ SBAR(); \
    const lds_cptr vp_=vp0+sl_prev; \
    VRD(0); SBAR(); float sacc=(P0[0]+P0[1]); \
    GAPA(C0=__builtin_amdgcn_mfma_f32_32x32x16_bf16(kf[0],qr[0],negm,0,0,0), P0[2],P0[3],P0[4],P0[5],     pw0[0]=PKW(P0,0), pw0[1]=PKW(P0,2), pw0); \
    VRD(4); SBAR(); GAPA(C1=__builtin_amdgcn_mfma_f32_32x32x16_bf16(kf[1],qr[0],negm,0,0,0), P0[6],P0[7],P0[8],P0[9],     pw0[2]=PKW(P0,4), pw0[3]=PKW(P0,6), pw0); \
    VRD(1); SBAR(); GAPA(C0=__builtin_amdgcn_mfma_f32_32x32x16_bf16(kf[2],qr[1],C0,0,0,0),   P0[10],P0[11],P0[12],P0[13], pw1[0]=PKW(P0,8), pw1[1]=PKW(P0,10), pw1); \
    VRD(5); SBAR(); GAPA(C1=__builtin_amdgcn_mfma_f32_32x32x16_bf16(kf[3],qr[1],C1,0,0,0),   P0[14],P0[15],P1[0],P1[1],   pw1[2]=PKW(P0,12),pw1[3]=PKW(P0,14), pw1); \
    VRD(2); SBAR(); GAPA(C0=__builtin_amdgcn_mfma_f32_32x32x16_bf16(kf[4],qr[2],C0,0,0,0),   P1[2],P1[3],P1[4],P1[5],     pw2[0]=PKW(P1,0), pw2[1]=PKW(P1,2), pw2); \
    VRD(6); SBAR(); GAPA(C1=__builtin_amdgcn_mfma_f32_32x32x16_bf16(kf[5],qr[2],C1,0,0,0),   P1[6],P1[7],P1[8],P1[9],     pw2[2]=PKW(P1,4), pw2[3]=PKW(P1,6), pw2); \
    VRD(3); SBAR(); GAPA(C0=__builtin_amdgcn_mfma_f32_32x32x16_bf16(kf[6],qr[3],C0,0,0,0),   P1[10],P1[11],P1[12],P1[13], pw3[0]=PKW(P1,8), pw3[1]=PKW(P1,10), pw3); \
    VRD(7); SBAR(); GAPA(C1=__builtin_amdgcn_mfma_f32_32x32x16_bf16(kf[7],qr[3],C1,0,0,0),   P1[14],P1[15],0.f,0.f,       pw3[2]=PKW(P1,12),pw3[3]=PKW(P1,14), pw3); \
    l_reg+=sacc; \
    if(GK){DMA_K((t)+3,sl_cur);} if(GV){DMA_V((t)+1,sl_next);} \
    CMASK(C0,C1,t); \
    { float a=MX3(C0[0],C0[1],C1[0]),b=MX3(C0[2],C0[3],C1[1]); a=MX3(a,C1[2],C1[3]); \
      _Pragma("unroll") for(int r=4;r<16;r+=4){a=MX3(a,C0[r],C0[r+1]);b=MX3(b,C0[r+2],C0[r+3]);a=MX3(a,C1[r],C1[r+1]);b=MX3(b,C1[r+2],C1[r+3]);} \
      float rm=__builtin_fmaxf(a,b); { auto rr=__builtin_amdgcn_permlane32_swap(__float_as_uint(rm),__float_as_uint(rm),false,false); rm=__builtin_fmaxf(__uint_as_float(rr[0]),__uint_as_float(rr[1])); } \
      resc=false; \
      rm-=mhat; \
      if(__builtin_expect(__any(rm>(float)THRL),0)){ const float dl=__builtin_fmaxf(rm,0.f); mhat+=dl; \
        const float f=__builtin_amdgcn_exp2f(-dl); l_reg*=f; if(hi==0)wsf[r32]=f; resc=true; } } \
    SBAR(); \
    GAPB(o[0]=__builtin_amdgcn_mfma_f32_32x32x16_bf16(PAF(0),VFR(0),o[0],0,0,0), C0,0); \
    GAPB(o[1]=__builtin_amdgcn_mfma_f32_32x32x16_bf16(PAF(0),VFR(4),o[1],0,0,0), C0,4); \
    KRD(GL,0); GAPB(o[0]=__builtin_amdgcn_mfma_f32_32x32x16_bf16(PAF(1),VFR(1),o[0],0,0,0), C0,8); \
    KRD(GL,1); GAPB(o[1]=__builtin_amdgcn_mfma_f32_32x32x16_bf16(PAF(1),VFR(5),o[1],0,0,0), C0,12); \
    KRD(GL,2); GAPB(o[0]=__builtin_amdgcn_mfma_f32_32x32x16_bf16(PAF(2),VFR(2),o[0],0,0,0), C1,0); \
    KRD(GL,3); GAPB(o[1]=__builtin_amdgcn_mfma_f32_32x32x16_bf16(PAF(2),VFR(6),o[1],0,0,0), C1,4); \
    GAPB(o[0]=__builtin_amdgcn_mfma_f32_32x32x16_bf16(PAF(3),VFR(3),o[0],0,0,0), C1,8); \
    GAPB(o[1]=__builtin_amdgcn_mfma_f32_32x32x16_bf16(PAF(3),VFR(7),o[1],0,0,0), C1,12); \
    }while(0)
  int t=1;
  #define ENDW(tt) do{ if((tt)+3<NT){WAIT_BAR(2);} else if((tt)+2<NT){WAIT_BAR(1);} else {WAIT_BAR(0);} }while(0)
  for(;t+1<NT;t+=2){
    STEP(pB0,pB1,pA0,pA1,t,(t+3<NT),(t+1<NT),(t+1<NT));       ENDW(t);   RESC(); ROT();
    STEP(pA0,pA1,pB0,pB1,t+1,(t+4<NT),(t+2<NT),(t+2<NT));     ENDW(t+1); RESC(); ROT();
  }
  STEP(pB0,pB1,pA0,pA1,NT-1,false,false,false); RESC();
  { float sacc=pB0[0]+pB0[1]; _Pragma("unroll") for(int r=2;r<16;++r)sacc+=pB0[r]; _Pragma("unroll") for(int r=0;r<16;++r)sacc+=pB1[r]; l_reg+=sacc;
    pw0=(u32x4){PKW(pB0,0),PKW(pB0,2),PKW(pB0,4),PKW(pB0,6)};pw1=(u32x4){PKW(pB0,8),PKW(pB0,10),PKW(pB0,12),PKW(pB0,14)};pw2=(u32x4){PKW(pB1,0),PKW(pB1,2),PKW(pB1,4),PKW(pB1,6)};pw3=(u32x4){PKW(pB1,8),PKW(pB1,10),PKW(pB1,12),PKW(pB1,14)};
    SBAR(); pv(o,vb0+sl_cur,PAF(0),PAF(1),PAF(2),PAF(3)); }
  #undef PKW
  #undef PAF
  #undef VFR
  #undef PIN
  #undef MX3
  #undef GAPA
  #undef GAPB
  #undef EX
  #undef VRD
  #undef KRD
  #undef STEP
  #undef ENDW
  {auto rr=__builtin_amdgcn_permlane32_swap(__float_as_uint(l_reg),__float_as_uint(l_reg),false,false);l_reg=__uint_as_float(rr[0])+__uint_as_float(rr[1]);}
  l_reg+=__builtin_amdgcn_exp2f(sink_l2-mhat);
  if(hi==0)wsf[32+r32]=l_reg;asm volatile("s_waitcnt lgkmcnt(0)":::"memory");
  float rli[16];
  #pragma unroll
  for(int r=0;r<16;++r)rli[r]=__builtin_amdgcn_rcpf(wsf[32+crow(r,hi)]);
  { bf16*stg=(bf16*)(shm+LDS_OST)+wid*2048;
    #pragma unroll
    for(int r=0;r<16;++r){const int orow=crow(r,hi);
      #pragma unroll
      for(int d0=0;d0<2;++d0)stg[orow*64+d0*32+r32]=__float2bfloat16(o[d0][r]*rli[r]);}
    asm volatile("s_waitcnt lgkmcnt(0)":::"memory");
    #pragma unroll
    for(int i=0;i<4;++i){const int row=i*8+(lane>>3),ch=lane&7; const u32x4 v=*(const u32x4*)(stg+row*64+ch*8); *(u32x4*)(Ow+(long)row*OP+ch*8)=v;} }
  asm volatile("s_waitcnt lgkmcnt(0)\n\ts_barrier":::"memory");
  #undef TROW
  #undef DMA_K
  #undef DMA_V
  #undef CMASK
  #undef START
  #undef RESC
  #undef ROT
}
#undef SBAR
#undef WAIT_BAR
}

constexpr int NWAVES = 8, NTHREADS = 512;
constexpr int RING_BYTES = 131072;
constexpr int MISC_OFF = RING_BYTES;
constexpr int LDS_BYTES = 147456;
constexpr int CW_BAR = 4096;

struct Args { GAS const float* in[23]; GAS float* out; GAS unsigned char* ws; int ph_lo, ph_hi; };
enum { I_X = 0, I_C, I_CTX, I_CCTX, I_WMOD, I_BMOD, I_N1G, I_N2G, I_WIN, I_CONVW, I_GWS, I_GB, I_SINK, I_WBC, I_WBG, I_WBA, I_WOUT, I_FGU, I_FD, I_ROUTER, I_MGU, I_MD, I_FNG };

struct Ctx {
    LAS unsigned char* lds; int tid, lane, wave, G, wg;
    const Args __attribute__((address_space(4)))* a; GAS unsigned char* ws;
};

__device__ __forceinline__ int zmap(int n) {
    const int pn = n >> 8;
    if (pn < 5 || pn > 7) return n;
    const int half = (n >> 7) & 1, hc = n & 127, idx = hc & 31, d = (idx < 16 ? idx : idx + 16) + 16 * half;
    if (pn < 7) return 1280 + (((pn - 5) * 4 + (hc >> 5)) * 64) + d;
    if (hc < 64) return 1792 + (hc >> 5) * 64 + d;
    return 1920 + half * 64 + (hc - 64);
}
__device__ __forceinline__ int gumap(int n, int ff) { const int p = n >> 8, half = (n >> 7) & 1, hc = n & 127; return half * ff + p * 128 + hc; }
template <int MAP> __device__ __forceinline__ void transpose_item(const float* W, int Nsrc, int Ndst, bf16_t* WT, int ldwt, int koff, int ff, LAS float* scr, int item, int lane) {
    const int nblk = Ndst / 32, kb = item / nblk, nb = item % nblk, k0 = 64 * kb, n0 = 32 * nb;
    const int nd = n0 + (lane & 31); const int sc = MAP == 0 ? nd : (MAP == 1 ? zmap(nd) : gumap(nd, ff));
    float wv[32];
#pragma unroll
    for (int i = 0; i < 32; ++i) wv[i] = W[(size_t)(k0 + 2 * i + (lane >> 5)) * Nsrc + sc];
#pragma unroll
    for (int i = 0; i < 32; ++i) scr[(2 * i + (lane >> 5)) * 33 + (lane & 31)] = wv[i];
    LDS_WAIT(); asm volatile("" ::: "memory");
    const int c = lane & 7;
#pragma unroll
    for (int j = 0; j < 4; ++j) { const int n = (lane >> 3) + 8 * j; const LAS float* s = scr + (8 * c) * 33 + n;
        u32x4 o; o.x = cvt_pk_bf16(s[0 * 33], s[1 * 33]); o.y = cvt_pk_bf16(s[2 * 33], s[3 * 33]); o.z = cvt_pk_bf16(s[4 * 33], s[5 * 33]); o.w = cvt_pk_bf16(s[6 * 33], s[7 * 33]);
        *(u32x4*)(WT + (size_t)(n0 + n) * ldwt + koff + k0 + 8 * c) = o; }
    LDS_WAIT(); asm volatile("" ::: "memory");
}
template <int MAP> __device__ __forceinline__ void transpose_item8(const float* W, int Nsrc, int Ndst, unsigned char* WT, int ldwt, int ff, float scale, LAS float* scr, int item, int lane, int koff = 0) {
    const int nblk = Ndst / 32, kb = item / nblk, nb = item % nblk, k0 = 64 * kb, n0 = 32 * nb;
    const int nd = n0 + (lane & 31); const int sc = MAP == 0 ? nd : (MAP == 1 ? zmap(nd) : gumap(nd, ff));
    float wv[32];
#pragma unroll
    for (int i = 0; i < 32; ++i) wv[i] = W[(size_t)(k0 + 2 * i + (lane >> 5)) * Nsrc + sc];
#pragma unroll
    for (int i = 0; i < 32; ++i) scr[(2 * i + (lane >> 5)) * 33 + (lane & 31)] = wv[i] * scale;
    LDS_WAIT(); asm volatile("" ::: "memory");
    const int c = lane & 3;
#pragma unroll
    for (int j = 0; j < 2; ++j) { const int n = (lane >> 2) + 16 * j; const LAS float* s = scr + (16 * c) * 33 + n;
        u32x4 o; o.x = pk4_fp8(s[0 * 33], s[1 * 33], s[2 * 33], s[3 * 33]); o.y = pk4_fp8(s[4 * 33], s[5 * 33], s[6 * 33], s[7 * 33]); o.z = pk4_fp8(s[8 * 33], s[9 * 33], s[10 * 33], s[11 * 33]); o.w = pk4_fp8(s[12 * 33], s[13 * 33], s[14 * 33], s[15 * 33]);
        *(u32x4*)(WT + (size_t)(n0 + n) * ldwt + koff + k0 + 16 * c) = o; }
    LDS_WAIT(); asm volatile("" ::: "memory");
}
template <int MAP> __device__ __forceinline__ void transpose_class8(const Ctx& F, const float* W, size_t wstride, int K, int Nsrc, int Ndst, unsigned char* WT, size_t wtstride, int ldwt, int ff, float scale, int nmat, int koff = 0) {
    LAS float* scr = (LAS float*)(F.lds + F.wave * 16384);
    const int per = (K / 64) * (Ndst / 32), total = per * nmat, gw = F.wg * NWAVES + F.wave, NGW = F.G * NWAVES;
    for (int it = gw; it < total; it += NGW) { const int mi = it / per, r = it - mi * per;
        transpose_item8<MAP>(W + (size_t)mi * wstride, Nsrc, Ndst, WT + (size_t)mi * wtstride, ldwt, ff, scale, scr, r, F.lane, koff); }
}
template <int MAP> __device__ __forceinline__ void transpose_class(const Ctx& F, const float* W, size_t wstride, int K, int Nsrc, int Ndst, bf16_t* WT, size_t wtstride, int ldwt, int koff, int ff, int nmat) {
    LAS float* scr = (LAS float*)(F.lds + F.wave * 16384);
    const int per = (K / 64) * (Ndst / 32), total = per * nmat, gw = F.wg * NWAVES + F.wave, NGW = F.G * NWAVES;
    for (int it = gw; it < total; it += NGW) { const int mi = it / per, r = it - mi * per;
        transpose_item<MAP>(W + (size_t)mi * wstride, Nsrc, Ndst, WT + (size_t)mi * wtstride, ldwt, koff, ff, scr, r, F.lane); }
}
__device__ __forceinline__ void ada_tasks(const Ctx& F) {
    LAS float* St = (LAS float*)F.lds;
    LAS float* red = (LAS float*)(F.lds + 1024 * 20 * 4);
    const float* c = as_global(F.a->in[I_C]); const float* cc = as_global(F.a->in[I_CCTX]);
    bool have = false;
    for (int task = F.wg; task < DEPTH * 96; task += F.G) {
        if (!have) { for (int i = F.tid; i < NMODR * 1024; i += NTHREADS) { const int r = i >> 10, k = i & 1023; const float v = r < 16 ? c[r * 1024 + k] : cc[k]; St[k * 20 + r] = fast_silu(v); }
            LDS_WAIT(); __syncthreads(); have = true; }
        const int layer = task / 96, n0 = (task % 96) * 64; const float* W = as_global(F.a->in[I_WMOD]) + (size_t)layer * 1024 * 6144 + n0 + F.lane;
        float accv[NMODR];
#pragma unroll
        for (int r = 0; r < NMODR; ++r) accv[r] = 0.f;
        const int kb = F.wave * 128;
#pragma unroll 16
        for (int k = 0; k < 128; ++k) { const float w = W[(size_t)(kb + k) * 6144]; const LAS float* s = St + (kb + k) * 20;
            const f32x4 s0 = *(const LAS f32x4*)s, s1 = *(const LAS f32x4*)(s + 4), s2 = *(const LAS f32x4*)(s + 8), s3 = *(const LAS f32x4*)(s + 12); const float s4 = s[16];
#pragma unroll
            for (int j = 0; j < 4; ++j) { accv[j] += s0[j] * w; accv[4 + j] += s1[j] * w; accv[8 + j] += s2[j] * w; accv[12 + j] += s3[j] * w; }
            accv[16] += s4 * w; }
#pragma unroll
        for (int r = 0; r < NMODR; ++r) red[(F.wave * NMODR + r) * 64 + F.lane] = accv[r];
        LDS_WAIT(); __syncthreads();
        for (int i = F.tid; i < NMODR * 64; i += NTHREADS) { const int r = i >> 6, l = i & 63; float s = as_global(F.a->in[I_BMOD])[layer * 6144 + n0 + l];
#pragma unroll
            for (int w = 0; w < 8; ++w) s += red[(w * NMODR + r) * 64 + l];
            ((float*)(F.ws + WS_MOD))[((size_t)layer * NMODR + r) * 6144 + n0 + l] = s; }
        LDS_WAIT(); __syncthreads();
    }
    __syncthreads();
}
__device__ __forceinline__ void prologue_phase(const Ctx& F) {
    ada_tasks(F);
    const int gt = F.wg * NTHREADS + F.tid, NGT = F.G * NTHREADS;
    if (gt < 1024) { const int pos = gt >> 4, f = gt & 15; const double ang = (double)pos * pow(10000.0, -(double)f / 16.0);
        float* rp = (float*)(F.ws + WS_ROPE); rp[gt] = (float)cos(ang); rp[1024 + gt] = (float)sin(ang); }
    { const float* s = as_global(F.a->in[I_GWS]); bf16_t* d = (bf16_t*)(F.ws + WS_GWS);
      for (int i = gt; i < DEPTH * 4 * 128 * 128 / 2; i += NGT) ((unsigned*)d)[i] = cvt_pk_bf16(s[2 * i], s[2 * i + 1]); }
#if Z8
    transpose_class8<1>(F, as_global(F.a->in[I_WIN]), (size_t)D * DIN, D, DIN, 2048, (unsigned char*)(F.ws + WS_WIN), (size_t)2048 * D, D, 0, W_GU_SCALE, DEPTH);
#else
    transpose_class<1>(F, as_global(F.a->in[I_WIN]), (size_t)D * DIN, D, DIN, 2048, (bf16_t*)(F.ws + WS_WIN), (size_t)2048 * D, D, 0, 0, DEPTH);
#endif
    transpose_class8<0>(F, as_global(F.a->in[I_WIN]) + 2048, (size_t)D * DIN, D, DIN, 3072, (unsigned char*)(F.ws + WS_WG8), (size_t)3072 * D, D, 0, W_GU_SCALE, DEPTH);
    transpose_class<0>(F, as_global(F.a->in[I_WBC]), (size_t)256 * D, 256, D, D, (bf16_t*)(F.ws + WS_WBR), (size_t)D * D, D, 0, 0, DEPTH);
    transpose_class<0>(F, as_global(F.a->in[I_WBG]), (size_t)256 * D, 256, D, D, (bf16_t*)(F.ws + WS_WBR), (size_t)D * D, D, 256, 0, DEPTH);
    transpose_class<0>(F, as_global(F.a->in[I_WBA]), (size_t)512 * D, 512, D, D, (bf16_t*)(F.ws + WS_WBR), (size_t)D * D, D, 512, 0, DEPTH);
#if MERGE8
    for (int rep3 = 0; rep3 < 3; ++rep3) transpose_class8<0>(F, as_global(F.a->in[I_WOUT]), (size_t)D * D, D, D, D, (unsigned char*)(F.ws + WS_WO8), (size_t)D * 3072, 3072, 0, W_GU_SCALE, DEPTH, rep3 * 1024);
#else
    transpose_class<0>(F, as_global(F.a->in[I_WOUT]), (size_t)D * D, D, D, D, (bf16_t*)(F.ws + WS_WO), (size_t)D * D, D, 0, 0, DEPTH);
#endif
    transpose_class<2>(F, as_global(F.a->in[I_FGU]), (size_t)D * 2 * DFF, D, 2 * DFF, 2 * DFF, (bf16_t*)(F.ws + WS_FGU), (size_t)2 * DFF * D, D, 0, DFF, 1);
    transpose_class8<2>(F, as_global(F.a->in[I_FGU]) + (size_t)D * 2 * DFF, (size_t)D * 2 * DFF, D, 2 * DFF, 2 * DFF, (unsigned char*)(F.ws + WS_FGU) + (size_t)2 * DFF * D * 2, (size_t)2 * DFF * D, D, DFF, W_GU_SCALE, 1);
    transpose_class<0>(F, as_global(F.a->in[I_FD]), (size_t)DFF * D, DFF, D, D, (bf16_t*)(F.ws + WS_FD), (size_t)D * DFF, DFF, 0, 0, 1);
    transpose_class8<0>(F, as_global(F.a->in[I_FD]) + (size_t)DFF * D, (size_t)DFF * D, DFF, D, D, (unsigned char*)(F.ws + WS_FD) + (size_t)D * DFF * 2, (size_t)D * DFF, DFF, 0, W_D_SCALE, 1);
    transpose_class8<2>(F, as_global(F.a->in[I_MGU]), (size_t)D * 2 * DFE, D, 2 * DFE, 2 * DFE, (unsigned char*)(F.ws + WS_MGU), (size_t)2 * DFE * D, D, DFE, W_GU_SCALE, 2 * NEXP);
    transpose_class8<0>(F, as_global(F.a->in[I_MD]), (size_t)DFE * D, DFE, D, D, (unsigned char*)(F.ws + WS_MD), (size_t)D * DFE, DFE, 0, W_D_SCALE, 2 * NEXP);
    __syncthreads();
}

struct NormP {
    int M, layer;
    const float* xin_x; const float* xin_c; float* xout_x; float* xout_c;
    const float* gain; int chunk;
    bf16_t* HX; unsigned char* HX8;
    const float* g2prev;
    const float* router;
};
template <bool COMBINE, bool ROUTER, bool FINAL, bool OUT8 = false, bool DUAL = false> __device__ __forceinline__ void norm_phase(const Ctx& F, const NormP& P) {
    const float* MOD = (const float*)(F.ws + WS_MOD) + (size_t)P.layer * NMODR * 6144;
    const bf16_t* Y = (const bf16_t*)(F.ws + WS_RA); const f32x2* selw = (const f32x2*)(F.ws + WS_SELW);
    int* sel_e = (int*)(F.ws + WS_SELE); f32x2* selw_o = (f32x2*)(F.ws + WS_SELW);
    LAS float* RT = (LAS float*)F.lds; LAS int* cl = (LAS int*)(F.lds + 32768);
    if (ROUTER) { for (int i = F.tid; i < 8192; i += NTHREADS) RT[i] = P.router[i]; if (F.tid < 8) cl[F.tid] = 0; LDS_WAIT(); __syncthreads(); }
    const int nr = (P.M + F.G - 1) / F.G;
    const int r0 = ROUTER ? F.wg * nr : F.wg * NWAVES, r1 = ROUTER ? ((r0 + nr < P.M) ? r0 + nr : P.M) : P.M; const int rstep = ROUTER ? NWAVES : F.G * NWAVES;
    const int l4 = F.lane * 4;
    f32x4 gn[4], sh[4], sc[4], g2[4];
#pragma unroll
    for (int j = 0; j < 4; ++j) { gn[j] = *(const f32x4*)(P.gain + 256 * j + l4); sh[j] = sc[j] = g2[j] = (f32x4){0.f, 0.f, 0.f, 0.f}; }
    int curb = -1;
    f32x4 vn[4];
    { const int row = r0 + F.wave; if (row < r1) { const float* xr = row < TX ? P.xin_x + (size_t)row * D : P.xin_c + (size_t)(row - TX) * D;
#pragma unroll
        for (int j = 0; j < 4; ++j) vn[j] = *(const f32x4*)(xr + 256 * j + l4); } }
    for (int row = r0 + F.wave; row < r1; row += rstep) {
        const bool isx = row < TX; const int b = isx ? (row >> 12) : 16;
        if (b != curb) { curb = b;
#pragma unroll
            for (int j = 0; j < 4; ++j) { if (!FINAL) { sh[j] = *(const f32x4*)(MOD + (size_t)b * 6144 + P.chunk * 1024 + 256 * j + l4); sc[j] = *(const f32x4*)(MOD + (size_t)b * 6144 + (P.chunk + 1) * 1024 + 256 * j + l4); }
                if (COMBINE) g2[j] = *(const f32x4*)(P.g2prev + (size_t)b * 6144 + 256 * j + l4); } }
        f32x4 v[4];
#pragma unroll
        for (int j = 0; j < 4; ++j) v[j] = vn[j];
        { const int nrow = row + rstep; if (nrow < r1) { const float* xr = nrow < TX ? P.xin_x + (size_t)nrow * D : P.xin_c + (size_t)(nrow - TX) * D;
#pragma unroll
            for (int j = 0; j < 4; ++j) vn[j] = *(const f32x4*)(xr + 256 * j + l4); } }
        if (COMBINE) { const f32x2 w = selw[row]; float* xo = isx ? P.xout_x + (size_t)row * D : P.xout_c + (size_t)(row - TX) * D;
            u32x2 yq0[4], yq1[4];
#pragma unroll
            for (int j = 0; j < 4; ++j) { yq0[j] = *(const u32x2*)(Y + (size_t)row * D + 256 * j + l4); yq1[j] = *(const u32x2*)(Y + ((size_t)T + row) * D + 256 * j + l4); }
#pragma unroll
            for (int j = 0; j < 4; ++j) { const u32x2 y0 = yq0[j], y1 = yq1[j];
                const f32x4 a = (f32x4){bf_lo(y0.x), bf_hi(y0.x), bf_lo(y0.y), bf_hi(y0.y)}, c = (f32x4){bf_lo(y1.x), bf_hi(y1.x), bf_lo(y1.y), bf_hi(y1.y)};
                v[j] += g2[j] * (a * w.x + c * w.y); if (!FINAL) *(f32x4*)(xo + 256 * j + l4) = v[j]; } }
        float ss = 0.f;
#pragma unroll
        for (int j = 0; j < 4; ++j) ss += (v[j].x * v[j].x + v[j].y * v[j].y) + (v[j].z * v[j].z + v[j].w * v[j].w);
        const float rs = 1.0f / sqrtf(wave_sum(ss) * (1.0f / D) + EPS);
        if (FINAL) { float* xo = P.xout_x + (size_t)row * D;
#pragma unroll
            for (int j = 0; j < 4; ++j) *(f32x4*)(xo + 256 * j + l4) = v[j] * rs * gn[j];
        } else {
#pragma unroll
            for (int j = 0; j < 4; ++j) { v[j] = v[j] * rs * gn[j] * (sc[j] + 1.0f) + sh[j];
                if (OUT8) *(unsigned*)((unsigned char*)P.HX + (size_t)row * D + 256 * j + l4) = pk4_fp8(v[j].x * A8_SCALE, v[j].y * A8_SCALE, v[j].z * A8_SCALE, v[j].w * A8_SCALE);
                else { u32x2 o; o.x = cvt_pk_bf16(v[j].x, v[j].y); o.y = cvt_pk_bf16(v[j].z, v[j].w); *(u32x2*)(P.HX + (size_t)row * D + 256 * j + l4) = o;
                    if (DUAL) *(unsigned*)(P.HX8 + (size_t)row * D + 256 * j + l4) = pk4_fp8(v[j].x * A8_SCALE, v[j].y * A8_SCALE, v[j].z * A8_SCALE, v[j].w * A8_SCALE); } }
            if (ROUTER) { float lg[8];
#pragma unroll
                for (int e = 0; e < 8; ++e) lg[e] = 0.f;
#pragma unroll
                for (int j = 0; j < 4; ++j)
#pragma unroll
                    for (int q = 0; q < 4; ++q) { const LAS float* rp = RT + (256 * j + l4 + q) * 8; const f32x4 ra = *(const LAS f32x4*)rp, rb = *(const LAS f32x4*)(rp + 4); const float hv = v[j][q];
#pragma unroll
                        for (int e = 0; e < 4; ++e) { lg[e] += hv * ra[e]; lg[4 + e] += hv * rb[e]; } }
#pragma unroll
                for (int e = 0; e < 8; ++e) lg[e] = wave_sum(lg[e]);
                int e0 = 0; float v0 = lg[0];
#pragma unroll
                for (int e = 1; e < 8; ++e) if (lg[e] > v0) { v0 = lg[e]; e0 = e; }
                int e1 = -1; float v1 = -INFINITY;
#pragma unroll
                for (int e = 0; e < 8; ++e) if (e != e0 && lg[e] > v1) { v1 = lg[e]; e1 = e; }
                if (F.lane == 0) { const float w0 = 1.0f / (1.0f + expf(v1 - v0)); sel_e[row] = e0 | (e1 << 8); selw_o[row] = (f32x2){w0, 1.0f - w0};
                    __hip_atomic_fetch_add(cl + e0, 1, __ATOMIC_RELAXED, __HIP_MEMORY_SCOPE_WORKGROUP); __hip_atomic_fetch_add(cl + e1, 1, __ATOMIC_RELAXED, __HIP_MEMORY_SCOPE_WORKGROUP); } }
        }
    }
    if (ROUTER) { LDS_WAIT(); __syncthreads(); if (F.tid < 8) ((int*)(F.ws + WS_CNT))[F.wg * 8 + F.tid] = cl[F.tid]; }
    __syncthreads();
}

__device__ __forceinline__ void moe_gather_phase(const Ctx& F, int M, const bf16_t* HX) {
    LAS int* sm = (LAS int*)F.lds;
    const int* cnt = (const int*)(F.ws + WS_CNT); const int* sel_e = (const int*)(F.ws + WS_SELE);
    int* rinfo = (int*)(F.ws + WS_RINFO); unsigned char* AS = (unsigned char*)(F.ws + WS_RA);
    const int nr = (M + F.G - 1) / F.G, r0 = F.wg * nr, r1 = (r0 + nr < M) ? r0 + nr : M;
    { const int e = F.wave;
      int c4[4]; int s = 0;
#pragma unroll
      for (int j = 0; j < 4; ++j) { const int w = 4 * F.lane + j; c4[j] = (w < F.G) ? cnt[w * 8 + e] : 0; s += c4[j]; }
      int incl = s;
#pragma unroll
      for (int o = 1; o < 64; o <<= 1) { const int t = lane_read(incl, F.lane >= o ? F.lane - o : F.lane); if (F.lane >= o) incl += t; }
      const int tot = __builtin_amdgcn_readlane(incl, 63); int excl = incl - s;
      if (F.lane == (F.wg >> 2)) { for (int j = 0; j < (F.wg & 3); ++j) excl += c4[j]; sm[8 + e] = excl; }
      if (F.lane == 0) sm[e] = tot; }
    LDS_WAIT(); __syncthreads();
    if (F.tid == 0) { int s = 0; for (int e = 0; e < 8; ++e) { sm[16 + e] = s; s += (sm[e] + 255) & ~255; } sm[24] = s; }
    LDS_WAIT(); __syncthreads();
    if (F.wg == 0 && F.tid < 9) ((int*)(F.ws + WS_META))[F.tid] = sm[16 + F.tid] >> 8;
    if (F.wg < 8) { const int e = F.wg, lo = sm[16 + e] + sm[e], hi = sm[17 + e]; for (int i = lo + F.tid; i < hi; i += NTHREADS) rinfo[i] = -1; }
    LAS int* pos0 = sm + 64; LAS int* pos1 = pos0 + nr;
    if (F.wave == 0) { int run[8];
#pragma unroll
        for (int e = 0; e < 8; ++e) run[e] = sm[16 + e] + sm[8 + e];
        for (int base = r0; base < r1; base += 64) { const int t = base + F.lane; const bool valid = t < r1; const int ee = valid ? sel_e[t] : 0xffff; const int e0 = ee & 0xff, e1 = (ee >> 8) & 0xff;
            int p0 = 0, p1 = 0; const unsigned long long lt = (1ull << F.lane) - 1ull;
#pragma unroll
            for (int e = 0; e < 8; ++e) { const unsigned long long m = __ballot(valid && (e0 == e || e1 == e)); const int pc = __popcll(m & lt);
                if (e0 == e) p0 = run[e] + pc; if (e1 == e) p1 = run[e] + pc; run[e] += __popcll(m); }
            if (valid) { pos0[t - r0] = p0; pos1[t - r0] = p1; rinfo[p0] = t; rinfo[p1] = t | (1 << 20); } } }
    LDS_WAIT(); __syncthreads();
    for (int p0 = F.wave; p0 < 2 * (r1 - r0); p0 += 4 * NWAVES) {
        u32x4 rq[4]; int dsts[4];
#pragma unroll
        for (int e = 0; e < 4; ++e) { const int p = p0 + e * NWAVES; const bool ok = p < 2 * (r1 - r0); const int tl = ok ? (p >> 1) : 0, k = p & 1; dsts[e] = ok ? (k ? pos1[tl] : pos0[tl]) : -1;
            rq[e] = ((const u32x4*)((const unsigned char*)HX + (size_t)(r0 + tl) * D))[F.lane]; }
#pragma unroll
        for (int e = 0; e < 4; ++e) if (dsts[e] >= 0) ((u32x4*)(AS + (size_t)dsts[e] * D))[F.lane] = rq[e]; }
    __syncthreads();
}

constexpr int GM_PITCH = 272;
__device__ __forceinline__ void gmlp_units(const Ctx& F, int layer, int M, const bf16_t* ZG, bf16_t* Y) {
    const bf16_t* GWS = (const bf16_t*)(F.ws + WS_GWS) + (size_t)layer * 4 * 128 * 128; const float* GB = as_global(F.a->in[I_GB]) + layer * 512;
    const int g = F.wave >> 1, ph = F.wave & 1, r = F.lane & 31, h = F.lane >> 5;
    bf16x8 wf[2][8];
#pragma unroll
    for (int pt = 0; pt < 2; ++pt)
#pragma unroll
        for (int s = 0; s < 8; ++s) wf[pt][s] = *(const bf16x8*)(GWS + ((size_t)g * 128 + ph * 64 + 32 * pt + r) * 128 + 16 * s + 8 * h);
    float bsv[2];
#pragma unroll
    for (int pt = 0; pt < 2; ++pt) bsv[pt] = GB[g * 128 + ph * 64 + 32 * pt + r];
    LAS unsigned char* VT = F.lds;
    const int nchunk = M / 128;
    for (int ch = F.wg; ch < nchunk; ch += F.G) {
        const int r0 = ch * 128;
        u32x2 vq[16];
#pragma unroll
        for (int i = 0; i < 16; ++i) vq[i] = *(const u32x2*)(ZG + (size_t)(r0 + 16 * F.wave + i) * 512 + 256 + 4 * F.lane);
#pragma unroll
        for (int i = 0; i < 8; ++i) { const int q = 16 * F.wave + 2 * i;
            const u32x2 wa = vq[2 * i], wb = vq[2 * i + 1];
            f32x4 a = (f32x4){bf_lo(wa.x), bf_hi(wa.x), bf_lo(wa.y), bf_hi(wa.y)}, b = (f32x4){bf_lo(wb.x), bf_hi(wb.x), bf_lo(wb.y), bf_hi(wb.y)};
            const float ma = wave_sum((a.x + a.y) + (a.z + a.w)) * (1.0f / 256.0f), mb = wave_sum((b.x + b.y) + (b.z + b.w)) * (1.0f / 256.0f);
            a = a - ma; b = b - mb;
            const float va = wave_sum((a.x * a.x + a.y * a.y) + (a.z * a.z + a.w * a.w)) * (1.0f / 256.0f), vb = wave_sum((b.x * b.x + b.y * b.y) + (b.z * b.z + b.w * b.w)) * (1.0f / 256.0f);
            const float ra = 1.0f / sqrtf(va + EPS), rb = 1.0f / sqrtf(vb + EPS);
#pragma unroll
            for (int j = 0; j < 4; ++j) *(LAS unsigned*)(VT + (4 * F.lane + j) * GM_PITCH + 2 * q) = cvt_pk_bf16(a[j] * ra, b[j] * rb); }
        LDS_WAIT(); __syncthreads();
        f32x16 acc[2][2];
#pragma unroll
        for (int ct = 0; ct < 2; ++ct)
#pragma unroll
            for (int pt = 0; pt < 2; ++pt) acc[ct][pt] = f32x16{};
#pragma unroll
        for (int s = 0; s < 8; ++s)
#pragma unroll
            for (int ct = 0; ct < 2; ++ct) { const bf16x8 af = *(const LAS bf16x8*)(VT + (g * 64 + 32 * ct + r) * GM_PITCH + 32 * s + 16 * h);
#pragma unroll
                for (int pt = 0; pt < 2; ++pt) acc[ct][pt] = __builtin_amdgcn_mfma_f32_32x32x16_bf16(af, wf[pt][s], acc[ct][pt], 0, 0, 0); }
        u32x2 uq[2][2][4];
#pragma unroll
        for (int pt = 0; pt < 2; ++pt) { const size_t row = (size_t)(r0 + ph * 64 + 32 * pt + r);
#pragma unroll
            for (int ct = 0; ct < 2; ++ct)
#pragma unroll
                for (int rg = 0; rg < 4; ++rg) uq[pt][ct][rg] = *(const u32x2*)(ZG + row * 512 + g * 64 + 32 * ct + 8 * rg + 4 * h); }
#pragma unroll
        for (int pt = 0; pt < 2; ++pt) { const size_t row = (size_t)(r0 + ph * 64 + 32 * pt + r);
#pragma unroll
            for (int ct = 0; ct < 2; ++ct)
#pragma unroll
                for (int rg = 0; rg < 4; ++rg) { const int c0 = g * 64 + 32 * ct + 8 * rg + 4 * h; const u32x2 uw = uq[pt][ct][rg];
                    const float y0 = bf_lo(uw.x) * (acc[ct][pt][4 * rg + 0] + bsv[pt]), y1 = bf_hi(uw.x) * (acc[ct][pt][4 * rg + 1] + bsv[pt]);
                    const float y2 = bf_lo(uw.y) * (acc[ct][pt][4 * rg + 2] + bsv[pt]), y3 = bf_hi(uw.y) * (acc[ct][pt][4 * rg + 3] + bsv[pt]);
                    u32x2 o; o.x = cvt_pk_bf16(y0, y1); o.y = cvt_pk_bf16(y2, y3); *(u32x2*)(Y + row * D + 256 + c0) = o; } }
        LDS_WAIT(); __syncthreads();
    }
}
__device__ __forceinline__ void conv_units(const Ctx& F, int layer, int M, const bf16_t* ZC, bf16_t* Y) {
    const float* CW = as_global(F.a->in[I_CONVW]) + layer * 768;
    const int gt = F.wg * NTHREADS + F.tid, NGT = F.G * NTHREADS;
    for (int it0 = gt; it0 < M * 32; it0 += 2 * NGT) {
        u32x4 q[2][7]; bool act[2], hasp[2], hasn[2];
#pragma unroll
        for (int e = 0; e < 2; ++e) { const int it = it0 + e * NGT; act[e] = it < M * 32; const int row = act[e] ? (it >> 5) : 0, c0 = (it & 31) * 8;
            const int s = row < TX ? (row & (SEQ - 1)) : ((row - TX) & (CTXL - 1)), L = row < TX ? SEQ : CTXL; hasp[e] = s > 0; hasn[e] = s < L - 1;
            const bf16_t* zp = ZC + (size_t)row * 768 + c0;
            q[e][0] = *(const u32x4*)zp; q[e][1] = *(const u32x4*)(zp + 256); q[e][2] = *(const u32x4*)(zp + 512);
            q[e][3] = hasp[e] ? *(const u32x4*)(zp - 768 + 256) : (u32x4){0u, 0u, 0u, 0u}; q[e][4] = hasp[e] ? *(const u32x4*)(zp - 768 + 512) : (u32x4){0u, 0u, 0u, 0u};
            q[e][5] = hasn[e] ? *(const u32x4*)(zp + 768 + 256) : (u32x4){0u, 0u, 0u, 0u}; q[e][6] = hasn[e] ? *(const u32x4*)(zp + 768 + 512) : (u32x4){0u, 0u, 0u, 0u}; }
#pragma unroll
        for (int e = 0; e < 2; ++e) { if (!act[e]) continue; const int it = it0 + e * NGT, row = it >> 5, c0 = (it & 31) * 8;
            f32x4 bg0, bg1, c0a, c0b, h0a, h0b, ca, cb, ha, hb; unpack8(q[e][0], bg0, bg1); unpack8(q[e][1], c0a, c0b); unpack8(q[e][2], h0a, h0b);
            const f32x4 w0a = *(const f32x4*)(CW + c0), w0b = *(const f32x4*)(CW + c0 + 4), w1a = *(const f32x4*)(CW + 256 + c0), w1b = *(const f32x4*)(CW + 256 + c0 + 4), w2a = *(const f32x4*)(CW + 512 + c0), w2b = *(const f32x4*)(CW + 512 + c0 + 4);
            f32x4 sa = w1a * (c0a * h0a), sb = w1b * (c0b * h0b);
            unpack8(q[e][3], ca, cb); unpack8(q[e][4], ha, hb); sa += w0a * (ca * ha); sb += w0b * (cb * hb);
            unpack8(q[e][5], ca, cb); unpack8(q[e][6], ha, hb); sa += w2a * (ca * ha); sb += w2b * (cb * hb);
            *(u32x4*)(Y + (size_t)row * D + c0) = pack8(bg0 * sa, bg1 * sb); }
    }
}
__device__ __forceinline__ void mixer_phase(const Ctx& F, int layer, bool ctx_out) {
    GAS unsigned char* rh = F.ws + WS_RH;
    const attn_body::bf16* Q = (const attn_body::bf16*)(rh + RH_Q); const attn_body::bf16* K = (const attn_body::bf16*)(rh + RH_K); const attn_body::bf16* V = (const attn_body::bf16*)(rh + RH_V);
    attn_body::bf16* Y = (attn_body::bf16*)(rh + RH_BUFA);
    const float* sink = as_global(F.a->in[I_SINK]) + layer * 8;
    char* shm = (char*)F.lds;
    for (int uid = F.wg; uid < NB * 32 * 4; uid += F.G) {
        const int hp = uid & 3, n = (uid >> 2) & 31, b = uid >> 7, kvh = hp >> 1, head = 2 * hp + (F.wave >> 2);
        const int i_lo = n == 0 ? 2 : 0, i_hi = n == 31 ? 3 : 5, NT = 4 + (i_hi - i_lo + 1);
        const int qrow = b * SEQ + n * 128 + 32 * (F.wave & 3), lrow0 = b * SEQ + n * 128 - 128 + 64 * i_lo, crow0 = TX + b * CTXL;
        const int qoff0 = 32 * (F.wave & 3) + 128 - 64 * i_lo;
        attn_body::attn_unit<8>(Q + (size_t)qrow * 512 + head * 64, K + kvh * 64, V + kvh * 64, Y + (size_t)qrow * D + 512 + head * 64, crow0, lrow0, NT, qoff0, sink[head] * 1.4426950408889634f, shm);
    }
    if (ctx_out) for (int uid = F.wg; uid < NB * 4 * 2; uid += F.G) {
        const int hp = uid & 3, half = (uid >> 2) & 1, b = uid >> 3, kvh = hp >> 1, head = 2 * hp + (F.wave >> 2);
        const int qrow = TX + b * CTXL + half * 128 + 32 * (F.wave & 3), crow0 = TX + b * CTXL;
        attn_body::attn_unit<8>(Q + (size_t)qrow * 512 + head * 64, K + kvh * 64, V + kvh * 64, Y + (size_t)qrow * D + 512 + head * 64, crow0, 0, 4, 0, sink[head] * 1.4426950408889634f, shm);
    }
    __syncthreads();
    const int M = ctx_out ? T : TX;
#ifndef REP_GC
#define REP_GC 0
#endif
    _Pragma("nounroll") for (int rep_ = 0; rep_ < 1 + ((REP_GC >> 0) & 1); ++rep_) gmlp_units(F, layer, M, (const bf16_t*)(rh + RH_ZG), (bf16_t*)(rh + RH_BUFA));
    _Pragma("nounroll") for (int rep_ = 0; rep_ < 1 + ((REP_GC >> 1) & 1); ++rep_) conv_units(F, layer, M, (const bf16_t*)(rh + RH_ZC), (bf16_t*)(rh + RH_BUFA));
}

constexpr int NPHASES = 38;
__global__ void __launch_bounds__(NTHREADS, 2) fwd(Args args) {
    extern __shared__ __attribute__((aligned(16))) unsigned char lds_[];
    Ctx F; F.lds = (LAS unsigned char*)lds_; F.tid = threadIdx.x; F.lane = F.tid & 63; F.wave = __builtin_amdgcn_readfirstlane(F.tid >> 6); F.G = gridDim.x; F.wg = blockIdx.x; F.a = (const Args __attribute__((address_space(4)))*)__builtin_amdgcn_kernarg_segment_ptr(); F.ws = F.a->ws;
    volatile LAS unsigned* MISC = (volatile LAS unsigned*)(F.lds + MISC_OFF);
    for (int u = F.tid; u < (LDS_BYTES - MISC_OFF) / 4; u += NTHREADS) ((LAS unsigned*)(F.lds + MISC_OFF))[u] = 0u;
    __syncthreads();
    if (F.lane == 0) *(volatile LAS int*)(unsigned long)(WAVEMAP_OFF + 4 * hw_wave_key()) = F.wave;
    __syncthreads();
    XcdBarrier bar = xcd_barrier_post((unsigned*)(F.ws + WS_CTL) + CW_BAR, MISC + 8);
    const int lo = F.a->ph_lo, hi = F.a->ph_hi;
#ifndef PHMASK
#define PHMASK 0xffff
#endif
#define EN(b) ((PHMASK >> (b)) & 1)
#ifndef REP_MASK
#define REP_MASK 0
#endif
#define REPS(b) _Pragma("nounroll") for (int rep_ = 0; rep_ < (((REP_MASK >> (b)) & 1) ? 2 : 1); ++rep_)
#define IN(k) (lo <= (k) && (k) < hi)
#define SEAM(a, b) do { if (IN(a) && IN(b)) xcd_barrier(bar); } while (0)
#define REFRESH_G() do { const Args __attribute__((address_space(4)))* a_ = (const Args __attribute__((address_space(4)))*)__builtin_amdgcn_kernarg_segment_ptr(); asm volatile("" : "+s"(a_)); F.a = a_; GAS unsigned char* w_ = a_->ws; asm volatile("" : "+s"(w_)); F.ws = w_; } while (0)
#define REFRESH() do { F.tid = opaque_tid(); F.lane = F.tid & 63; F.wave = __builtin_amdgcn_readfirstlane(F.tid >> 6); const Args __attribute__((address_space(4)))* a_ = (const Args __attribute__((address_space(4)))*)__builtin_amdgcn_kernarg_segment_ptr(); asm volatile("" : "+s"(a_)); F.a = a_; GAS unsigned char* w_ = a_->ws; asm volatile("" : "+s"(w_)); F.ws = w_; } while (0)
#define rh (F.ws + WS_RH)
#define BUFA ((bf16_t*)(F.ws + WS_RH + RH_BUFA))
#define BUFB ((bf16_t*)(F.ws + WS_RH + RH_BUFB))
#define XC ((float*)(F.ws + WS_XC))
#define MODALL ((const float*)(F.ws + WS_MOD))

    if (EN(0) && IN(0)) REPS(0) { REFRESH(); prologue_phase(F); }
    SEAM(0, 1);
#pragma nounroll
    for (int i = 0; i < DEPTH; ++i) {
        const int pb = 1 + 9 * i; const bool moe = (i & 1) != 0, last = (i == DEPTH - 1); const int j = i >> 1;
        const int Mact = last ? TX : T, nMact = Mact / 256;
#define MODL (MODALL + (size_t)i * NMODR * 6144)
        if (EN(1) && IN(pb + 0)) REPS(1) { REFRESH(); NormP P; P.M = T; P.layer = i; P.xin_x = i == 0 ? as_global(F.a->in[I_X]) : as_global(F.a->out); P.xin_c = i == 0 ? as_global(F.a->in[I_CTX]) : XC; P.xout_x = as_global(F.a->out); P.xout_c = XC;
            P.gain = as_global(F.a->in[I_N1G]) + i * D; P.chunk = 0; P.HX = BUFA; P.g2prev = MODALL + (size_t)(i - 1) * NMODR * 6144 + 5 * D; P.router = nullptr;
            P.HX8 = (unsigned char*)BUFB;
            if (i == 2) norm_phase<true, false, false, false, true>(F, P); else norm_phase<false, false, false, false, true>(F, P); }
        SEAM(pb + 0, pb + 1);
        if (EN(2) && IN(pb + 1)) REPS(2) { REFRESH_G();
#if Z8
            { pg8::DenseSched S{(const char*)BUFB, (const char*)(F.ws + WS_WIN) + (size_t)i * 2048 * D, 1024u, 1024u, nMact, 8, D / 128, F.G, F.wg, last ? TC / 256 : 0, NPX, 7};
              pg8::EpiZ E{(bf16_t*)(rh + RH_ZC), (bf16_t*)(rh + RH_ZG), (bf16_t*)(rh + RH_Q), (bf16_t*)(rh + RH_K), (bf16_t*)(rh + RH_V), (bf16_t*)(rh + RH_G), (const float*)(F.ws + WS_ROPE), 1.0f / (A8_SCALE * W_GU_SCALE)};
              pg8::gemm_phase<pg8::EpiZ, pg8::DenseSched, true>(F.lds, 1024u, 1024u, S, E); }
#else
            { pg8::DenseSched S{(const char*)BUFA, (const char*)(F.ws + WS_WIN) + (size_t)i * 2048 * D * 2, 2048u, 2048u, nMact, 8, 16, F.G, F.wg, last ? TC / 256 : 0, NPX, 7};
              pg8::EpiZ E{(bf16_t*)(rh + RH_ZC), (bf16_t*)(rh + RH_ZG), (bf16_t*)(rh + RH_Q), (bf16_t*)(rh + RH_K), (bf16_t*)(rh + RH_V), (bf16_t*)(rh + RH_G), (const float*)(F.ws + WS_ROPE), 1.0f};
              pg8::gemm_phase(F.lds, 2048u, 2048u, S, E); }
#endif
            { pg8::DenseSched S{(const char*)BUFB, (const char*)(F.ws + WS_WG8) + (size_t)i * 3072 * D, 1024u, 1024u, nMact, 12, D / 128, F.G, F.wg, 0, 0, 0};
              pg8::EpiGate8 E{(bf16_t*)(rh + RH_G)};
              pg8::gemm_phase<pg8::EpiGate8, pg8::DenseSched, true>(F.lds, 1024u, 1024u, S, E); } }
        SEAM(pb + 1, pb + 2);
        if (EN(3) && IN(pb + 2)) REPS(3) { REFRESH(); mixer_phase(F, i, !last); }
        SEAM(pb + 2, pb + 3);
#if MERGE8
        if (EN(4) && IN(pb + 3)) REPS(4) { REFRESH_G(); pg8::Merge12Sched S{(const char*)BUFA, (const char*)(F.ws + WS_WBR) + (size_t)i * D * D * 2, nMact, F.G, F.wg};
            pg8::EpiMerge8 E{(const bf16_t*)(rh + RH_G), (unsigned char*)(rh + RH_GP8)};
            pg8::gemm_phase(F.lds, 2048u, 2048u, S, E); }
#else
        if (EN(4) && IN(pb + 3)) REPS(4) { REFRESH_G(); pg8::MergeSched S{(const char*)BUFA, (const char*)(F.ws + WS_WBR) + (size_t)i * D * D * 2, nMact, F.G, F.wg};
            pg8::EpiMerge E{(const bf16_t*)(rh + RH_G), BUFB};
            pg8::gemm_phase(F.lds, 2048u, 2048u, S, E); }
#endif
        SEAM(pb + 3, pb + 4);
#if MERGE8
        if (EN(5) && IN(pb + 4)) REPS(5) { REFRESH_G(); pg8::DenseSched S{(const char*)(rh + RH_GP8), (const char*)(F.ws + WS_WO8) + (size_t)i * D * 3072, 3072u, 3072u, nMact, 4, 3072 / 128, F.G, F.wg, 0, 0, 0};
            pg8::EpiResid E{i == 0 ? as_global(F.a->in[I_X]) : as_global(F.a->out), i == 0 ? as_global(F.a->in[I_CTX]) : XC, as_global(F.a->out), XC, MODL + 2 * D, 1.0f / (GP8_SCALE * W_GU_SCALE)};
            pg8::gemm_phase<pg8::EpiResid, pg8::DenseSched, true>(F.lds, 3072u, 3072u, S, E); }
#else
        if (EN(5) && IN(pb + 4)) REPS(5) { REFRESH_G(); pg8::DenseSched S{(const char*)BUFB, (const char*)(F.ws + WS_WO) + (size_t)i * D * D * 2, 2048u, 2048u, nMact, 4, 16, F.G, F.wg, 0, 0, 0};
            pg8::EpiResid E{i == 0 ? as_global(F.a->in[I_X]) : as_global(F.a->out), i == 0 ? as_global(F.a->in[I_CTX]) : XC, as_global(F.a->out), XC, MODL + 2 * D, 1.0f};
            pg8::gemm_phase(F.lds, 2048u, 2048u, S, E); }
#endif
        SEAM(pb + 4, pb + 5);
        if (EN(6) && IN(pb + 5)) REPS(6) { REFRESH(); NormP P; P.M = Mact; P.layer = i; P.xin_x = as_global(F.a->out); P.xin_c = XC; P.xout_x = as_global(F.a->out); P.xout_c = XC; P.gain = as_global(F.a->in[I_N2G]) + i * D; P.chunk = 3; P.HX = BUFA; P.g2prev = nullptr;
            P.router = as_global(F.a->in[I_ROUTER]) + (size_t)j * D * NEXP;
            if (moe) norm_phase<false, true, false, true>(F, P); else if (i == 0) norm_phase<false, false, false>(F, P); else norm_phase<false, false, false, true>(F, P); }
        if (moe) {
            SEAM(pb + 5, pb + 6);
            if (EN(7) && IN(pb + 6)) REPS(7) { REFRESH(); moe_gather_phase(F, Mact, BUFA); }
            SEAM(pb + 6, pb + 7);
            if (EN(8) && IN(pb + 7)) REPS(8) { REFRESH_G(); pg8::MoeSched S; S.A = (const char*)(F.ws + WS_RA); S.B = (const char*)(F.ws + WS_MGU) + (size_t)j * NEXP * 2 * DFE * D; S.lda = 1024u; S.ldb = 1024u; S.estride = (size_t)2 * DFE * D;
                S.nN = 2 * DFE / 256; S.nt = D / 128; S.G = F.G; S.c = F.wg;
#pragma unroll
                for (int k = 0; k < 9; ++k) S.P[k] = __builtin_amdgcn_readfirstlane(((const int*)(F.ws + WS_META))[k]);
                pg8::EpiGU8 E{(unsigned char*)rh, DFE};
                pg8::gemm_phase<pg8::EpiGU8, pg8::MoeSched, true>(F.lds, 1024u, 1024u, S, E); }
            SEAM(pb + 7, pb + 8);
            if (EN(9) && IN(pb + 8)) REPS(9) { REFRESH_G(); pg8::MoeSched S; S.A = (const char*)rh; S.B = (const char*)(F.ws + WS_MD) + (size_t)j * NEXP * D * DFE; S.lda = (unsigned)DFE; S.ldb = (unsigned)DFE; S.estride = (size_t)D * DFE;
                S.nN = 4; S.nt = DFE / 128; S.G = F.G; S.c = F.wg;
#pragma unroll
                for (int k = 0; k < 9; ++k) S.P[k] = __builtin_amdgcn_readfirstlane(((const int*)(F.ws + WS_META))[k]);
                pg8::EpiMoeDown E{(const int*)(F.ws + WS_RINFO), (bf16_t*)(F.ws + WS_RA), 1.0f / (H8_SCALE * W_D_SCALE)};
                pg8::gemm_phase<pg8::EpiMoeDown, pg8::MoeSched, true>(F.lds, (unsigned)DFE, (unsigned)DFE, S, E); }
        } else {
            SEAM(pb + 5, pb + 7);
            if (EN(10) && IN(pb + 7)) REPS(10) { REFRESH_G();
                if (i == 0) { pg8::DenseSched S{(const char*)BUFA, (const char*)(F.ws + WS_FGU), 2048u, 2048u, nMact, 2 * DFF / 256, 16, F.G, F.wg, 0, 0, 0};
                    pg8::EpiGU E{(bf16_t*)(rh + RH_HD), DFF};
                    pg8::gemm_phase(F.lds, 2048u, 2048u, S, E); }
                else { pg8::DenseSched S{(const char*)BUFA, (const char*)(F.ws + WS_FGU) + (size_t)2 * DFF * D * 2, 1024u, 1024u, nMact, 2 * DFF / 256, D / 128, F.G, F.wg, 0, 0, 0};
                    pg8::EpiGU8 E{(unsigned char*)(rh + RH_HD), DFF};
                    pg8::gemm_phase<pg8::EpiGU8, pg8::DenseSched, true>(F.lds, 1024u, 1024u, S, E); } }
            SEAM(pb + 7, pb + 8);
            if (EN(11) && IN(pb + 8)) REPS(11) { REFRESH_G();
                if (i == 0) { pg8::DenseSched S{(const char*)(rh + RH_HD), (const char*)(F.ws + WS_FD), 2u * DFF, 2u * DFF, nMact, 4, DFF / 64, F.G, F.wg, 0, 0, 0};
                    pg8::EpiResid E{as_global(F.a->out), XC, as_global(F.a->out), XC, MODL + 5 * D, 1.0f};
                    pg8::gemm_phase(F.lds, 2u * DFF, 2u * DFF, S, E); }
                else { pg8::DenseSched S{(const char*)(rh + RH_HD), (const char*)(F.ws + WS_FD) + (size_t)D * DFF * 2, (unsigned)DFF, (unsigned)DFF, nMact, 4, DFF / 128, F.G, F.wg, 0, 0, 0};
                    pg8::EpiResid E{as_global(F.a->out), XC, as_global(F.a->out), XC, MODL + 5 * D, 1.0f / (H8_SCALE * W_D_SCALE)};
                    pg8::gemm_phase<pg8::EpiResid, pg8::DenseSched, true>(F.lds, (unsigned)DFF, (unsigned)DFF, S, E); } }
        }
        SEAM(pb + 8, pb + 9);
    }
    if (EN(12) && IN(37)) REPS(12) { REFRESH(); NormP P; P.M = TX; P.layer = DEPTH - 1; P.xin_x = as_global(F.a->out); P.xin_c = XC; P.xout_x = as_global(F.a->out); P.xout_c = XC; P.gain = as_global(F.a->in[I_FNG]); P.chunk = 0; P.HX = nullptr;
        P.g2prev = MODALL + (size_t)(DEPTH - 1) * NMODR * 6144 + 5 * D; P.router = nullptr;
        norm_phase<true, false, true>(F, P); }
#undef IN
#undef SEAM
#undef rh
#undef BUFA
#undef BUFB
#undef XC
#undef MODALL
#undef MODL
}


extern "C" void kernel_launch(void* const* d_in, const int* in_sizes, int n_in, void* d_out, int out_size, void* d_ws, size_t ws_size, hipStream_t stream) {
    static int grid = 0;
    if (grid == 0) {
        if (n_in != 23 || out_size != TX * D || ws_size < WS_END) { fprintf(stderr, "kernel_launch: unexpected shapes (n_in %d, out %d, ws %zu < %zu)\n", n_in, out_size, ws_size, (size_t)WS_END); grid = -1; return; }
        int dev = 0, cus = 0, per_cu = 0;
        if (hipGetDevice(&dev) != hipSuccess || hipDeviceGetAttribute(&cus, hipDeviceAttributeMultiprocessorCount, dev) != hipSuccess) { grid = -1; return; }
        if (hipFuncSetAttribute((const void*)fwd, hipFuncAttributeMaxDynamicSharedMemorySize, LDS_BYTES) != hipSuccess) { fprintf(stderr, "kernel_launch: hipFuncSetAttribute failed\n"); grid = -1; return; }
        if (hipOccupancyMaxActiveBlocksPerMultiprocessor(&per_cu, (const void*)fwd, NTHREADS, LDS_BYTES) != hipSuccess || per_cu < 1) fprintf(stderr, "kernel_launch: occupancy query says %d\n", per_cu);
        (void)hipGetLastError();
        grid = cus > 256 ? 256 : cus;
    }
    if (grid < 0) return;
    (void)hipMemsetAsync((char*)d_ws + WS_CTL, 0, CTL_BYTES, stream);
    Args a{};
    for (int i = 0; i < 23; ++i) a.in[i] = (GAS const float*)d_in[i];
    a.out = (GAS float*)d_out; a.ws = (GAS unsigned char*)d_ws;
#if MK_MULTI
    for (int p = 0; p < NPHASES; ++p) { if (p >= 1 && p < 37) { const int i = (p - 1) / 9, k = (p - 1) % 9; if (k == 6 && !(i & 1)) continue; }
        a.ph_lo = p; a.ph_hi = p + 1; hipLaunchKernelGGL(fwd, dim3(grid), dim3(NTHREADS), LDS_BYTES, stream, a); }
#else
    a.ph_lo = 0; a.ph_hi = NPHASES;
    hipLaunchKernelGGL(fwd, dim3(grid), dim3(NTHREADS), LDS_BYTES, stream, a);
#endif
    const hipError_t le = hipPeekAtLastError();
    if (le != hipSuccess) fprintf(stderr, "kernel_launch: launch failed: %s\n", hipGetErrorName(le));
}
```

```cpp
#include <hip/hip_runtime.h>
#include <hip/hip_bf16.h>
#include <cstdio>
#include <cstdint>

#ifndef USE_AGPR
#define USE_AGPR 0
#endif
#ifndef Z8
#define Z8 0
#endif
#ifndef MERGE8
#define MERGE8 0
#endif
#ifndef MK_MULTI
#define MK_MULTI 0
#endif

constexpr int D = 1024, NB = 16, SEQ = 4096, CTXL = 256, DEPTH = 4;
constexpr int TX = NB * SEQ, TC = NB * CTXL, T = TX + TC;
constexpr int DIN = 5120, DFF = 2816, DFE = 3584, NEXP = 8, NMODR = 17;
constexpr int NPX = TX / 256, NPA = T / 256;
constexpr int SROWS = 2 * T + 2048;
constexpr float EPS = 1e-6f;
constexpr float QSCALE = 0.125f * 1.4426950408889634f;
constexpr float A8_SCALE = 8.0f, W_GU_SCALE = 64.0f, H8_SCALE = 4.0f, W_D_SCALE = 128.0f, GP8_SCALE = 16.0f;

constexpr size_t al256(size_t x) { return (x + 255) & ~(size_t)255; }
constexpr size_t WS_CTL = 0, CTL_BYTES = 1u << 20;
constexpr size_t WS_MOD = WS_CTL + CTL_BYTES;
constexpr size_t WS_ROPE = WS_MOD + al256((size_t)DEPTH * NMODR * 6 * D * 4);
constexpr size_t WS_GWS = WS_ROPE + 8192;
constexpr size_t WS_SELE = WS_GWS + (size_t)DEPTH * 4 * 128 * 128 * 2;
constexpr size_t WS_SELW = WS_SELE + al256((size_t)T * 4);
constexpr size_t WS_CNT = WS_SELW + al256((size_t)T * 8);
constexpr size_t WS_META = WS_CNT + 8192;
constexpr size_t WS_RINFO = WS_META + 256;
constexpr size_t WS_XC = WS_RINFO + al256((size_t)SROWS * 4);
constexpr size_t WS_WIN = WS_XC + (size_t)TC * D * 4;
constexpr size_t WS_WG8 = WS_WIN + (size_t)DEPTH * 2048 * D * 2;
constexpr size_t WS_WO8 = WS_WG8 + (size_t)DEPTH * 3072 * D;
static_assert(WS_WO8 + (size_t)DEPTH * D * 3072 <= WS_WIN + (size_t)DEPTH * DIN * D * 2, "fp8 copies fit the w_in region");
constexpr size_t WS_WBR = WS_WIN + (size_t)DEPTH * DIN * D * 2;
constexpr size_t WS_WO = WS_WBR + (size_t)DEPTH * D * D * 2;
constexpr size_t WS_FGU = WS_WO + (size_t)DEPTH * D * D * 2;
constexpr size_t WS_FD = WS_FGU + (size_t)2 * 2 * DFF * D * 2;
constexpr size_t WS_MGU = WS_FD + (size_t)2 * D * DFF * 2;
constexpr size_t WS_MD = WS_MGU + (size_t)2 * NEXP * 2 * DFE * D;
constexpr size_t WS_RA = WS_MD + (size_t)2 * NEXP * D * DFE;
constexpr size_t RA_BYTES = (size_t)SROWS * D * 2;
constexpr size_t WS_RH = WS_RA + RA_BYTES;
constexpr size_t RH_BYTES = (size_t)SROWS * DFE * 2;
constexpr size_t WS_END = WS_RH + RH_BYTES;
static_assert((size_t)2 * T * D * 2 <= RA_BYTES, "Yslot fits region A");
static_assert(WS_END <= (size_t)1879048192, "d_ws map exceeds 4x largest tensor");
constexpr size_t RH_ZC = 0;
constexpr size_t RH_ZG = RH_ZC + (size_t)T * 768 * 2;
constexpr size_t RH_Q = RH_ZG + (size_t)T * 512 * 2;
constexpr size_t RH_K = RH_Q + (size_t)T * 512 * 2;
constexpr size_t RH_V = RH_K + (size_t)T * 128 * 2;
constexpr size_t RH_G = RH_V + (size_t)T * 128 * 2;
constexpr size_t RH_ZEND = RH_G + (size_t)T * 3072 * 2;
constexpr size_t RH_BUFA = RH_ZEND;
constexpr size_t RH_BUFB = RH_BUFA + (size_t)T * D * 2;
constexpr size_t RH_GP8 = 0;
static_assert((size_t)T * 3072 <= RH_G, "gated products fit below the gates");
constexpr size_t RH_MIXP = 0;
constexpr size_t RH_HD = 0;
static_assert(RH_BUFB + (size_t)T * D * 2 <= RH_BYTES && (size_t)T * DFF * 2 <= RH_ZEND, "region H overlays");

#define LAS __attribute__((address_space(3)))
#define GAS __attribute__((address_space(1)))
typedef unsigned short bf16_t;
typedef short bf16x8 __attribute__((ext_vector_type(8)));
typedef float f32x4 __attribute__((ext_vector_type(4)));
typedef float f32x2 __attribute__((ext_vector_type(2)));
typedef float f32x16 __attribute__((ext_vector_type(16)));
typedef unsigned u32x4 __attribute__((ext_vector_type(4)));
typedef unsigned u32x2 __attribute__((ext_vector_type(2)));
#define LDS_WAIT() asm volatile("s_waitcnt lgkmcnt(0)" ::: "memory")
#define VM_WAIT() asm volatile("s_waitcnt vmcnt(0)" ::: "memory")

typedef __bf16 bf16x2_v __attribute__((ext_vector_type(2)));
__device__ __forceinline__ unsigned cvt_pk_bf16(float lo, float hi) { const f32x2 v = {lo, hi}; const bf16x2_v b = __builtin_convertvector(v, bf16x2_v); return __builtin_bit_cast(unsigned, b); }
__device__ __forceinline__ float clamp8(float v) { return __builtin_fminf(__builtin_fmaxf(v, -448.0f), 448.0f); }
__device__ __forceinline__ unsigned pk4_fp8(float a, float b, float c, float d) { int w = 0; w = __builtin_amdgcn_cvt_pk_fp8_f32(clamp8(a), clamp8(b), w, false); w = __builtin_amdgcn_cvt_pk_fp8_f32(clamp8(c), clamp8(d), w, true); return (unsigned)w; }
__device__ __forceinline__ float bf_lo(unsigned u) { return __uint_as_float(u << 16); }
__device__ __forceinline__ float bf_hi(unsigned u) { return __uint_as_float(u & 0xffff0000u); }
__device__ __forceinline__ u32x4 pack8(f32x4 a, f32x4 b) { u32x4 w; w.x = cvt_pk_bf16(a[0], a[1]); w.y = cvt_pk_bf16(a[2], a[3]); w.z = cvt_pk_bf16(b[0], b[1]); w.w = cvt_pk_bf16(b[2], b[3]); return w; }
__device__ __forceinline__ void unpack8(u32x4 w, f32x4& a, f32x4& b) { a = (f32x4){bf_lo(w.x), bf_hi(w.x), bf_lo(w.y), bf_hi(w.y)}; b = (f32x4){bf_lo(w.z), bf_hi(w.z), bf_lo(w.w), bf_hi(w.w)}; }
__device__ __forceinline__ float fast_sigmoid(float x) { return __builtin_amdgcn_rcpf(1.0f + __builtin_amdgcn_exp2f(-1.4426950408889634f * x)); }
__device__ __forceinline__ float fast_silu(float x) { return x * fast_sigmoid(x); }
__device__ __forceinline__ float gelu_tanh(float x) { const float t = x * (1.0f + 0.044715f * x * x); return x * __builtin_amdgcn_rcpf(1.0f + __builtin_amdgcn_exp2f(-2.302208198f * t)); }
template <class Tp> __device__ __forceinline__ Tp* as_global(GAS Tp* p) { return (Tp*)p; }
template <int K> __device__ __forceinline__ float xor_lane(float v) { return __int_as_float(__builtin_amdgcn_ds_swizzle(__float_as_int(v), (K << 10) | 0x1F)); }
__device__ __forceinline__ float wave_sum(float v) {
    v += xor_lane<1>(v); v += xor_lane<2>(v); v += xor_lane<4>(v); v += xor_lane<8>(v); v += xor_lane<16>(v);
    const auto rr = __builtin_amdgcn_permlane32_swap(__float_as_uint(v), __float_as_uint(v), false, false);
    return __uint_as_float(rr[0]) + __uint_as_float(rr[1]);
}
__device__ __forceinline__ int lane_read(int v, int srclane) { return __builtin_amdgcn_ds_bpermute(srclane << 2, v); }

constexpr int WAVEMAP_OFF = 131072 + 256;
__device__ __forceinline__ int hw_wave_key() { return (int)(__builtin_amdgcn_s_getreg((6 << 11) | 4) & 63u); }
__device__ __forceinline__ int opaque_tid() { int key_ = hw_wave_key(); asm volatile("" : "+s"(key_)); int w = *(volatile LAS int*)(unsigned long)(WAVEMAP_OFF + 4 * key_); unsigned z0 = 0u; asm volatile("" : "+v"(z0)); int l = (int)__builtin_amdgcn_mbcnt_hi(~0u, __builtin_amdgcn_mbcnt_lo(~0u, z0)); int t = (w << 6) | l; asm volatile("" : "+v"(t)); return t; }
#define XB_TMO      128
#define XB_XCNT(j)  (256  + 64 * (j))
#define XB_XSUB(j)  (1280 + 64 * (j))
#define XB_XGEN(j)  (2304 + 64 * (j))
#define XB_TOP      3328
#define XB_TOPGEN   3392
#define XCD_BAR_WORDS 3456
#define XB_SPIN_CAP (1u << 18)
__device__ __forceinline__ unsigned xb_ld(unsigned* p)              { return __hip_atomic_load(p, __ATOMIC_RELAXED, __HIP_MEMORY_SCOPE_AGENT); }
__device__ __forceinline__ unsigned xb_add(unsigned* p, unsigned v) { return __hip_atomic_fetch_add(p, v, __ATOMIC_RELAXED, __HIP_MEMORY_SCOPE_AGENT); }
__device__ __forceinline__ unsigned xb_xcc_id() { return (unsigned)__builtin_amdgcn_s_getreg((3 << 11) | 20) & 0xFu; }
#define XB_SPIN(cond, bar) do { unsigned _sp = 0; while (cond) { __builtin_amdgcn_s_sleep(1); \
    if ((++_sp & 255u) == 0u) { if (xb_ld(&(bar)[XB_TMO])) break; if (_sp > XB_SPIN_CAP) { atomicAdd(&(bar)[XB_TMO], 1u); break; } } } } while (0)
struct XcdBarrier { unsigned* bar; unsigned x; volatile LAS unsigned* st; };
__device__ __forceinline__ XcdBarrier xcd_barrier_post(unsigned* bar, volatile LAS unsigned* st) {
    XcdBarrier b; b.bar = bar; b.x = xb_xcc_id(); b.st = st;
    if (opaque_tid() == 0) (void)xb_add(&bar[XB_XCNT(b.x)], 1u);
    return b;
}
__device__ __forceinline__ void xcd_barrier_complete(unsigned* bar, unsigned x, unsigned& nloc, unsigned& nx) {
    const unsigned G = gridDim.x * gridDim.y * gridDim.z;
    unsigned sum, cnt, mine, sp = 0u;
    for (;;) {
        sum = 0u; cnt = 0u; mine = 0u;
#pragma unroll
        for (unsigned j = 0; j < 16; ++j) { const unsigned c = xb_ld(&bar[XB_XCNT(j)]); sum += c; cnt += (c > 0u) ? 1u : 0u; mine = (j == x) ? c : mine; }
        if (sum == G) break;
        __builtin_amdgcn_s_sleep(1);
        if ((++sp & 255u) == 0u) { if (xb_ld(&bar[XB_TMO])) break; if (sp > XB_SPIN_CAP) { atomicAdd(&bar[XB_TMO], 1u); break; } }
    }
    nloc = mine > 0u ? mine : 1u; nx = cnt > 0u ? cnt : 1u;
}
__device__ __forceinline__ void xcd_barrier(const XcdBarrier& b) {
    asm volatile("s_waitcnt vmcnt(0)" ::: "memory");
    __syncthreads();
    if (opaque_tid() == 0) {
        unsigned* bar = b.bar;
        __builtin_amdgcn_s_waitcnt(0);
        unsigned nloc = b.st[0], nx = b.st[1];
        if (nloc == 0u) { xcd_barrier_complete(bar, b.x, nloc, nx); b.st[0] = nloc; b.st[1] = nx; }
        const unsigned old = xb_add(&bar[XB_XSUB(b.x)], 1u);
        const unsigned gen = old / nloc;
        if (old + 1u == (gen + 1u) * nloc) {
            __builtin_amdgcn_fence(__ATOMIC_RELEASE, "agent");
            asm volatile("s_waitcnt vmcnt(0)" ::: "memory");
            const unsigned og = xb_add(&bar[XB_TOP], 1u);
            const unsigned tg = og / nx;
            if (og + 1u == (tg + 1u) * nx) xb_add(&bar[XB_TOPGEN], 1u);
            else XB_SPIN(xb_ld(&bar[XB_TOPGEN]) == tg, bar);
            __builtin_amdgcn_fence(__ATOMIC_ACQUIRE, "agent");
            xb_add(&bar[XB_XGEN(b.x)], 1u);
            asm volatile("s_waitcnt vmcnt(0)" ::: "memory");
        } else {
            XB_SPIN(xb_ld(&bar[XB_XGEN(b.x)]) == gen, bar);
            __builtin_amdgcn_fence(__ATOMIC_ACQUIRE, "agent");
            asm volatile("s_waitcnt vmcnt(0)" ::: "memory");
        }
    }
    __syncthreads();
}

namespace pg8 {
constexpr int BM = 256, BK = 64, HALF = 128, HTB = HALF * BK * 2, STAGE_BYTES = 8 * HTB;
__device__ __forceinline__ int lds_byte(int r, int c) { const int st = (r >> 4) * 2 + (c >> 5), rr = r & 15, cc = c & 31, ob = rr * 64 + cc * 2; return st * 1024 + (ob ^ (((ob >> 9) & 1) << 5)); }
__device__ __forceinline__ void stage_rc(int b, int& R, int& C) { const int st = b / 1024, sb = b % 1024, swz = sb ^ (((sb >> 9) & 1) << 5); R = (st >> 1) * 16 + swz / 64; C = (st & 1) * 32 + (swz % 64) / 2; }
__device__ __forceinline__ int perm32(int rho) { const int n = rho >> 4, i = rho & 15; return 8 * (i >> 2) + 4 * n + (i & 3); }

struct GUnit { const char* A; const char* B; int nt; int pm, pn, aux; };

__device__ __forceinline__ void tile_of(int L, int nM, int nN, int& pm, int& pn) {
    const int nwg = nM * nN; int wgid = L;
    { const int q = nwg / 8, r = nwg % 8, xcd = wgid % 8, off = wgid / 8; wgid = (xcd < r ? xcd * (q + 1) : r * (q + 1) + (xcd - r) * q) + off; }
    const int nig = 8 * nN, gid = wgid / nig, fm = gid * 8, gsz = (nM - fm) < 8 ? (nM - fm) : 8;
    pm = fm + ((wgid % nig) % gsz); pn = (wgid % nig) / gsz;
}

typedef int i32x8 __attribute__((ext_vector_type(8)));
__device__ __forceinline__ void glds_saddr(const char* gbase_, unsigned voff, unsigned ldsdst) { unsigned keep;
    const unsigned long long gb_ = (unsigned long long)gbase_; const unsigned long long gbase = ((unsigned long long)(unsigned)__builtin_amdgcn_readfirstlane((int)(gb_ >> 32)) << 32) | (unsigned)__builtin_amdgcn_readfirstlane((int)gb_);
    asm volatile("s_mov_b32 %0, m0\n\ts_mov_b32 m0, %2\n\ts_nop 0\n\tglobal_load_lds_dwordx4 %1, %3\n\ts_mov_b32 m0, %0" : "=&s"(keep) : "v"(voff), "s"(ldsdst), "s"(gbase) : "memory"); }
template <class Epi, class Sched, bool FP8 = false>
__device__ __forceinline__ void gemm_phase(LAS unsigned char* lds, const unsigned lda, const unsigned ldb, const Sched& S, const Epi& E) {
    const int tid = opaque_tid(), wid = __builtin_amdgcn_readfirstlane(tid >> 6), lane = tid & 63, wr = wid >> 2, wc = wid & 3, fr = lane & 15, fq = lane >> 4;
    unsigned voffA[2], voffB[2];
#pragma unroll
    for (int i = 0; i < 2; ++i) { int R, C; stage_rc(tid * 16 + i * 8192, R, C); const int Rb = (R & ~31) + perm32(R & 31);
        voffA[i] = (unsigned)R * lda + (unsigned)C * 2u; voffB[i] = (unsigned)Rb * ldb + (unsigned)C * 2u; }
    const size_t kstep = (size_t)(BK * 2);
    const size_t hstepA = (size_t)HALF * lda, hstepB = (size_t)HALF * ldb;
    const unsigned ldsw = (unsigned)wid * 1024u;
    const int aoff = lds_byte(wr * 64 + fr, fq * 8), boff = lds_byte(wc * 32 + fr, fq * 8);
#define PG8_SA(b, h) (((b) * 2 + (h)) * HTB)
#define PG8_SB(b, h) ((4 + (b) * 2 + (h)) * HTB)
    const unsigned ldsb = (unsigned)(unsigned long)lds + ldsw;
#define PG8_STAGE(bufoff, gbase, voff) do { _Pragma("unroll") for (int _i = 0; _i < 2; ++_i) { \
        if constexpr (FP8) glds_saddr((const char*)(gbase), (voff)[_i], (unsigned)__builtin_amdgcn_readfirstlane((int)(ldsb + (bufoff) + _i * 8192))); \
        else __builtin_amdgcn_global_load_lds((const unsigned*)((const char*)(gbase) + (voff)[_i]), (LAS unsigned*)(lds + (bufoff) + ldsw + _i * 8192), 16, 0, 0); } } while (0)
#define PG8_LDA(dst, b, h) do { _Pragma("unroll") for (int m = 0; m < 4; ++m) _Pragma("unroll") for (int k = 0; k < 2; ++k) dst[m][k] = *(const LAS bf16x8*)(lds + PG8_SA(b, h) + aoff + m * 2048 + k * 1024); } while (0)
#define PG8_LDB(dst, b, h) do { _Pragma("unroll") for (int n = 0; n < 2; ++n) _Pragma("unroll") for (int k = 0; k < 2; ++k) dst[n][k] = *(const LAS bf16x8*)(lds + PG8_SB(b, h) + boff + n * 2048 + k * 1024); } while (0)
#define PG8_CAT(x) (__builtin_bit_cast(i32x8, __builtin_shufflevector((x)[0], (x)[1], 0, 1, 2, 3, 4, 5, 6, 7, 8, 9, 10, 11, 12, 13, 14, 15)))
#define PG8_MMA(ai, bj, At, Bt) do { __builtin_amdgcn_s_setprio(1); _Pragma("unroll") for (int m = 0; m < 4; ++m) _Pragma("unroll") for (int n = 0; n < 2; ++n) { \
        if constexpr (FP8) acc[ai][bj][m][n] = __builtin_amdgcn_mfma_scale_f32_16x16x128_f8f6f4(PG8_CAT(Bt[n]), PG8_CAT(At[m]), acc[ai][bj][m][n], 0, 0, 0, 0x7F7F7F7F, 0, 0x7F7F7F7F); \
        else { _Pragma("unroll") for (int k = 0; k < 2; ++k) acc[ai][bj][m][n] = __builtin_amdgcn_mfma_f32_16x16x32_bf16(Bt[n][k], At[m][k], acc[ai][bj][m][n], 0, 0, 0); } } __builtin_amdgcn_s_setprio(0); } while (0)
#define PG8_WAIT_V(n) asm volatile("s_waitcnt vmcnt(" #n ")" ::: "memory")
#define PG8_WAIT_L(n) asm volatile("s_waitcnt lgkmcnt(" #n ")" ::: "memory")
#define PG8_BAR __builtin_amdgcn_s_barrier()
#define PG8_SCHED __builtin_amdgcn_sched_barrier(0)
    GUnit cur, nxt; int ui = 0;
    if (!S.next(0, cur)) return;
#if USE_AGPR
    { int z_ = 0; asm volatile("" : "+a"(z_)); }
#endif
    f32x4 acc[2][2][4][2];
#pragma unroll
    for (int a = 0; a < 2; ++a)
#pragma unroll
        for (int b = 0; b < 2; ++b)
#pragma unroll
            for (int m = 0; m < 4; ++m)
#pragma unroll
                for (int n = 0; n < 2; ++n) acc[a][b][m][n] = (f32x4){0.f, 0.f, 0.f, 0.f};
    bf16x8 At[4][2], B0[2][2], B1[2][2];
    const char* cA = cur.A; const char* cB = cur.B;
    PG8_STAGE(PG8_SB(0, 0), cB, voffB); PG8_STAGE(PG8_SB(0, 1), cB + hstepB, voffB); PG8_STAGE(PG8_SA(0, 0), cA, voffA); PG8_STAGE(PG8_SA(0, 1), cA + hstepA, voffA);
    if (wr == 1) PG8_BAR;
    PG8_WAIT_V(2); PG8_BAR;
    PG8_STAGE(PG8_SB(1, 0), cB + kstep, voffB); PG8_STAGE(PG8_SA(1, 0), cA + kstep, voffA); PG8_STAGE(PG8_SB(1, 1), cB + hstepB + kstep, voffB);
    PG8_WAIT_V(6); PG8_BAR;
    for (;;) {
        const bool has_next = S.next(ui + 1, nxt);
        const char* nA = has_next ? nxt.A : cA; const char* nB = has_next ? nxt.B : cB;
        const int nt = cur.nt;
        for (int t = 0; t < nt; t += 2) {
            const bool last = (t == nt - 2);
            const char* a1 = cA + (size_t)(t + 1) * kstep;
            const char* a2 = last ? nA : cA + (size_t)(t + 2) * kstep; const char* b2 = last ? nB : cB + (size_t)(t + 2) * kstep;
            const char* a3 = a2 + kstep; const char* b3 = b2 + kstep;
            PG8_LDB(B0, 0, 0); PG8_LDB(B1, 0, 1); PG8_SCHED; PG8_LDA(At, 0, 0); PG8_STAGE(PG8_SA(1, 1), a1 + hstepA, voffA);
            PG8_WAIT_V(8); PG8_WAIT_L(0); PG8_BAR; PG8_MMA(0, 0, At, B0); PG8_MMA(0, 1, At, B1); PG8_BAR; PG8_SCHED;
            PG8_LDA(At, 0, 1); PG8_STAGE(PG8_SB(0, 0), b2, voffB); PG8_STAGE(PG8_SB(0, 1), b2 + hstepB, voffB); PG8_STAGE(PG8_SA(0, 0), a2, voffA);
            PG8_WAIT_V(8); PG8_WAIT_L(0); PG8_BAR; PG8_MMA(1, 0, At, B0); PG8_MMA(1, 1, At, B1); PG8_BAR; PG8_SCHED;
            PG8_LDB(B0, 1, 0); PG8_LDB(B1, 1, 1); PG8_SCHED; PG8_LDA(At, 1, 0); PG8_STAGE(PG8_SA(0, 1), a2 + hstepA, voffA);
            PG8_WAIT_V(8); PG8_WAIT_L(0); PG8_BAR; PG8_MMA(0, 0, At, B0); PG8_MMA(0, 1, At, B1); PG8_BAR; PG8_SCHED;
            PG8_LDA(At, 1, 1); PG8_STAGE(PG8_SB(1, 0), b3, voffB); PG8_STAGE(PG8_SB(1, 1), b3 + hstepB, voffB); PG8_STAGE(PG8_SA(1, 0), a3, voffA);
            PG8_WAIT_V(8); PG8_WAIT_L(0); PG8_BAR; PG8_MMA(1, 0, At, B0); PG8_MMA(1, 1, At, B1); PG8_BAR; PG8_SCHED;
            if constexpr (Epi::HOOK) { if (E.want(t + 2)) { const int l2_ = opaque_tid() & 63; E.mid(acc, cur, t + 2, wr, wc, l2_ & 15, l2_ >> 4); } }
        }
        if (wr == 0) PG8_BAR;
        { const int l2_ = opaque_tid() & 63; E(acc, cur, wr, wc, l2_ & 15, l2_ >> 4); }
        if (!has_next) break;
#pragma unroll
        for (int a = 0; a < 2; ++a)
#pragma unroll
            for (int b = 0; b < 2; ++b)
#pragma unroll
                for (int m = 0; m < 4; ++m)
#pragma unroll
                    for (int n = 0; n < 2; ++n) acc[a][b][m][n] = (f32x4){0.f, 0.f, 0.f, 0.f};
        cur = nxt; cA = nA; cB = nB; ++ui;
        if (wr == 1) PG8_BAR;
    }
    PG8_WAIT_V(0);
    PG8_BAR;
#undef PG8_SA
#undef PG8_SB
#undef PG8_STAGE
#undef PG8_LDA
#undef PG8_LDB
#undef PG8_MMA
#undef PG8_CAT
#undef PG8_WAIT_V
#undef PG8_WAIT_L
#undef PG8_BAR
#undef PG8_SCHED
}

__device__ __forceinline__ const char* sgpr_ptr(const char* p) { const unsigned long long v = (unsigned long long)p; return (const char*)(((unsigned long long)(unsigned)__builtin_amdgcn_readfirstlane((int)(v >> 32)) << 32) | (unsigned)__builtin_amdgcn_readfirstlane((int)v)); }
struct DenseSched {
    const char* A; const char* B; unsigned lda, ldb; int nM, nN, nt, G, c, nExtra, exPm0, exPn;
    __device__ __forceinline__ bool next(int i, GUnit& u) const {
        const long L = (long)i * G + c; const int nwg = nM * nN; if (L >= nwg + nExtra) return false;
        int pm, pn; if (L < nwg) tile_of((int)L, nM, nN, pm, pn); else { pm = exPm0 + (int)(L - nwg); pn = exPn; }
        u.pm = pm; u.pn = pn; u.aux = 0; u.nt = nt; u.A = sgpr_ptr(A + (size_t)pm * 256 * lda); u.B = sgpr_ptr(B + (size_t)pn * 256 * ldb); return true;
    }
};
struct MergeSched {
    const char* A; const char* B; int nM, G, c;
    __device__ __forceinline__ bool next(int i, GUnit& u) const {
        const int tile = i / 3, seg = i - 3 * tile; const long L = (long)tile * G + c; if (L >= nM * 4) return false;
        int pm, pn; tile_of((int)L, nM, 4, pm, pn); const int koff = seg == 0 ? 0 : (seg == 1 ? 256 : 512);
        u.pm = pm; u.pn = pn; u.aux = seg; u.nt = seg == 2 ? 8 : 4; u.A = sgpr_ptr(A + (size_t)pm * 256 * 2048 + koff * 2); u.B = sgpr_ptr(B + (size_t)pn * 256 * 2048 + koff * 2); return true;
    }
};
struct MoeSched {
    const char* A; const char* B; unsigned lda, ldb; size_t estride; int nN, nt, G, c; int P[9];
    __device__ __forceinline__ bool next(int i, GUnit& u) const {
        const int nM = P[8]; const long L = (long)i * G + c; if (L >= (long)nM * nN) return false;
        int pm, pn; tile_of((int)L, nM, nN, pm, pn); int e = 0;
#pragma unroll
        for (int k = 1; k < 8; ++k) e += (pm >= P[k]) ? 1 : 0;
        u.pm = pm; u.pn = pn; u.aux = e; u.nt = nt; u.A = sgpr_ptr(A + (size_t)pm * 256 * lda); u.B = sgpr_ptr(B + (size_t)e * estride + (size_t)pn * 256 * ldb); return true;
    }
};

typedef f32x4 Acc[2][2][4][2];
__device__ __forceinline__ unsigned tile_off(int wr, int wc, int ai, int m, int bj, int fr, int fq) { return (unsigned)((((((wr * 4 + wc) * 2 + ai) * 4 + m) * 2 + bj) * 64 + fq * 16 + fr) * 8); }
struct EpiZ {
    static constexpr bool HOOK = false;
    bf16_t *ZC, *ZG, *Q, *K, *V, *G; const float* rope; float scz;
    __device__ __forceinline__ void operator()(const Acc& acc, const GUnit& u, int wr, int wc, int fr, int fq) const {
        const int pn = u.pn, row0 = u.pm * 256 + wr * 64 + fr, c8 = wc * 32 + fq * 8; const bool isx = u.pm < NPX; float sc_ = scz; asm volatile("" : "+s"(sc_));
#pragma unroll
        for (int ai = 0; ai < 2; ++ai)
#pragma unroll
            for (int m = 0; m < 4; ++m) { const int row = row0 + ai * 128 + m * 16;
                f32x4 a0 = acc[ai][0][m][0] * sc_, a1 = acc[ai][0][m][1] * sc_, b0 = acc[ai][1][m][0] * sc_, b1 = acc[ai][1][m][1] * sc_;
                if (pn < 3) { bf16_t* rp = ZC + (size_t)row * 768 + pn * 256 + c8; *(u32x4*)rp = pack8(a0, a1); *(u32x4*)(rp + 128) = pack8(b0, b1);
                } else if (pn < 5) { bf16_t* rp = ZG + (size_t)row * 512 + (pn - 3) * 256 + c8;
#pragma unroll
                    for (int j = 0; j < 4; ++j) { a0[j] = gelu_tanh(a0[j]); a1[j] = gelu_tanh(a1[j]); b0[j] = gelu_tanh(b0[j]); b1[j] = gelu_tanh(b1[j]); }
                    *(u32x4*)rp = pack8(a0, a1); *(u32x4*)(rp + 128) = pack8(b0, b1);
                } else if (pn < 8) {
                    if (pn == 7 && wc >= 2) {
                        bf16_t* vp = V + (size_t)row * 128 + (wc - 2) * 32 + fq * 8; *(u32x4*)vp = pack8(a0, a1); *(u32x4*)(vp + 64) = pack8(b0, b1);
                    } else {
                        if (isx) { const int s = row & (SEQ - 1), p = (fq < 2) ? (s >> 6) : (s & 63); const float* cs = rope + p * 16 + (fq & 1) * 8;
                            const f32x4 c0 = *(const f32x4*)cs, c1 = *(const f32x4*)(cs + 4), s0 = *(const f32x4*)(cs + 1024), s1 = *(const f32x4*)(cs + 1028);
                            const f32x4 oa0 = a0 * c0 - b0 * s0, oa1 = a1 * c1 - b1 * s1, ob0 = b0 * c0 + a0 * s0, ob1 = b1 * c1 + a1 * s1;
                            a0 = oa0; a1 = oa1; b0 = ob0; b1 = ob1; }
                        if (pn < 7) { a0 *= QSCALE; a1 *= QSCALE; b0 *= QSCALE; b1 *= QSCALE;
                            bf16_t* qp = Q + (size_t)row * 512 + ((pn - 5) * 4 + wc) * 64 + fq * 8; *(u32x4*)qp = pack8(a0, a1); *(u32x4*)(qp + 32) = pack8(b0, b1);
                        } else { bf16_t* kp = K + (size_t)row * 128 + wc * 64 + fq * 8; *(u32x4*)kp = pack8(a0, a1); *(u32x4*)(kp + 32) = pack8(b0, b1); }
                    }
                } else { bf16_t* rp = G + (size_t)row * 3072 + (pn - 8) * 256 + c8;
#pragma unroll
                    for (int j = 0; j < 4; ++j) { a0[j] = fast_sigmoid(a0[j]); a1[j] = fast_sigmoid(a1[j]); b0[j] = fast_sigmoid(b0[j]); b1[j] = fast_sigmoid(b1[j]); }
                    *(u32x4*)rp = pack8(a0, a1); *(u32x4*)(rp + 128) = pack8(b0, b1);
                }
                }
    }
};
struct EpiGate8 {
    static constexpr bool HOOK = false;
    bf16_t* G;
    __device__ __forceinline__ void operator()(const Acc& acc, const GUnit& u, int wr, int wc, int fr, int fq) const {
        const int row0 = u.pm * 256 + wr * 64 + fr, col = u.pn * 256 + wc * 32 + fq * 8; float sc = 1.0f / (A8_SCALE * W_GU_SCALE); asm volatile("" : "+s"(sc));
#pragma unroll
        for (int ai = 0; ai < 2; ++ai)
#pragma unroll
            for (int m = 0; m < 4; ++m) { bf16_t* tp = G + (size_t)(u.pm * 12 + u.pn) * 65536;
#pragma unroll
                for (int bj = 0; bj < 2; ++bj) { f32x4 a = acc[ai][bj][m][0] * sc, b = acc[ai][bj][m][1] * sc;
#pragma unroll
                    for (int j = 0; j < 4; ++j) { a[j] = fast_sigmoid(a[j]); b[j] = fast_sigmoid(b[j]); }
                    *(u32x4*)(tp + tile_off(wr, wc, ai, m, bj, fr, fq)) = pack8(a, b); } }
    }
};
struct EpiMerge {
    static constexpr bool HOOK = false;
    const bf16_t* G; bf16_t* MIXP; bf16_t* MIX;
    template <int SEG> __device__ __forceinline__ void run(const Acc& acc, const GUnit& u, int wr, int wc, int fr, int fq) const {
        const int row0 = u.pm * 256 + wr * 64 + fr, col = u.pn * 256 + wc * 32 + fq * 8;
        const bf16_t* gt = G + (size_t)(u.pm * 12 + SEG * 4 + u.pn) * 65536; bf16_t* pt = MIXP + (size_t)(u.pm * 4 + u.pn) * 65536;
#pragma unroll
        for (int ai = 0; ai < 2; ++ai) { u32x4 gq[4][2], mq[4][2];
#pragma unroll
            for (int m = 0; m < 4; ++m)
#pragma unroll
                for (int bj = 0; bj < 2; ++bj) { const unsigned o = tile_off(wr, wc, ai, m, bj, fr, fq); gq[m][bj] = *(const u32x4*)(gt + o); if (SEG > 0) mq[m][bj] = *(const u32x4*)(pt + o); }
#pragma unroll
            for (int m = 0; m < 4; ++m)
#pragma unroll
                for (int bj = 0; bj < 2; ++bj) { f32x4 g0, g1; unpack8(gq[m][bj], g0, g1);
                    f32x4 v0 = g0 * acc[ai][bj][m][0], v1 = g1 * acc[ai][bj][m][1];
                    if (SEG > 0) { f32x4 o0, o1; unpack8(mq[m][bj], o0, o1); v0 += o0; v1 += o1; }
                    if (SEG < 2) *(u32x4*)(pt + tile_off(wr, wc, ai, m, bj, fr, fq)) = pack8(v0, v1);
                    else *(u32x4*)(MIX + (size_t)(row0 + ai * 128 + m * 16) * 1024 + col + bj * 128) = pack8(v0, v1); } }
    }
    __device__ __forceinline__ void operator()(const Acc& acc, const GUnit& u, int wr, int wc, int fr, int fq) const {
        if (u.aux == 0) run<0>(acc, u, wr, wc, fr, fq); else if (u.aux == 1) run<1>(acc, u, wr, wc, fr, fq); else run<2>(acc, u, wr, wc, fr, fq); }
};
struct EpiMergeH {
    static constexpr bool HOOK = true;
    const bf16_t* G; bf16_t* MIX;
    __device__ __forceinline__ bool want(int kdone) const { return kdone == 4 || kdone == 8; }
    __device__ __forceinline__ void mid(Acc& acc, const GUnit& u, int kdone, int wr, int wc, int fr, int fq) const {
        const int seg = kdone == 4 ? 0 : 1, row0 = u.pm * 256 + wr * 64 + fr, col = u.pn * 256 + wc * 32 + fq * 8;
#pragma unroll
        for (int ai = 0; ai < 2; ++ai)
#pragma unroll
            for (int m = 0; m < 4; ++m) { const bf16_t* gp = G + (size_t)(row0 + ai * 128 + m * 16) * 3072 + seg * 1024 + col;
#pragma unroll
                for (int bj = 0; bj < 2; ++bj) { f32x4 p0, p1, n0, n1; unpack8(*(const u32x4*)(gp + bj * 128), p0, p1); unpack8(*(const u32x4*)(gp + 1024 + bj * 128), n0, n1);
#pragma unroll
                    for (int j = 0; j < 4; ++j) { acc[ai][bj][m][0][j] *= __builtin_fmaxf(p0[j], 1e-30f) * __builtin_amdgcn_rcpf(__builtin_fmaxf(n0[j], 1e-30f)); acc[ai][bj][m][1][j] *= __builtin_fmaxf(p1[j], 1e-30f) * __builtin_amdgcn_rcpf(__builtin_fmaxf(n1[j], 1e-30f)); } }
                asm volatile("" ::: "memory"); }
    }
    __device__ __forceinline__ void operator()(const Acc& acc, const GUnit& u, int wr, int wc, int fr, int fq) const {
        const int row0 = u.pm * 256 + wr * 64 + fr, col = u.pn * 256 + wc * 32 + fq * 8;
#pragma unroll
        for (int ai = 0; ai < 2; ++ai)
#pragma unroll
            for (int m = 0; m < 4; ++m) { const size_t row = (size_t)(row0 + ai * 128 + m * 16);
#pragma unroll
                for (int bj = 0; bj < 2; ++bj) { f32x4 g0, g1; unpack8(*(const u32x4*)(G + row * 3072 + 2048 + col + bj * 128), g0, g1);
#pragma unroll
                    for (int j = 0; j < 4; ++j) { g0[j] = __builtin_fmaxf(g0[j], 1e-30f); g1[j] = __builtin_fmaxf(g1[j], 1e-30f); }
                    *(u32x4*)(MIX + row * 1024 + col + bj * 128) = pack8(g0 * acc[ai][bj][m][0], g1 * acc[ai][bj][m][1]); }
                asm volatile("" ::: "memory"); }
    }
};
struct Merge12Sched {
    const char* A; const char* B; int nM, G, c;
    __device__ __forceinline__ bool next(int i, GUnit& u) const {
        const long L = (long)i * G + c; if (L >= (long)nM * 12) return false;
        int pm, pn; tile_of((int)L, nM, 12, pm, pn); const int j = pn >> 2, koff = j == 0 ? 0 : (j == 1 ? 256 : 512);
        u.pm = pm; u.pn = pn; u.aux = j; u.nt = j == 2 ? 8 : 4; u.A = sgpr_ptr(A + (size_t)pm * 256 * 2048 + koff * 2); u.B = sgpr_ptr(B + (size_t)(pn & 3) * 256 * 2048 + koff * 2); return true;
    }
};
struct EpiMerge8 {
    static constexpr bool HOOK = false;
    const bf16_t* G; unsigned char* GP;
    __device__ __forceinline__ void operator()(const Acc& acc, const GUnit& u, int wr, int wc, int fr, int fq) const {
        const int row0 = u.pm * 256 + wr * 64 + fr, col = u.pn * 256 + wc * 32 + fq * 8; float sc = GP8_SCALE; asm volatile("" : "+s"(sc));
#pragma unroll
        for (int ai = 0; ai < 2; ++ai)
#pragma unroll
            for (int m = 0; m < 4; ++m) { const unsigned row = (unsigned)(row0 + ai * 128 + m * 16);
#pragma unroll
                for (int bj = 0; bj < 2; ++bj) { f32x4 g0, g1; unpack8(*(const u32x4*)(G + (size_t)row * 3072 + col + bj * 128), g0, g1);
                    const f32x4 v0 = g0 * acc[ai][bj][m][0] * sc, v1 = g1 * acc[ai][bj][m][1] * sc;
                    u32x2 o; o.x = pk4_fp8(v0[0], v0[1], v0[2], v0[3]); o.y = pk4_fp8(v1[0], v1[1], v1[2], v1[3]);
                    *(u32x2*)(GP + row * 3072u + (unsigned)(col + bj * 128)) = o; } }
    }
};
struct EpiResid {
    static constexpr bool HOOK = false;
    const float* xin_x; const float* xin_c; float* xout_x; float* xout_c; const float* gate; float sc;
    __device__ __forceinline__ void operator()(const Acc& acc, const GUnit& u, int wr, int wc, int fr, int fq) const {
        const bool isx = u.pm < NPX; const int b = isx ? (u.pm >> 4) : 16;
        const float* xi = isx ? xin_x + (size_t)u.pm * 256 * D : xin_c + (size_t)(u.pm - NPX) * 256 * D;
        float* xo = isx ? xout_x + (size_t)u.pm * 256 * D : xout_c + (size_t)(u.pm - NPX) * 256 * D;
        const int col = u.pn * 256 + wc * 32 + fq * 8; const float* gp = gate + (size_t)b * 6 * D + col;
        f32x4 gv[2][2];
#pragma unroll
        for (int bj = 0; bj < 2; ++bj) { gv[bj][0] = *(const f32x4*)(gp + bj * 128) * sc; gv[bj][1] = *(const f32x4*)(gp + bj * 128 + 4) * sc; }
#pragma unroll
        for (int ai = 0; ai < 2; ++ai) { f32x4 xq[4][2][2];
#pragma unroll
            for (int m = 0; m < 4; ++m) { const size_t off = (size_t)(wr * 64 + fr + ai * 128 + m * 16) * D + col;
#pragma unroll
                for (int bj = 0; bj < 2; ++bj) { xq[m][bj][0] = *(const f32x4*)(xi + off + bj * 128); xq[m][bj][1] = *(const f32x4*)(xi + off + bj * 128 + 4); } }
#pragma unroll
            for (int m = 0; m < 4; ++m) { const size_t off = (size_t)(wr * 64 + fr + ai * 128 + m * 16) * D + col;
#pragma unroll
                for (int bj = 0; bj < 2; ++bj) { *(f32x4*)(xo + off + bj * 128) = xq[m][bj][0] + gv[bj][0] * acc[ai][bj][m][0]; *(f32x4*)(xo + off + bj * 128 + 4) = xq[m][bj][1] + gv[bj][1] * acc[ai][bj][m][1]; } } }
    }
};
struct EpiGU {
    static constexpr bool HOOK = false;
    bf16_t* H; int ldh;
    __device__ __forceinline__ void operator()(const Acc& acc, const GUnit& u, int wr, int wc, int fr, int fq) const {
        const int row0 = u.pm * 256 + wr * 64 + fr, col = u.pn * 128 + wc * 32 + fq * 8;
#pragma unroll
        for (int ai = 0; ai < 2; ++ai)
#pragma unroll
            for (int m = 0; m < 4; ++m) { f32x4 a = acc[ai][0][m][0], b = acc[ai][0][m][1]; const f32x4 c = acc[ai][1][m][0], d = acc[ai][1][m][1];
#pragma unroll
                for (int j = 0; j < 4; ++j) { a[j] = fast_silu(a[j]) * c[j]; b[j] = fast_silu(b[j]) * d[j]; }
                *(u32x4*)(H + (size_t)(row0 + ai * 128 + m * 16) * ldh + col) = pack8(a, b); }
    }
};
struct EpiGU8 {
    static constexpr bool HOOK = false;
    unsigned char* H; int ldh;
    __device__ __forceinline__ void operator()(const Acc& acc, const GUnit& u, int wr, int wc, int fr, int fq) const {
        const int row0 = u.pm * 256 + wr * 64 + fr, col = u.pn * 128 + wc * 32 + fq * 8; float sc = 1.0f / (A8_SCALE * W_GU_SCALE), sch = H8_SCALE / (A8_SCALE * W_GU_SCALE);
        asm volatile("" : "+s"(sc), "+s"(sch));
#pragma unroll
        for (int ai = 0; ai < 2; ++ai)
#pragma unroll
            for (int m = 0; m < 4; ++m) { f32x4 a = acc[ai][0][m][0] * sc, b = acc[ai][0][m][1] * sc; const f32x4 c = acc[ai][1][m][0] * sch, d = acc[ai][1][m][1] * sch;
#pragma unroll
                for (int j = 0; j < 4; ++j) { a[j] = fast_silu(a[j]) * c[j]; b[j] = fast_silu(b[j]) * d[j]; }
                u32x2 o; o.x = pk4_fp8(a[0], a[1], a[2], a[3]); o.y = pk4_fp8(b[0], b[1], b[2], b[3]);
                const unsigned off = (unsigned)(row0 + ai * 128 + m * 16) * (unsigned)ldh + (unsigned)col;
                *(u32x2*)(H + off) = o; }
    }
};
struct EpiMoeDown {
    static constexpr bool HOOK = false;
    const int* rinfo; bf16_t* Y; float sc;
    __device__ __forceinline__ void operator()(const Acc& acc, const GUnit& u, int wr, int wc, int fr, int fq) const {
        const int row0 = u.pm * 256 + wr * 64 + fr, col = u.pn * 256 + wc * 32 + fq * 8;
        int infos[2][4];
#pragma unroll
        for (int ai = 0; ai < 2; ++ai)
#pragma unroll
            for (int m = 0; m < 4; ++m) infos[ai][m] = rinfo[row0 + ai * 128 + m * 16];
#pragma unroll
        for (int ai = 0; ai < 2; ++ai)
#pragma unroll
            for (int m = 0; m < 4; ++m) { const int info = infos[ai][m];
                if (info >= 0) { const unsigned t = (unsigned)info & 0xfffffu, k = ((unsigned)info >> 20) & 1u; const unsigned off = ((k * (unsigned)T + t) * (unsigned)D + (unsigned)col) * 2u;
#pragma unroll
                    for (int bj = 0; bj < 2; ++bj) *(u32x4*)((unsigned char*)Y + off + bj * 256) = pack8(acc[ai][bj][m][0] * sc, acc[ai][bj][m][1] * sc); } }
    }
};
}

namespace attn_body {
using bf16=__hip_bfloat16;
using s16x4=__attribute__((ext_vector_type(4)))short;
constexpr int D64=64,NW=8,QBLK=32,KVBLK=64;
constexpr int QP=512,KP=128,OP=1024;
__device__ __forceinline__ int crow(int r,int hi){return (r&3)+8*(r>>2)+4*hi;}
#define SBAR() __builtin_amdgcn_sched_barrier(0)
__device__ __forceinline__ void wmask(f32x16&p0,f32x16&p1,int base,int hi){
  const float NEG=-INFINITY; const int kb=base+4*hi;
  #pragma unroll
  for(int r=0;r<16;++r){const int d=kb+(r&3)+8*(r>>2); if(d>128||d<-128)p0[r]=NEG; if(d+32>128||d+32<-128)p1[r]=NEG;}
}
constexpr int NSLOT=3, SLOTB=8192;
constexpr int LDS_K=0, LDS_V=NSLOT*SLOTB, LDS_WS=2*NSLOT*SLOTB, LDS_OST=LDS_WS+NW*64*4, LDS_BYTES=LDS_OST+NW*4096;
__device__ __forceinline__ void glds16(const void*gsrc,unsigned lds_dst){unsigned keep;
  asm volatile("s_mov_b32 %0, m0\n\ts_mov_b32 m0, %2\n\ts_nop 0\n\tglobal_load_lds_dwordx4 %1, off\n\ts_mov_b32 m0, %0":"=&s"(keep):"v"(gsrc),"s"(lds_dst):"memory");}
__device__ __forceinline__ float max3f(float a,float b,float c){float r;asm("v_max3_f32 %0, %1, %2, %3":"=v"(r):"v"(a),"v"(b),"v"(c));return r;}
__device__ __forceinline__ float max2f(float a,float b){float r;asm("v_max_f32_e32 %0, %1, %2":"=v"(r):"v"(a),"v"(b));return r;}
__device__ __forceinline__ float fadd_s(float a,float b){float r;asm("v_add_f32_e32 %0, %1, %2":"=v"(r):"v"(a),"v"(b));return r;}
__device__ __forceinline__ float fsub_s(float a,float b){float r;asm("v_sub_f32_e32 %0, %1, %2":"=v"(r):"v"(a),"v"(b));return r;}
typedef float f32x2_t __attribute__((ext_vector_type(2))); typedef __bf16 bf16x2_t __attribute__((ext_vector_type(2)));
__device__ __forceinline__ unsigned cvtpk_s(float lo,float hi){f32x2_t v={lo,hi};bf16x2_t b=__builtin_convertvector(v,bf16x2_t);return __builtin_bit_cast(unsigned,b);}
#define WAIT_BAR(N) asm volatile("s_waitcnt vmcnt(" #N ") lgkmcnt(0)\n\ts_barrier":::"memory")
__device__ __forceinline__ void qkt(f32x16&p0,f32x16&p1,const char*Kslot,const bf16x8*qr,const f32x16&negm,int r32,int hi){
  const char*kb=Kslot+hi*1024+r32*16;
  #pragma unroll
  for(int d0=0;d0<4;++d0){
    const bf16x8 b0=*reinterpret_cast<const bf16x8*>(kb+d0*2048);
    const bf16x8 b1=*reinterpret_cast<const bf16x8*>(kb+d0*2048+512);
    if(d0==0){p0=__builtin_amdgcn_mfma_f32_32x32x16_bf16(b0,qr[0],negm,0,0,0);p1=__builtin_amdgcn_mfma_f32_32x32x16_bf16(b1,qr[0],negm,0,0,0);}
    else{p0=__builtin_amdgcn_mfma_f32_32x32x16_bf16(b0,qr[d0],p0,0,0,0);p1=__builtin_amdgcn_mfma_f32_32x32x16_bf16(b1,qr[d0],p1,0,0,0);}}
}
typedef __attribute__((address_space(3))) const char* lds_cptr;
typedef short v4i16_t __attribute__((ext_vector_type(4)));
__device__ __forceinline__ void kload8(bf16x8*kf,lds_cptr kp){
  kf[0]=*(const __attribute__((address_space(3))) bf16x8*)(kp);      kf[1]=*(const __attribute__((address_space(3))) bf16x8*)(kp+512);
  kf[2]=*(const __attribute__((address_space(3))) bf16x8*)(kp+2048); kf[3]=*(const __attribute__((address_space(3))) bf16x8*)(kp+2560);
  kf[4]=*(const __attribute__((address_space(3))) bf16x8*)(kp+4096); kf[5]=*(const __attribute__((address_space(3))) bf16x8*)(kp+4608);
  kf[6]=*(const __attribute__((address_space(3))) bf16x8*)(kp+6144); kf[7]=*(const __attribute__((address_space(3))) bf16x8*)(kp+6656);
}
__device__ __forceinline__ void kload2(bf16x8*kf,lds_cptr kp,int j){ kf[2*j]=*(const __attribute__((address_space(3))) bf16x8*)(kp+j*2048); kf[2*j+1]=*(const __attribute__((address_space(3))) bf16x8*)(kp+j*2048+512); }
__device__ __forceinline__ s16x4 vtr(lds_cptr p){ return __builtin_bit_cast(s16x4,__builtin_amdgcn_ds_read_tr16_b64_v4i16((__attribute__((address_space(3))) v4i16_t*)p)); }
__device__ __forceinline__ float rowmax(const f32x16&p0,const f32x16&p1){
  float a=max3f(p0[0],p0[1],p1[0]),b=max3f(p0[2],p0[3],p1[1]);a=max3f(a,p1[2],p1[3]);
  #pragma unroll
  for(int r=4;r<16;r+=4){a=max3f(a,p0[r],p0[r+1]);b=max3f(b,p0[r+2],p0[r+3]);a=max3f(a,p1[r],p1[r+1]);b=max3f(b,p1[r+2],p1[r+3]);}
  const float m=max2f(a,b);
  auto rr=__builtin_amdgcn_permlane32_swap(__float_as_uint(m),__float_as_uint(m),false,false);
  return max2f(__uint_as_float(rr[0]),__uint_as_float(rr[1]));
}
__device__ __forceinline__ void pv(f32x16*o,int vb,bf16x8 pa0,bf16x8 pa1,bf16x8 pa2,bf16x8 pa3){
  #pragma unroll
  for(int d0=0;d0<2;++d0){s16x4 lo[4],hi[4];
    #pragma unroll
    for(int ks=0;ks<4;++ks){
      asm volatile("ds_read_b64_tr_b16 %0,%1 offset:%c2":"=&v"(lo[ks]):"v"(vb),"i"(d0*4096+ks*1024):"memory");
      asm volatile("ds_read_b64_tr_b16 %0,%1 offset:%c2":"=&v"(hi[ks]):"v"(vb),"i"(d0*4096+ks*1024+512):"memory");}
    asm volatile("s_waitcnt lgkmcnt(0)":::"memory");SBAR();
    #define PK(k) (bf16x8){lo[k][0],lo[k][1],lo[k][2],lo[k][3],hi[k][0],hi[k][1],hi[k][2],hi[k][3]}
    o[d0]=__builtin_amdgcn_mfma_f32_32x32x16_bf16(pa0,PK(0),o[d0],0,0,0);
    o[d0]=__builtin_amdgcn_mfma_f32_32x32x16_bf16(pa1,PK(1),o[d0],0,0,0);
    o[d0]=__builtin_amdgcn_mfma_f32_32x32x16_bf16(pa2,PK(2),o[d0],0,0,0);
    o[d0]=__builtin_amdgcn_mfma_f32_32x32x16_bf16(pa3,PK(3),o[d0],0,0,0);
    #undef PK
  }
}
template<int THRL> __device__ __forceinline__ void attn_unit(const bf16*Qw,const bf16*__restrict__ Kc,const bf16*__restrict__ Vc,bf16*Ow,int crow0,int lrow0,int NT,int qoff0,float sink_l2,char*shm){
  const int tid=opaque_tid(),lane=tid&63,r32=lane&31,hi=lane>>5; const int wid=__builtin_amdgcn_readfirstlane(tid>>6);
  const unsigned lds0=(unsigned)(uintptr_t)shm;
  float*wsf=(float*)(shm+LDS_WS)+wid*64;
  const bf16*ksrc=Kc+(long)lane*KP+wid*8;
  const bf16*vsrc=Vc+(long)(16*(wid&3)+(lane>>2))*KP+(wid>>2)*32+(lane&3)*8;
  const unsigned kdst=lds0+LDS_K+wid*1024, vdst=lds0+LDS_V+wid*1024;
  #define TROW(t) ((long)(((t)<4)?(crow0+64*(t)):(lrow0+64*((t)-4)))*KP)
  #define DMA_K(t,slot) glds16(ksrc+TROW(t),(unsigned)__builtin_amdgcn_readfirstlane(kdst+(slot)))
  #define DMA_V(t,slot) glds16(vsrc+TROW(t),(unsigned)__builtin_amdgcn_readfirstlane(vdst+(slot)))
  const int vb0=(int)(lds0+LDS_V)+((lane>>4)&1)*32+(lane&3)*8+(4*hi+((lane&15)>>2))*64;
  const char*Kbase=shm+LDS_K; bf16x8 kf[8];
  const lds_cptr shm3=(lds_cptr)shm; const lds_cptr kp0=shm3+LDS_K+hi*1024+r32*16; const lds_cptr vp0=shm3+LDS_V+((lane>>4)&1)*32+(lane&3)*8+(4*hi+((lane&15)>>2))*64;
  DMA_K(0,0);DMA_V(0,0);DMA_K(1,SLOTB);
  bf16x8 qr[4];
  #pragma unroll
  for(int d0=0;d0<4;++d0)qr[d0]=*reinterpret_cast<const bf16x8*>(&Qw[(long)r32*QP+d0*16+hi*8]);
  float mhat=0.f,l_reg=0.f;f32x16 o[2];o[0]=f32x16{};o[1]=f32x16{};const f32x16 negm=f32x16{};
  const int qoff=qoff0+r32;
  #define CMASK(P0,P1,t) do{ if((t)>=4){ const int kb_=64*((t)-4); if(kb_-(qoff0+31)<-128||kb_+63-qoff0>128) wmask(P0,P1,kb_-qoff,hi);} }while(0)
  bool resc=false;
  #define START(P0,P1) do{ const float rm=rowmax(P0,P1); resc=false; mhat=rm; \
    _Pragma("unroll") for(int r=0;r<16;++r){P0[r]=fsub_s(P0[r],mhat);P1[r]=fsub_s(P1[r],mhat);} \
    _Pragma("unroll") for(int r=0;r<16;++r)P0[r]=__builtin_amdgcn_exp2f(P0[r]); }while(0)
  #define RESC() do{ if(resc){ asm volatile("s_waitcnt lgkmcnt(0)":::"memory"); \
      _Pragma("unroll") for(int d_=0;d_<2;++d_) _Pragma("unroll") for(int r=0;r<16;++r)o[d_][r]*=wsf[crow(r,hi)]; } }while(0)
  f32x16 pA0,pA1,pB0,pB1;
  int sl_prev=0,sl_cur=0,sl_next=SLOTB;
  #define ROT() do{sl_prev=sl_cur;sl_cur=sl_next;sl_next=(sl_next==(NSLOT-1)*SLOTB)?0:sl_next+SLOTB;}while(0)
  DMA_K(2,2*SLOTB);
  WAIT_BAR(3);
  qkt(pA0,pA1,Kbase,qr,negm,r32,hi);asm volatile("s_nop 15\n\ts_nop 7":"+v"(pA0),"+v"(pA1));
  START(pA0,pA1);
  _Pragma("unroll") for(int r=0;r<16;++r)pA1[r]=__builtin_amdgcn_exp2f(pA1[r]);
  WAIT_BAR(0);
  DMA_K(3,0);DMA_V(1,SLOTB);
  ROT();
  kload8(kf,kp0+sl_cur);
  WAIT_BAR(2);
  s16x4 vlo[8],vhi[8]; u32x4 pw0,pw1,pw2,pw3;
  #define PKW(P,B) cvtpk_s(P[B],P[B+1])
  #define PAF(k) __builtin_bit_cast(bf16x8,pw##k)
  #define VFR(i) (bf16x8){vlo[i][0],vlo[i][1],vlo[i][2],vlo[i][3],vhi[i][0],vhi[i][1],vhi[i][2],vhi[i][3]}
  #define PIN(x) asm volatile("":"+v"(x))
  #define MX3(a,b,c) __builtin_fmaxf(__builtin_fmaxf((a),(b)),(c))
  #define GAPA(MF,A0,A1,A2,A3,W0,W1,PW) do{ MF; sacc+=A0; sacc+=A1; sacc+=A2; sacc+=A3; PIN(sacc); W0; W1; PIN(PW); SBAR(); }while(0)
  #define EX(v) __builtin_amdgcn_exp2f(v)
  #define GAPB(MF,X,B) do{ MF; X[B]=EX(X[B]-mhat); X[B+1]=EX(X[B+1]-mhat); X[B+2]=EX(X[B+2]-mhat); X[B+3]=EX(X[B+3]-mhat); PIN(X); SBAR(); }while(0)
  #define VRD(i) do{ vlo[i]=vtr(vp_+(((i)>>2)*4096+((i)&3)*1024)); vhi[i]=vtr(vp_+(((i)>>2)*4096+((i)&3)*1024+512)); }while(0)
  #define KRD(G,j) do{ if(G){ kload2(kf,kp0+sl_next,j); SBAR(); } }while(0)
  #define STEP(C0,C1,P0,P1,t,GK,GV,GL) do{ SBAR(); \
    const lds_cptr vp_=vp0+sl_prev; \
    VRD(0); SBAR(); float sacc=(P0[0]+P0[1]); \
    GAPA(C0=__builtin_amdgcn_mfma_f32_32x32x16_bf16(kf[0],qr[0],negm,0,0,0), P0[2],P0[3],P0[4],P0[5],     pw0[0]=PKW(P0,0), pw0[1]=PKW(P0,2), pw0); \
    VRD(4); SBAR(); GAPA(C1=__builtin_amdgcn_mfma_f32_32x32x16_bf16(kf[1],qr[0],negm,0,0,0), P0[6],P0[7],P0[8],P0[9],     pw0[2]=PKW(P0,4), pw0[3]=PKW(P0,6), pw0); \
    VRD(1); SBAR(); GAPA(C0=__builtin_amdgcn_mfma_f32_32x32x16_bf16(kf[2],qr[1],C0,0,0,0),   P0[10],P0[11],P0[12],P0[13], pw1[0]=PKW(P0,8), pw1[1]=PKW(P0,10), pw1); \
    VRD(5); SBAR(); GAPA(C1=__builtin_amdgcn_mfma_f32_32x32x16_bf16(kf[3],qr[1],C1,0,0,0),   P0[14],P0[15],P1[0],P1[1],   pw1[2]=PKW(P0,12),pw1[3]=PKW(P0,14), pw1); \
    VRD(2); SBAR(); GAPA(C0=__builtin_amdgcn_mfma_f32_32x32x16_bf16(kf[4],qr[2],C0,0,0,0),   P1[2],P1[3],P1[4],P1[5],     pw2[0]=PKW(P1,0), pw2[1]=PKW(P1,2), pw2); \
    VRD(6); SBAR(); GAPA(C1=__builtin_amdgcn_mfma_f32_32x32x16_bf16(kf[5],qr[2],C1,0,0,0),   P1[6],P1[7],P1[8],P1[9],     pw2[2]=PKW(P1,4), pw2[3]=PKW(P1,6), pw2); \
    VRD(3); SBAR(); GAPA(C0=__builtin_amdgcn_mfma_f32_32x32x16_bf16(kf[6],qr[3],C0,0,0,0),   P1[10],P1[11],P1[12],P1[13], pw3[0]=PKW(P1,8), pw3[1]=PKW(P1,10), pw3); \
    VRD(7); SBAR(); GAPA(C1=__builtin_amdgcn_mfma_f32_32x32x16_bf16(kf[7],qr[3],C1,0,0,0),   P1[14],P1[15],0.f,0.f,       pw3[2]=PKW(P1,12),pw3[3]=PKW(P1,14), pw3); \
    l_reg+=sacc; \
    if(GK){DMA_K((t)+3,sl_cur);} if(GV){DMA_V((t)+1,sl_next);} \
    CMASK(C0,C1,t); \
    { float a=MX3(C0[0],C0[1],C1[0]),b=MX3(C0[2],C0[3],C1[1]); a=MX3(a,C1[2],C1[3]); \
      _Pragma("unroll") for(int r=4;r<16;r+=4){a=MX3(a,C0[r],C0[r+1]);b=MX3(b,C0[r+2],C0[r+3]);a=MX3(a,C1[r],C1[r+1]);b=MX3(b,C1[r+2],C1[r+3]);} \
      float rm=__builtin_fmaxf(a,b); { auto rr=__builtin_amdgcn_permlane32_swap(__float_as_uint(rm),__float_as_uint(rm),false,false); rm=__builtin_fmaxf(__uint_as_float(rr[0]),__uint_as_float(rr[1])); } \
      resc=false; \
      rm-=mhat; \
      if(__builtin_expect(__any(rm>(float)THRL),0)){ const float dl=__builtin_fmaxf(rm,0.f); mhat+=dl; \
        const float f=__builtin_amdgcn_exp2f(-dl); l_reg*=f; if(hi==0)wsf[r32]=f; resc=true; } } \
    SBAR(); \
    GAPB(o[0]=__builtin_amdgcn_mfma_f32_32x32x16_bf16(PAF(0),VFR(0),o[0],0,0,0), C0,0); \
    GAPB(o[1]=__builtin_amdgcn_mfma_f32_32x32x16_bf16(PAF(0),VFR(4),o[1],0,0,0), C0,4); \
    KRD(GL,0); GAPB(o[0]=__builtin_amdgcn_mfma_f32_32x32x16_bf16(PAF(1),VFR(1),o[0],0,0,0), C0,8); \
    KRD(GL,1); GAPB(o[1]=__builtin_amdgcn_mfma_f32_32x32x16_bf16(PAF(1),VFR(5),o[1],0,0,0), C0,12); \
    KRD(GL,2); GAPB(o[0]=__builtin_amdgcn_mfma_f32_32x32x16_bf16(PAF(2),VFR(2),o[0],0,0,0), C1,0); \
    KRD(GL,3); GAPB(o[1]=__builtin_amdgcn_mfma_f32_32x32x16_bf16(PAF(2),VFR(6),o[1],0,0,0), C1,4); \
    GAPB(o[0]=__builtin_amdgcn_mfma_f32_32x32x16_bf16(PAF(3),VFR(3),o[0],0,0,0), C1,8); \
    GAPB(o[1]=__builtin_amdgcn_mfma_f32_32x32x16_bf16(PAF(3),VFR(7),o[1],0,0,0), C1,12); \
    }while(0)
  int t=1;
  #define ENDW(tt) do{ if((tt)+3<NT){WAIT_BAR(2);} else if((tt)+2<NT){WAIT_BAR(1);} else {WAIT_BAR(0);} }while(0)
  for(;t+1<NT;t+=2){
    STEP(pB0,pB1,pA0,pA1,t,(t+3<NT),(t+1<NT),(t+1<NT));       ENDW(t);   RESC(); ROT();
    STEP(pA0,pA1,pB0,pB1,t+1,(t+4<NT),(t+2<NT),(t+2<NT));     ENDW(t+1); RESC(); ROT();
  }
  STEP(pB0,pB1,pA0,pA1,NT-1,false,false,false); RESC();
  { float sacc=pB0[0]+pB0[1]; _Pragma("unroll") for(int r=2;r<16;++r)sacc+=pB0[r]; _Pragma("unroll") for(int r=0;r<16;++r)sacc+=pB1[r]; l_reg+=sacc;
    pw0=(u32x4){PKW(pB0,0),PKW(pB0,2),PKW(pB0,4),PKW(pB0,6)};pw1=(u32x4){PKW(pB0,8),PKW(pB0,10),PKW(pB0,12),PKW(pB0,14)};pw2=(u32x4){PKW(pB1,0),PKW(pB1,2),PKW(pB1,4),PKW(pB1,6)};pw3=(u32x4){PKW(pB1,8),PKW(pB1,10),PKW(pB1,12),PKW(pB1,14)};
    SBAR(); pv(o,vb0+sl_cur,PAF(0),PAF(1),PAF(2),PAF(3)); }
  #undef PKW
  #undef PAF
  #undef VFR
  #undef PIN
  #undef MX3
  #undef GAPA
  #undef GAPB
  #undef EX
  #undef VRD
  #undef KRD
  #undef STEP
  #undef ENDW
  {auto rr=__builtin_amdgcn_permlane32_swap(__float_as_uint(l_reg),__float_as_uint(l_reg),false,false);l_reg=__uint_as_float(rr[0])+__uint_as_float(rr[1]);}
  l_reg+=__builtin_amdgcn_exp2f(sink_l2-mhat);
  if(hi==0)wsf[32+r32]=l_reg;asm volatile("s_waitcnt lgkmcnt(0)":::"memory");
  float rli[16];
  #pragma unroll
  for(int r=0;r<16;++r)rli[r]=__builtin_amdgcn_rcpf(wsf[32+crow(r,hi)]);
  { bf16*stg=(bf16*)(shm+LDS_OST)+wid*2048;
    #pragma unroll
    for(int r=0;r<16;++r){const int orow=crow(r,hi);
      #pragma unroll
      for(int d0=0;d0<2;++d0)stg[orow*64+d0*32+r32]=__float2bfloat16(o[d0][r]*rli[r]);}
    asm volatile("s_waitcnt lgkmcnt(0)":::"memory");
    #pragma unroll
    for(int i=0;i<4;++i){const int row=i*8+(lane>>3),ch=lane&7; const u32x4 v=*(const u32x4*)(stg+row*64+ch*8); *(u32x4*)(Ow+(long)row*OP+ch*8)=v;} }
  asm volatile("s_waitcnt lgkmcnt(0)\n\ts_barrier":::"memory");
  #undef TROW
  #undef DMA_K
  #undef DMA_V
  #undef CMASK
  #undef START
  #undef RESC
  #undef ROT
}
#undef SBAR
#undef WAIT_BAR
}

constexpr int NWAVES = 8, NTHREADS = 512;
constexpr int RING_BYTES = 131072;
constexpr int MISC_OFF = RING_BYTES;
constexpr int LDS_BYTES = 147456;
constexpr int CW_BAR = 4096;

struct Args { GAS const float* in[23]; GAS float* out; GAS unsigned char* ws; int ph_lo, ph_hi; };
enum { I_X = 0, I_C, I_CTX, I_CCTX, I_WMOD, I_BMOD, I_N1G, I_N2G, I_WIN, I_CONVW, I_GWS, I_GB, I_SINK, I_WBC, I_WBG, I_WBA, I_WOUT, I_FGU, I_FD, I_ROUTER, I_MGU, I_MD, I_FNG };

struct Ctx {
    LAS unsigned char* lds; int tid, lane, wave, G, wg;
    const Args __attribute__((address_space(4)))* a; GAS unsigned char* ws;
};

__device__ __forceinline__ int zmap(int n) {
    const int pn = n >> 8;
    if (pn < 5 || pn > 7) return n;
    const int half = (n >> 7) & 1, hc = n & 127, idx = hc & 31, d = (idx < 16 ? idx : idx + 16) + 16 * half;
    if (pn < 7) return 1280 + (((pn - 5) * 4 + (hc >> 5)) * 64) + d;
    if (hc < 64) return 1792 + (hc >> 5) * 64 + d;
    return 1920 + half * 64 + (hc - 64);
}
__device__ __forceinline__ int gumap(int n, int ff) { const int p = n >> 8, half = (n >> 7) & 1, hc = n & 127; return half * ff + p * 128 + hc; }
template <int MAP> __device__ __forceinline__ void transpose_item(const float* W, int Nsrc, int Ndst, bf16_t* WT, int ldwt, int koff, int ff, LAS float* scr, int item, int lane) {
    const int nblk = Ndst / 32, kb = item / nblk, nb = item % nblk, k0 = 64 * kb, n0 = 32 * nb;
    const int nd = n0 + (lane & 31); const int sc = MAP == 0 ? nd : (MAP == 1 ? zmap(nd) : gumap(nd, ff));
    float wv[32];
#pragma unroll
    for (int i = 0; i < 32; ++i) wv[i] = W[(size_t)(k0 + 2 * i + (lane >> 5)) * Nsrc + sc];
#pragma unroll
    for (int i = 0; i < 32; ++i) scr[(2 * i + (lane >> 5)) * 33 + (lane & 31)] = wv[i];
    LDS_WAIT(); asm volatile("" ::: "memory");
    const int c = lane & 7;
#pragma unroll
    for (int j = 0; j < 4; ++j) { const int n = (lane >> 3) + 8 * j; const LAS float* s = scr + (8 * c) * 33 + n;
        u32x4 o; o.x = cvt_pk_bf16(s[0 * 33], s[1 * 33]); o.y = cvt_pk_bf16(s[2 * 33], s[3 * 33]); o.z = cvt_pk_bf16(s[4 * 33], s[5 * 33]); o.w = cvt_pk_bf16(s[6 * 33], s[7 * 33]);
        *(u32x4*)(WT + (size_t)(n0 + n) * ldwt + koff + k0 + 8 * c) = o; }
    LDS_WAIT(); asm volatile("" ::: "memory");
}
template <int MAP> __device__ __forceinline__ void transpose_item8(const float* W, int Nsrc, int Ndst, unsigned char* WT, int ldwt, int ff, float scale, LAS float* scr, int item, int lane, int koff = 0) {
    const int nblk = Ndst / 32, kb = item / nblk, nb = item % nblk, k0 = 64 * kb, n0 = 32 * nb;
    const int nd = n0 + (lane & 31); const int sc = MAP == 0 ? nd : (MAP == 1 ? zmap(nd) : gumap(nd, ff));
    float wv[32];
#pragma unroll
    for (int i = 0; i < 32; ++i) wv[i] = W[(size_t)(k0 + 2 * i + (lane >> 5)) * Nsrc + sc];
#pragma unroll
    for (int i = 0; i < 32; ++i) scr[(2 * i + (lane >> 5)) * 33 + (lane & 31)] = wv[i] * scale;
    LDS_WAIT(); asm volatile("" ::: "memory");
    const int c = lane & 3;
#pragma unroll
    for (int j = 0; j < 2; ++j) { const int n = (lane >> 2) + 16 * j; const LAS float* s = scr + (16 * c) * 33 + n;
        u32x4 o; o.x = pk4_fp8(s[0 * 33], s[1 * 33], s[2 * 33], s[3 * 33]); o.y = pk4_fp8(s[4 * 33], s[5 * 33], s[6 * 33], s[7 * 33]); o.z = pk4_fp8(s[8 * 33], s[9 * 33], s[10 * 33], s[11 * 33]); o.w = pk4_fp8(s[12 * 33], s[13 * 33], s[14 * 33], s[15 * 33]);
        *(u32x4*)(WT + (size_t)(n0 + n) * ldwt + koff + k0 + 16 * c) = o; }
    LDS_WAIT(); asm volatile("" ::: "memory");
}
template <int MAP> __device__ __forceinline__ void transpose_class8(const Ctx& F, const float* W, size_t wstride, int K, int Nsrc, int Ndst, unsigned char* WT, size_t wtstride, int ldwt, int ff, float scale, int nmat, int koff = 0) {
    LAS float* scr = (LAS float*)(F.lds + F.wave * 16384);
    const int per = (K / 64) * (Ndst / 32), total = per * nmat, gw = F.wg * NWAVES + F.wave, NGW = F.G * NWAVES;
    for (int it = gw; it < total; it += NGW) { const int mi = it / per, r = it - mi * per;
        transpose_item8<MAP>(W + (size_t)mi * wstride, Nsrc, Ndst, WT + (size_t)mi * wtstride, ldwt, ff, scale, scr, r, F.lane, koff); }
}
template <int MAP> __device__ __forceinline__ void transpose_class(const Ctx& F, const float* W, size_t wstride, int K, int Nsrc, int Ndst, bf16_t* WT, size_t wtstride, int ldwt, int koff, int ff, int nmat) {
    LAS float* scr = (LAS float*)(F.lds + F.wave * 16384);
    const int per = (K / 64) * (Ndst / 32), total = per * nmat, gw = F.wg * NWAVES + F.wave, NGW = F.G * NWAVES;
    for (int it = gw; it < total; it += NGW) { const int mi = it / per, r = it - mi * per;
        transpose_item<MAP>(W + (size_t)mi * wstride, Nsrc, Ndst, WT + (size_t)mi * wtstride, ldwt, koff, ff, scr, r, F.lane); }
}
__device__ __forceinline__ void ada_tasks(const Ctx& F) {
    LAS float* St = (LAS float*)F.lds;
    LAS float* red = (LAS float*)(F.lds + 1024 * 20 * 4);
    const float* c = as_global(F.a->in[I_C]); const float* cc = as_global(F.a->in[I_CCTX]);
    bool have = false;
    for (int task = F.wg; task < DEPTH * 96; task += F.G) {
        if (!have) { for (int i = F.tid; i < NMODR * 1024; i += NTHREADS) { const int r = i >> 10, k = i & 1023; const float v = r < 16 ? c[r * 1024 + k] : cc[k]; St[k * 20 + r] = fast_silu(v); }
            LDS_WAIT(); __syncthreads(); have = true; }
        const int layer = task / 96, n0 = (task % 96) * 64; const float* W = as_global(F.a->in[I_WMOD]) + (size_t)layer * 1024 * 6144 + n0 + F.lane;
        float accv[NMODR];
#pragma unroll
        for (int r = 0; r < NMODR; ++r) accv[r] = 0.f;
        const int kb = F.wave * 128;
#pragma unroll 16
        for (int k = 0; k < 128; ++k) { const float w = W[(size_t)(kb + k) * 6144]; const LAS float* s = St + (kb + k) * 20;
            const f32x4 s0 = *(const LAS f32x4*)s, s1 = *(const LAS f32x4*)(s + 4), s2 = *(const LAS f32x4*)(s + 8), s3 = *(const LAS f32x4*)(s + 12); const float s4 = s[16];
#pragma unroll
            for (int j = 0; j < 4; ++j) { accv[j] += s0[j] * w; accv[4 + j] += s1[j] * w; accv[8 + j] += s2[j] * w; accv[12 + j] += s3[j] * w; }
            accv[16] += s4 * w; }
#pragma unroll
        for (int r = 0; r < NMODR; ++r) red[(F.wave * NMODR + r) * 64 + F.lane] = accv[r];
        LDS_WAIT(); __syncthreads();
        for (int i = F.tid; i < NMODR * 64; i += NTHREADS) { const int r = i >> 6, l = i & 63; float s = as_global(F.a->in[I_BMOD])[layer * 6144 + n0 + l];
#pragma unroll
            for (int w = 0; w < 8; ++w) s += red[(w * NMODR + r) * 64 + l];
            ((float*)(F.ws + WS_MOD))[((size_t)layer * NMODR + r) * 6144 + n0 + l] = s; }
        LDS_WAIT(); __syncthreads();
    }
    __syncthreads();
}
__device__ __forceinline__ void prologue_phase(const Ctx& F) {
    ada_tasks(F);
    const int gt = F.wg * NTHREADS + F.tid, NGT = F.G * NTHREADS;
    if (gt < 1024) { const int pos = gt >> 4, f = gt & 15; const double ang = (double)pos * pow(10000.0, -(double)f / 16.0);
        float* rp = (float*)(F.ws + WS_ROPE); rp[gt] = (float)cos(ang); rp[1024 + gt] = (float)sin(ang); }
    { const float* s = as_global(F.a->in[I_GWS]); bf16_t* d = (bf16_t*)(F.ws + WS_GWS);
      for (int i = gt; i < DEPTH * 4 * 128 * 128 / 2; i += NGT) ((unsigned*)d)[i] = cvt_pk_bf16(s[2 * i], s[2 * i + 1]); }
#if Z8
    transpose_class8<1>(F, as_global(F.a->in[I_WIN]), (size_t)D * DIN, D, DIN, 2048, (unsigned char*)(F.ws + WS_WIN), (size_t)2048 * D, D, 0, W_GU_SCALE, DEPTH);
#else
    transpose_class<1>(F, as_global(F.a->in[I_WIN]), (size_t)D * DIN, D, DIN, 2048, (bf16_t*)(F.ws + WS_WIN), (size_t)2048 * D, D, 0, 0, DEPTH);
#endif
    transpose_class8<0>(F, as_global(F.a->in[I_WIN]) + 2048, (size_t)D * DIN, D, DIN, 3072, (unsigned char*)(F.ws + WS_WG8), (size_t)3072 * D, D, 0, W_GU_SCALE, DEPTH);
    transpose_class<0>(F, as_global(F.a->in[I_WBC]), (size_t)256 * D, 256, D, D, (bf16_t*)(F.ws + WS_WBR), (size_t)D * D, D, 0, 0, DEPTH);
    transpose_class<0>(F, as_global(F.a->in[I_WBG]), (size_t)256 * D, 256, D, D, (bf16_t*)(F.ws + WS_WBR), (size_t)D * D, D, 256, 0, DEPTH);
    transpose_class<0>(F, as_global(F.a->in[I_WBA]), (size_t)512 * D, 512, D, D, (bf16_t*)(F.ws + WS_WBR), (size_t)D * D, D, 512, 0, DEPTH);
#if MERGE8
    for (int rep3 = 0; rep3 < 3; ++rep3) transpose_class8<0>(F, as_global(F.a->in[I_WOUT]), (size_t)D * D, D, D, D, (unsigned char*)(F.ws + WS_WO8), (size_t)D * 3072, 3072, 0, W_GU_SCALE, DEPTH, rep3 * 1024);
#else
    transpose_class<0>(F, as_global(F.a->in[I_WOUT]), (size_t)D * D, D, D, D, (bf16_t*)(F.ws + WS_WO), (size_t)D * D, D, 0, 0, DEPTH);
#endif
    transpose_class<2>(F, as_global(F.a->in[I_FGU]), (size_t)D * 2 * DFF, D, 2 * DFF, 2 * DFF, (bf16_t*)(F.ws + WS_FGU), (size_t)2 * DFF * D, D, 0, DFF, 1);
    transpose_class8<2>(F, as_global(F.a->in[I_FGU]) + (size_t)D * 2 * DFF, (size_t)D * 2 * DFF, D, 2 * DFF, 2 * DFF, (unsigned char*)(F.ws + WS_FGU) + (size_t)2 * DFF * D * 2, (size_t)2 * DFF * D, D, DFF, W_GU_SCALE, 1);
    transpose_class<0>(F, as_global(F.a->in[I_FD]), (size_t)DFF * D, DFF, D, D, (bf16_t*)(F.ws + WS_FD), (size_t)D * DFF, DFF, 0, 0, 1);
    transpose_class8<0>(F, as_global(F.a->in[I_FD]) + (size_t)DFF * D, (size_t)DFF * D, DFF, D, D, (unsigned char*)(F.ws + WS_FD) + (size_t)D * DFF * 2, (size_t)D * DFF, DFF, 0, W_D_SCALE, 1);
    transpose_class8<2>(F, as_global(F.a->in[I_MGU]), (size_t)D * 2 * DFE, D, 2 * DFE, 2 * DFE, (unsigned char*)(F.ws + WS_MGU), (size_t)2 * DFE * D, D, DFE, W_GU_SCALE, 2 * NEXP);
    transpose_class8<0>(F, as_global(F.a->in[I_MD]), (size_t)DFE * D, DFE, D, D, (unsigned char*)(F.ws + WS_MD), (size_t)D * DFE, DFE, 0, W_D_SCALE, 2 * NEXP);
    __syncthreads();
}

struct NormP {
    int M, layer;
    const float* xin_x; const float* xin_c; float* xout_x; float* xout_c;
    const float* gain; int chunk;
    bf16_t* HX; unsigned char* HX8;
    const float* g2prev;
    const float* router;
};
template <bool COMBINE, bool ROUTER, bool FINAL, bool OUT8 = false, bool DUAL = false> __device__ __forceinline__ void norm_phase(const Ctx& F, const NormP& P) {
    const float* MOD = (const float*)(F.ws + WS_MOD) + (size_t)P.layer * NMODR * 6144;
    const bf16_t* Y = (const bf16_t*)(F.ws + WS_RA); const f32x2* selw = (const f32x2*)(F.ws + WS_SELW);
    int* sel_e = (int*)(F.ws + WS_SELE); f32x2* selw_o = (f32x2*)(F.ws + WS_SELW);
    LAS float* RT = (LAS float*)F.lds; LAS int* cl = (LAS int*)(F.lds + 32768);
    if (ROUTER) { for (int i = F.tid; i < 8192; i += NTHREADS) RT[i] = P.router[i]; if (F.tid < 8) cl[F.tid] = 0; LDS_WAIT(); __syncthreads(); }
    const int nr = (P.M + F.G - 1) / F.G;
    const int r0 = ROUTER ? F.wg * nr : F.wg * NWAVES, r1 = ROUTER ? ((r0 + nr < P.M) ? r0 + nr : P.M) : P.M; const int rstep = ROUTER ? NWAVES : F.G * NWAVES;
    const int l4 = F.lane * 4;
    f32x4 gn[4], sh[4], sc[4], g2[4];
#pragma unroll
    for (int j = 0; j < 4; ++j) { gn[j] = *(const f32x4*)(P.gain + 256 * j + l4); sh[j] = sc[j] = g2[j] = (f32x4){0.f, 0.f, 0.f, 0.f}; }
    int curb = -1;
    f32x4 vn[4];
    { const int row = r0 + F.wave; if (row < r1) { const float* xr = row < TX ? P.xin_x + (size_t)row * D : P.xin_c + (size_t)(row - TX) * D;
#pragma unroll
        for (int j = 0; j < 4; ++j) vn[j] = *(const f32x4*)(xr + 256 * j + l4); } }
    for (int row = r0 + F.wave; row < r1; row += rstep) {
        const bool isx = row < TX; const int b = isx ? (row >> 12) : 16;
        if (b != curb) { curb = b;
#pragma unroll
            for (int j = 0; j < 4; ++j) { if (!FINAL) { sh[j] = *(const f32x4*)(MOD + (size_t)b * 6144 + P.chunk * 1024 + 256 * j + l4); sc[j] = *(const f32x4*)(MOD + (size_t)b * 6144 + (P.chunk + 1) * 1024 + 256 * j + l4); }
                if (COMBINE) g2[j] = *(const f32x4*)(P.g2prev + (size_t)b * 6144 + 256 * j + l4); } }
        f32x4 v[4];
#pragma unroll
        for (int j = 0; j < 4; ++j) v[j] = vn[j];
        { const int nrow = row + rstep; if (nrow < r1) { const float* xr = nrow < TX ? P.xin_x + (size_t)nrow * D : P.xin_c + (size_t)(nrow - TX) * D;
#pragma unroll
            for (int j = 0; j < 4; ++j) vn[j] = *(const f32x4*)(xr + 256 * j + l4); } }
        if (COMBINE) { const f32x2 w = selw[row]; float* xo = isx ? P.xout_x + (size_t)row * D : P.xout_c + (size_t)(row - TX) * D;
            u32x2 yq0[4], yq1[4];
#pragma unroll
            for (int j = 0; j < 4; ++j) { yq0[j] = *(const u32x2*)(Y + (size_t)row * D + 256 * j + l4); yq1[j] = *(const u32x2*)(Y + ((size_t)T + row) * D + 256 * j + l4); }
#pragma unroll
            for (int j = 0; j < 4; ++j) { const u32x2 y0 = yq0[j], y1 = yq1[j];
                const f32x4 a = (f32x4){bf_lo(y0.x), bf_hi(y0.x), bf_lo(y0.y), bf_hi(y0.y)}, c = (f32x4){bf_lo(y1.x), bf_hi(y1.x), bf_lo(y1.y), bf_hi(y1.y)};
                v[j] += g2[j] * (a * w.x + c * w.y); if (!FINAL) *(f32x4*)(xo + 256 * j + l4) = v[j]; } }
        float ss = 0.f;
#pragma unroll
        for (int j = 0; j < 4; ++j) ss += (v[j].x * v[j].x + v[j].y * v[j].y) + (v[j].z * v[j].z + v[j].w * v[j].w);
        const float rs = 1.0f / sqrtf(wave_sum(ss) * (1.0f / D) + EPS);
        if (FINAL) { float* xo = P.xout_x + (size_t)row * D;
#pragma unroll
            for (int j = 0; j < 4; ++j) *(f32x4*)(xo + 256 * j + l4) = v[j] * rs * gn[j];
        } else {
#pragma unroll
            for (int j = 0; j < 4; ++j) { v[j] = v[j] * rs * gn[j] * (sc[j] + 1.0f) + sh[j];
                if (OUT8) *(unsigned*)((unsigned char*)P.HX + (size_t)row * D + 256 * j + l4) = pk4_fp8(v[j].x * A8_SCALE, v[j].y * A8_SCALE, v[j].z * A8_SCALE, v[j].w * A8_SCALE);
                else { u32x2 o; o.x = cvt_pk_bf16(v[j].x, v[j].y); o.y = cvt_pk_bf16(v[j].z, v[j].w); *(u32x2*)(P.HX + (size_t)row * D + 256 * j + l4) = o;
                    if (DUAL) *(unsigned*)(P.HX8 + (size_t)row * D + 256 * j + l4) = pk4_fp8(v[j].x * A8_SCALE, v[j].y * A8_SCALE, v[j].z * A8_SCALE, v[j].w * A8_SCALE); } }
            if (ROUTER) { float lg[8];
#pragma unroll
                for (int e = 0; e < 8; ++e) lg[e] = 0.f;
#pragma unroll
                for (int j = 0; j < 4; ++j)
#pragma unroll
                    for (int q = 0; q < 4; ++q) { const LAS float* rp = RT + (256 * j + l4 + q) * 8; const f32x4 ra = *(const LAS f32x4*)rp, rb = *(const LAS f32x4*)(rp + 4); const float hv = v[j][q];
#pragma unroll
                        for (int e = 0; e < 4; ++e) { lg[e] += hv * ra[e]; lg[4 + e] += hv * rb[e]; } }
#pragma unroll
                for (int e = 0; e < 8; ++e) lg[e] = wave_sum(lg[e]);
                int e0 = 0; float v0 = lg[0];
#pragma unroll
                for (int e = 1; e < 8; ++e) if (lg[e] > v0) { v0 = lg[e]; e0 = e; }
                int e1 = -1; float v1 = -INFINITY;
#pragma unroll
                for (int e = 0; e < 8; ++e) if (e != e0 && lg[e] > v1) { v1 = lg[e]; e1 = e; }
                if (F.lane == 0) { const float w0 = 1.0f / (1.0f + expf(v1 - v0)); sel_e[row] = e0 | (e1 << 8); selw_o[row] = (f32x2){w0, 1.0f - w0};
                    __hip_atomic_fetch_add(cl + e0, 1, __ATOMIC_RELAXED, __HIP_MEMORY_SCOPE_WORKGROUP); __hip_atomic_fetch_add(cl + e1, 1, __ATOMIC_RELAXED, __HIP_MEMORY_SCOPE_WORKGROUP); } }
        }
    }
    if (ROUTER) { LDS_WAIT(); __syncthreads(); if (F.tid < 8) ((int*)(F.ws + WS_CNT))[F.wg * 8 + F.tid] = cl[F.tid]; }
    __syncthreads();
}

__device__ __forceinline__ void moe_gather_phase(const Ctx& F, int M, const bf16_t* HX) {
    LAS int* sm = (LAS int*)F.lds;
    const int* cnt = (const int*)(F.ws + WS_CNT); const int* sel_e = (const int*)(F.ws + WS_SELE);
    int* rinfo = (int*)(F.ws + WS_RINFO); unsigned char* AS = (unsigned char*)(F.ws + WS_RA);
    const int nr = (M + F.G - 1) / F.G, r0 = F.wg * nr, r1 = (r0 + nr < M) ? r0 + nr : M;
    { const int e = F.wave;
      int c4[4]; int s = 0;
#pragma unroll
      for (int j = 0; j < 4; ++j) { const int w = 4 * F.lane + j; c4[j] = (w < F.G) ? cnt[w * 8 + e] : 0; s += c4[j]; }
      int incl = s;
#pragma unroll
      for (int o = 1; o < 64; o <<= 1) { const int t = lane_read(incl, F.lane >= o ? F.lane - o : F.lane); if (F.lane >= o) incl += t; }
      const int tot = __builtin_amdgcn_readlane(incl, 63); int excl = incl - s;
      if (F.lane == (F.wg >> 2)) { for (int j = 0; j < (F.wg & 3); ++j) excl += c4[j]; sm[8 + e] = excl; }
      if (F.lane == 0) sm[e] = tot; }
    LDS_WAIT(); __syncthreads();
    if (F.tid == 0) { int s = 0; for (int e = 0; e < 8; ++e) { sm[16 + e] = s; s += (sm[e] + 255) & ~255; } sm[24] = s; }
    LDS_WAIT(); __syncthreads();
    if (F.wg == 0 && F.tid < 9) ((int*)(F.ws + WS_META))[F.tid] = sm[16 + F.tid] >> 8;
    if (F.wg < 8) { const int e = F.wg, lo = sm[16 + e] + sm[e], hi = sm[17 + e]; for (int i = lo + F.tid; i < hi; i += NTHREADS) rinfo[i] = -1; }
    LAS int* pos0 = sm + 64; LAS int* pos1 = pos0 + nr;
    if (F.wave == 0) { int run[8];
#pragma unroll
        for (int e = 0; e < 8; ++e) run[e] = sm[16 + e] + sm[8 + e];
        for (int base = r0; base < r1; base += 64) { const int t = base + F.lane; const bool valid = t < r1; const int ee = valid ? sel_e[t] : 0xffff; const int e0 = ee & 0xff, e1 = (ee >> 8) & 0xff;
            int p0 = 0, p1 = 0; const unsigned long long lt = (1ull << F.lane) - 1ull;
#pragma unroll
            for (int e = 0; e < 8; ++e) { const unsigned long long m = __ballot(valid && (e0 == e || e1 == e)); const int pc = __popcll(m & lt);
                if (e0 == e) p0 = run[e] + pc; if (e1 == e) p1 = run[e] + pc; run[e] += __popcll(m); }
            if (valid) { pos0[t - r0] = p0; pos1[t - r0] = p1; rinfo[p0] = t; rinfo[p1] = t | (1 << 20); } } }
    LDS_WAIT(); __syncthreads();
    for (int p0 = F.wave; p0 < 2 * (r1 - r0); p0 += 4 * NWAVES) {
        u32x4 rq[4]; int dsts[4];
#pragma unroll
        for (int e = 0; e < 4; ++e) { const int p = p0 + e * NWAVES; const bool ok = p < 2 * (r1 - r0); const int tl = ok ? (p >> 1) : 0, k = p & 1; dsts[e] = ok ? (k ? pos1[tl] : pos0[tl]) : -1;
            rq[e] = ((const u32x4*)((const unsigned char*)HX + (size_t)(r0 + tl) * D))[F.lane]; }
#pragma unroll
        for (int e = 0; e < 4; ++e) if (dsts[e] >= 0) ((u32x4*)(AS + (size_t)dsts[e] * D))[F.lane] = rq[e]; }
    __syncthreads();
}

constexpr int GM_PITCH = 272;
__device__ __forceinline__ void gmlp_units(const Ctx& F, int layer, int M, const bf16_t* ZG, bf16_t* Y) {
    const bf16_t* GWS = (const bf16_t*)(F.ws + WS_GWS) + (size_t)layer * 4 * 128 * 128; const float* GB = as_global(F.a->in[I_GB]) + layer * 512;
    const int g = F.wave >> 1, ph = F.wave & 1, r = F.lane & 31, h = F.lane >> 5;
    bf16x8 wf[2][8];
#pragma unroll
    for (int pt = 0; pt < 2; ++pt)
#pragma unroll
        for (int s = 0; s < 8; ++s) wf[pt][s] = *(const bf16x8*)(GWS + ((size_t)g * 128 + ph * 64 + 32 * pt + r) * 128 + 16 * s + 8 * h);
    float bsv[2];
#pragma unroll
    for (int pt = 0; pt < 2; ++pt) bsv[pt] = GB[g * 128 + ph * 64 + 32 * pt + r];
    LAS unsigned char* VT = F.lds;
    const int nchunk = M / 128;
    for (int ch = F.wg; ch < nchunk; ch += F.G) {
        const int r0 = ch * 128;
        u32x2 vq[16];
#pragma unroll
        for (int i = 0; i < 16; ++i) vq[i] = *(const u32x2*)(ZG + (size_t)(r0 + 16 * F.wave + i) * 512 + 256 + 4 * F.lane);
#pragma unroll
        for (int i = 0; i < 8; ++i) { const int q = 16 * F.wave + 2 * i;
            const u32x2 wa = vq[2 * i], wb = vq[2 * i + 1];
            f32x4 a = (f32x4){bf_lo(wa.x), bf_hi(wa.x), bf_lo(wa.y), bf_hi(wa.y)}, b = (f32x4){bf_lo(wb.x), bf_hi(wb.x), bf_lo(wb.y), bf_hi(wb.y)};
            const float ma = wave_sum((a.x + a.y) + (a.z + a.w)) * (1.0f / 256.0f), mb = wave_sum((b.x + b.y) + (b.z + b.w)) * (1.0f / 256.0f);
            a = a - ma; b = b - mb;
            const float va = wave_sum((a.x * a.x + a.y * a.y) + (a.z * a.z + a.w * a.w)) * (1.0f / 256.0f), vb = wave_sum((b.x * b.x + b.y * b.y) + (b.z * b.z + b.w * b.w)) * (1.0f / 256.0f);
            const float ra = 1.0f / sqrtf(va + EPS), rb = 1.0f / sqrtf(vb + EPS);
#pragma unroll
            for (int j = 0; j < 4; ++j) *(LAS unsigned*)(VT + (4 * F.lane + j) * GM_PITCH + 2 * q) = cvt_pk_bf16(a[j] * ra, b[j] * rb); }
        LDS_WAIT(); __syncthreads();
        f32x16 acc[2][2];
#pragma unroll
        for (int ct = 0; ct < 2; ++ct)
#pragma unroll
            for (int pt = 0; pt < 2; ++pt) acc[ct][pt] = f32x16{};
#pragma unroll
        for (int s = 0; s < 8; ++s)
#pragma unroll
            for (int ct = 0; ct < 2; ++ct) { const bf16x8 af = *(const LAS bf16x8*)(VT + (g * 64 + 32 * ct + r) * GM_PITCH + 32 * s + 16 * h);
#pragma unroll
                for (int pt = 0; pt < 2; ++pt) acc[ct][pt] = __builtin_amdgcn_mfma_f32_32x32x16_bf16(af, wf[pt][s], acc[ct][pt], 0, 0, 0); }
        u32x2 uq[2][2][4];
#pragma unroll
        for (int pt = 0; pt < 2; ++pt) { const size_t row = (size_t)(r0 + ph * 64 + 32 * pt + r);
#pragma unroll
            for (int ct = 0; ct < 2; ++ct)
#pragma unroll
                for (int rg = 0; rg < 4; ++rg) uq[pt][ct][rg] = *(const u32x2*)(ZG + row * 512 + g * 64 + 32 * ct + 8 * rg + 4 * h); }
#pragma unroll
        for (int pt = 0; pt < 2; ++pt) { const size_t row = (size_t)(r0 + ph * 64 + 32 * pt + r);
#pragma unroll
            for (int ct = 0; ct < 2; ++ct)
#pragma unroll
                for (int rg = 0; rg < 4; ++rg) { const int c0 = g * 64 + 32 * ct + 8 * rg + 4 * h; const u32x2 uw = uq[pt][ct][rg];
                    const float y0 = bf_lo(uw.x) * (acc[ct][pt][4 * rg + 0] + bsv[pt]), y1 = bf_hi(uw.x) * (acc[ct][pt][4 * rg + 1] + bsv[pt]);
                    const float y2 = bf_lo(uw.y) * (acc[ct][pt][4 * rg + 2] + bsv[pt]), y3 = bf_hi(uw.y) * (acc[ct][pt][4 * rg + 3] + bsv[pt]);
                    u32x2 o; o.x = cvt_pk_bf16(y0, y1); o.y = cvt_pk_bf16(y2, y3); *(u32x2*)(Y + row * D + 256 + c0) = o; } }
        LDS_WAIT(); __syncthreads();
    }
}
__device__ __forceinline__ void conv_units(const Ctx& F, int layer, int M, const bf16_t* ZC, bf16_t* Y) {
    const float* CW = as_global(F.a->in[I_CONVW]) + layer * 768;
    const int gt = F.wg * NTHREADS + F.tid, NGT = F.G * NTHREADS;
    for (int it0 = gt; it0 < M * 32; it0 += 2 * NGT) {
        u32x4 q[2][7]; bool act[2], hasp[2], hasn[2];
#pragma unroll
        for (int e = 0; e < 2; ++e) { const int it = it0 + e * NGT; act[e] = it < M * 32; const int row = act[e] ? (it >> 5) : 0, c0 = (it & 31) * 8;
            const int s = row < TX ? (row & (SEQ - 1)) : ((row - TX) & (CTXL - 1)), L = row < TX ? SEQ : CTXL; hasp[e] = s > 0; hasn[e] = s < L - 1;
            const bf16_t* zp = ZC + (size_t)row * 768 + c0;
            q[e][0] = *(const u32x4*)zp; q[e][1] = *(const u32x4*)(zp + 256); q[e][2] = *(const u32x4*)(zp + 512);
            q[e][3] = hasp[e] ? *(const u32x4*)(zp - 768 + 256) : (u32x4){0u, 0u, 0u, 0u}; q[e][4] = hasp[e] ? *(const u32x4*)(zp - 768 + 512) : (u32x4){0u, 0u, 0u, 0u};
            q[e][5] = hasn[e] ? *(const u32x4*)(zp + 768 + 256) : (u32x4){0u, 0u, 0u, 0u}; q[e][6] = hasn[e] ? *(const u32x4*)(zp + 768 + 512) : (u32x4){0u, 0u, 0u, 0u}; }
#pragma unroll
        for (int e = 0; e < 2; ++e) { if (!act[e]) continue; const int it = it0 + e * NGT, row = it >> 5, c0 = (it & 31) * 8;
            f32x4 bg0, bg1, c0a, c0b, h0a, h0b, ca, cb, ha, hb; unpack8(q[e][0], bg0, bg1); unpack8(q[e][1], c0a, c0b); unpack8(q[e][2], h0a, h0b);
            const f32x4 w0a = *(const f32x4*)(CW + c0), w0b = *(const f32x4*)(CW + c0 + 4), w1a = *(const f32x4*)(CW + 256 + c0), w1b = *(const f32x4*)(CW + 256 + c0 + 4), w2a = *(const f32x4*)(CW + 512 + c0), w2b = *(const f32x4*)(CW + 512 + c0 + 4);
            f32x4 sa = w1a * (c0a * h0a), sb = w1b * (c0b * h0b);
            unpack8(q[e][3], ca, cb); unpack8(q[e][4], ha, hb); sa += w0a * (ca * ha); sb += w0b * (cb * hb);
            unpack8(q[e][5], ca, cb); unpack8(q[e][6], ha, hb); sa += w2a * (ca * ha); sb += w2b * (cb * hb);
            *(u32x4*)(Y + (size_t)row * D + c0) = pack8(bg0 * sa, bg1 * sb); }
    }
}
__device__ __forceinline__ void mixer_phase(const Ctx& F, int layer, bool ctx_out) {
    GAS unsigned char* rh = F.ws + WS_RH;
    const attn_body::bf16* Q = (const attn_body::bf16*)(rh + RH_Q); const attn_body::bf16* K = (const attn_body::bf16*)(rh + RH_K); const attn_body::bf16* V = (const attn_body::bf16*)(rh + RH_V);
    attn_body::bf16* Y = (attn_body::bf16*)(rh + RH_BUFA);
    const float* sink = as_global(F.a->in[I_SINK]) + layer * 8;
    char* shm = (char*)F.lds;
    for (int uid = F.wg; uid < NB * 32 * 4; uid += F.G) {
        const int hp = uid & 3, n = (uid >> 2) & 31, b = uid >> 7, kvh = hp >> 1, head = 2 * hp + (F.wave >> 2);
        const int i_lo = n == 0 ? 2 : 0, i_hi = n == 31 ? 3 : 5, NT = 4 + (i_hi - i_lo + 1);
        const int qrow = b * SEQ + n * 128 + 32 * (F.wave & 3), lrow0 = b * SEQ + n * 128 - 128 + 64 * i_lo, crow0 = TX + b * CTXL;
        const int qoff0 = 32 * (F.wave & 3) + 128 - 64 * i_lo;
        attn_body::attn_unit<8>(Q + (size_t)qrow * 512 + head * 64, K + kvh * 64, V + kvh * 64, Y + (size_t)qrow * D + 512 + head * 64, crow0, lrow0, NT, qoff0, sink[head] * 1.4426950408889634f, shm);
    }
    if (ctx_out) for (int uid = F.wg; uid < NB * 4 * 2; uid += F.G) {
        const int hp = uid & 3, half = (uid >> 2) & 1, b = uid >> 3, kvh = hp >> 1, head = 2 * hp + (F.wave >> 2);
        const int qrow = TX + b * CTXL + half * 128 + 32 * (F.wave & 3), crow0 = TX + b * CTXL;
        attn_body::attn_unit<8>(Q + (size_t)qrow * 512 + head * 64, K + kvh * 64, V + kvh * 64, Y + (size_t)qrow * D + 512 + head * 64, crow0, 0, 4, 0, sink[head] * 1.4426950408889634f, shm);
    }
    __syncthreads();
    const int M = ctx_out ? T : TX;
#ifndef REP_GC
#define REP_GC 0
#endif
    _Pragma("nounroll") for (int rep_ = 0; rep_ < 1 + ((REP_GC >> 0) & 1); ++rep_) gmlp_units(F, layer, M, (const bf16_t*)(rh + RH_ZG), (bf16_t*)(rh + RH_BUFA));
    _Pragma("nounroll") for (int rep_ = 0; rep_ < 1 + ((REP_GC >> 1) & 1); ++rep_) conv_units(F, layer, M, (const bf16_t*)(rh + RH_ZC), (bf16_t*)(rh + RH_BUFA));
}

constexpr int NPHASES = 38;
__global__ void __launch_bounds__(NTHREADS, 2) fwd(Args args) {
    extern __shared__ __attribute__((aligned(16))) unsigned char lds_[];
    Ctx F; F.lds = (LAS unsigned char*)lds_; F.tid = threadIdx.x; F.lane = F.tid & 63; F.wave = __builtin_amdgcn_readfirstlane(F.tid >> 6); F.G = gridDim.x; F.wg = blockIdx.x; F.a = (const Args __attribute__((address_space(4)))*)__builtin_amdgcn_kernarg_segment_ptr(); F.ws = F.a->ws;
    volatile LAS unsigned* MISC = (volatile LAS unsigned*)(F.lds + MISC_OFF);
    for (int u = F.tid; u < (LDS_BYTES - MISC_OFF) / 4; u += NTHREADS) ((LAS unsigned*)(F.lds + MISC_OFF))[u] = 0u;
    __syncthreads();
    if (F.lane == 0) *(volatile LAS int*)(unsigned long)(WAVEMAP_OFF + 4 * hw_wave_key()) = F.wave;
    __syncthreads();
    XcdBarrier bar = xcd_barrier_post((unsigned*)(F.ws + WS_CTL) + CW_BAR, MISC + 8);
    const int lo = F.a->ph_lo, hi = F.a->ph_hi;
#ifndef PHMASK
#define PHMASK 0xffff
#endif
#define EN(b) ((PHMASK >> (b)) & 1)
#ifndef REP_MASK
#define REP_MASK 0
#endif
#define REPS(b) _Pragma("nounroll") for (int rep_ = 0; rep_ < (((REP_MASK >> (b)) & 1) ? 2 : 1); ++rep_)
#define IN(k) (lo <= (k) && (k) < hi)
#define SEAM(a, b) do { if (IN(a) && IN(b)) xcd_barrier(bar); } while (0)
#define REFRESH_G() do { const Args __attribute__((address_space(4)))* a_ = (const Args __attribute__((address_space(4)))*)__builtin_amdgcn_kernarg_segment_ptr(); asm volatile("" : "+s"(a_)); F.a = a_; GAS unsigned char* w_ = a_->ws; asm volatile("" : "+s"(w_)); F.ws = w_; } while (0)
#define REFRESH() do { F.tid = opaque_tid(); F.lane = F.tid & 63; F.wave = __builtin_amdgcn_readfirstlane(F.tid >> 6); const Args __attribute__((address_space(4)))* a_ = (const Args __attribute__((address_space(4)))*)__builtin_amdgcn_kernarg_segment_ptr(); asm volatile("" : "+s"(a_)); F.a = a_; GAS unsigned char* w_ = a_->ws; asm volatile("" : "+s"(w_)); F.ws = w_; } while (0)
#define rh (F.ws + WS_RH)
#define BUFA ((bf16_t*)(F.ws + WS_RH + RH_BUFA))
#define BUFB ((bf16_t*)(F.ws + WS_RH + RH_BUFB))
#define XC ((float*)(F.ws + WS_XC))
#define MODALL ((const float*)(F.ws + WS_MOD))

    if (EN(0) && IN(0)) REPS(0) { REFRESH(); prologue_phase(F); }
    SEAM(0, 1);
#pragma nounroll
    for (int i = 0; i < DEPTH; ++i) {
        const int pb = 1 + 9 * i; const bool moe = (i & 1) != 0, last = (i == DEPTH - 1); const int j = i >> 1;
        const int Mact = last ? TX : T, nMact = Mact / 256;
#define MODL (MODALL + (size_t)i * NMODR * 6144)
        if (EN(1) && IN(pb + 0)) REPS(1) { REFRESH(); NormP P; P.M = T; P.layer = i; P.xin_x = i == 0 ? as_global(F.a->in[I_X]) : as_global(F.a->out); P.xin_c = i == 0 ? as_global(F.a->in[I_CTX]) : XC; P.xout_x = as_global(F.a->out); P.xout_c = XC;
            P.gain = as_global(F.a->in[I_N1G]) + i * D; P.chunk = 0; P.HX = BUFA; P.g2prev = MODALL + (size_t)(i - 1) * NMODR * 6144 + 5 * D; P.router = nullptr;
            P.HX8 = (unsigned char*)BUFB;
            if (i == 2) norm_phase<true, false, false, false, true>(F, P); else norm_phase<false, false, false, false, true>(F, P); }
        SEAM(pb + 0, pb + 1);
        if (EN(2) && IN(pb + 1)) REPS(2) { REFRESH_G();
#if Z8
            { pg8::DenseSched S{(const char*)BUFB, (const char*)(F.ws + WS_WIN) + (size_t)i * 2048 * D, 1024u, 1024u, nMact, 8, D / 128, F.G, F.wg, last ? TC / 256 : 0, NPX, 7};
              pg8::EpiZ E{(bf16_t*)(rh + RH_ZC), (bf16_t*)(rh + RH_ZG), (bf16_t*)(rh + RH_Q), (bf16_t*)(rh + RH_K), (bf16_t*)(rh + RH_V), (bf16_t*)(rh + RH_G), (const float*)(F.ws + WS_ROPE), 1.0f / (A8_SCALE * W_GU_SCALE)};
              pg8::gemm_phase<pg8::EpiZ, pg8::DenseSched, true>(F.lds, 1024u, 1024u, S, E); }
#else
            { pg8::DenseSched S{(const char*)BUFA, (const char*)(F.ws + WS_WIN) + (size_t)i * 2048 * D * 2, 2048u, 2048u, nMact, 8, 16, F.G, F.wg, last ? TC / 256 : 0, NPX, 7};
              pg8::EpiZ E{(bf16_t*)(rh + RH_ZC), (bf16_t*)(rh + RH_ZG), (bf16_t*)(rh + RH_Q), (bf16_t*)(rh + RH_K), (bf16_t*)(rh + RH_V), (bf16_t*)(rh + RH_G), (const float*)(F.ws + WS_ROPE), 1.0f};
              pg8::gemm_phase(F.lds, 2048u, 2048u, S, E); }
#endif
            { pg8::DenseSched S{(const char*)BUFB, (const char*)(F.ws + WS_WG8) + (size_t)i * 3072 * D, 1024u, 1024u, nMact, 12, D / 128, F.G, F.wg, 0, 0, 0};
              pg8::EpiGate8 E{(bf16_t*)(rh + RH_G)};
              pg8::gemm_phase<pg8::EpiGate8, pg8::DenseSched, true>(F.lds, 1024u, 1024u, S, E); } }
        SEAM(pb + 1, pb + 2);
        if (EN(3) && IN(pb + 2)) REPS(3) { REFRESH(); mixer_phase(F, i, !last); }
        SEAM(pb + 2, pb + 3);
#if MERGE8
        if (EN(4) && IN(pb + 3)) REPS(4) { REFRESH_G(); pg8::Merge12Sched S{(const char*)BUFA, (const char*)(F.ws + WS_WBR) + (size_t)i * D * D * 2, nMact, F.G, F.wg};
            pg8::EpiMerge8 E{(const bf16_t*)(rh + RH_G), (unsigned char*)(rh + RH_GP8)};
            pg8::gemm_phase(F.lds, 2048u, 2048u, S, E); }
#else
        if (EN(4) && IN(pb + 3)) REPS(4) { REFRESH_G(); pg8::MergeSched S{(const char*)BUFA, (const char*)(F.ws + WS_WBR) + (size_t)i * D * D * 2, nMact, F.G, F.wg};
            pg8::EpiMerge E{(const bf16_t*)(rh + RH_G), (bf16_t*)(rh + RH_MIXP), BUFB};
            pg8::gemm_phase(F.lds, 2048u, 2048u, S, E); }
#endif
        SEAM(pb + 3, pb + 4);
#if MERGE8
        if (EN(5) && IN(pb + 4)) REPS(5) { REFRESH_G(); pg8::DenseSched S{(const char*)(rh + RH_GP8), (const char*)(F.ws + WS_WO8) + (size_t)i * D * 3072, 3072u, 3072u, nMact, 4, 3072 / 128, F.G, F.wg, 0, 0, 0};
            pg8::EpiResid E{i == 0 ? as_global(F.a->in[I_X]) : as_global(F.a->out), i == 0 ? as_global(F.a->in[I_CTX]) : XC, as_global(F.a->out), XC, MODL + 2 * D, 1.0f / (GP8_SCALE * W_GU_SCALE)};
            pg8::gemm_phase<pg8::EpiResid, pg8::DenseSched, true>(F.lds, 3072u, 3072u, S, E); }
#else
        if (EN(5) && IN(pb + 4)) REPS(5) { REFRESH_G(); pg8::DenseSched S{(const char*)BUFB, (const char*)(F.ws + WS_WO) + (size_t)i * D * D * 2, 2048u, 2048u, nMact, 4, 16, F.G, F.wg, 0, 0, 0};
            pg8::EpiResid E{i == 0 ? as_global(F.a->in[I_X]) : as_global(F.a->out), i == 0 ? as_global(F.a->in[I_CTX]) : XC, as_global(F.a->out), XC, MODL + 2 * D, 1.0f};
            pg8::gemm_phase(F.lds, 2048u, 2048u, S, E); }
#endif
        SEAM(pb + 4, pb + 5);
        if (EN(6) && IN(pb + 5)) REPS(6) { REFRESH(); NormP P; P.M = Mact; P.layer = i; P.xin_x = as_global(F.a->out); P.xin_c = XC; P.xout_x = as_global(F.a->out); P.xout_c = XC; P.gain = as_global(F.a->in[I_N2G]) + i * D; P.chunk = 3; P.HX = BUFA; P.g2prev = nullptr;
            P.router = as_global(F.a->in[I_ROUTER]) + (size_t)j * D * NEXP;
            if (moe) norm_phase<false, true, false, true>(F, P); else if (i == 0) norm_phase<false, false, false>(F, P); else norm_phase<false, false, false, true>(F, P); }
        if (moe) {
            SEAM(pb + 5, pb + 6);
            if (EN(7) && IN(pb + 6)) REPS(7) { REFRESH(); moe_gather_phase(F, Mact, BUFA); }
            SEAM(pb + 6, pb + 7);
            if (EN(8) && IN(pb + 7)) REPS(8) { REFRESH_G(); pg8::MoeSched S; S.A = (const char*)(F.ws + WS_RA); S.B = (const char*)(F.ws + WS_MGU) + (size_t)j * NEXP * 2 * DFE * D; S.lda = 1024u; S.ldb = 1024u; S.estride = (size_t)2 * DFE * D;
                S.nN = 2 * DFE / 256; S.nt = D / 128; S.G = F.G; S.c = F.wg;
#pragma unroll
                for (int k = 0; k < 9; ++k) S.P[k] = __builtin_amdgcn_readfirstlane(((const int*)(F.ws + WS_META))[k]);
                pg8::EpiGU8 E{(unsigned char*)rh, DFE};
                pg8::gemm_phase<pg8::EpiGU8, pg8::MoeSched, true>(F.lds, 1024u, 1024u, S, E); }
            SEAM(pb + 7, pb + 8);
            if (EN(9) && IN(pb + 8)) REPS(9) { REFRESH_G(); pg8::MoeSched S; S.A = (const char*)rh; S.B = (const char*)(F.ws + WS_MD) + (size_t)j * NEXP * D * DFE; S.lda = (unsigned)DFE; S.ldb = (unsigned)DFE; S.estride = (size_t)D * DFE;
                S.nN = 4; S.nt = DFE / 128; S.G = F.G; S.c = F.wg;
#pragma unroll
                for (int k = 0; k < 9; ++k) S.P[k] = __builtin_amdgcn_readfirstlane(((const int*)(F.ws + WS_META))[k]);
                pg8::EpiMoeDown E{(const int*)(F.ws + WS_RINFO), (bf16_t*)(F.ws + WS_RA), 1.0f / (H8_SCALE * W_D_SCALE)};
                pg8::gemm_phase<pg8::EpiMoeDown, pg8::MoeSched, true>(F.lds, (unsigned)DFE, (unsigned)DFE, S, E); }
        } else {
            SEAM(pb + 5, pb + 7);
            if (EN(10) && IN(pb + 7)) REPS(10) { REFRESH_G();
                if (i == 0) { pg8::DenseSched S{(const char*)BUFA, (const char*)(F.ws + WS_FGU), 2048u, 2048u, nMact, 2 * DFF / 256, 16, F.G, F.wg, 0, 0, 0};
                    pg8::EpiGU E{(bf16_t*)(rh + RH_HD), DFF};
                    pg8::gemm_phase(F.lds, 2048u, 2048u, S, E); }
                else { pg8::DenseSched S{(const char*)BUFA, (const char*)(F.ws + WS_FGU) + (size_t)2 * DFF * D * 2, 1024u, 1024u, nMact, 2 * DFF / 256, D / 128, F.G, F.wg, 0, 0, 0};
                    pg8::EpiGU8 E{(unsigned char*)(rh + RH_HD), DFF};
                    pg8::gemm_phase<pg8::EpiGU8, pg8::DenseSched, true>(F.lds, 1024u, 1024u, S, E); } }
            SEAM(pb + 7, pb + 8);
            if (EN(11) && IN(pb + 8)) REPS(11) { REFRESH_G();
                if (i == 0) { pg8::DenseSched S{(const char*)(rh + RH_HD), (const char*)(F.ws + WS_FD), 2u * DFF, 2u * DFF, nMact, 4, DFF / 64, F.G, F.wg, 0, 0, 0};
                    pg8::EpiResid E{as_global(F.a->out), XC, as_global(F.a->out), XC, MODL + 5 * D, 1.0f};
                    pg8::gemm_phase(F.lds, 2u * DFF, 2u * DFF, S, E); }
                else { pg8::DenseSched S{(const char*)(rh + RH_HD), (const char*)(F.ws + WS_FD) + (size_t)D * DFF * 2, (unsigned)DFF, (unsigned)DFF, nMact, 4, DFF / 128, F.G, F.wg, 0, 0, 0};
                    pg8::EpiResid E{as_global(F.a->out), XC, as_global(F.a->out), XC, MODL + 5 * D, 1.0f / (H8_SCALE * W_D_SCALE)};
                    pg8::gemm_phase<pg8::EpiResid, pg8::DenseSched, true>(F.lds, (unsigned)DFF, (unsigned)DFF, S, E); } }
        }
        SEAM(pb + 8, pb + 9);
    }
    if (EN(12) && IN(37)) REPS(12) { REFRESH(); NormP P; P.M = TX; P.layer = DEPTH - 1; P.xin_x = as_global(F.a->out); P.xin_c = XC; P.xout_x = as_global(F.a->out); P.xout_c = XC; P.gain = as_global(F.a->in[I_FNG]); P.chunk = 0; P.HX = nullptr;
        P.g2prev = MODALL + (size_t)(DEPTH - 1) * NMODR * 6144 + 5 * D; P.router = nullptr;
        norm_phase<true, false, true>(F, P); }
#undef IN
#undef SEAM
#undef rh
#undef BUFA
#undef BUFB
#undef XC
#undef MODALL
#undef MODL
}


extern "C" void kernel_launch(void* const* d_in, const int* in_sizes, int n_in, void* d_out, int out_size, void* d_ws, size_t ws_size, hipStream_t stream) {
    static int grid = 0;
    if (grid == 0) {
        if (n_in != 23 || out_size != TX * D || ws_size < WS_END) { fprintf(stderr, "kernel_launch: unexpected shapes (n_in %d, out %d, ws %zu < %zu)\n", n_in, out_size, ws_size, (size_t)WS_END); grid = -1; return; }
        int dev = 0, cus = 0, per_cu = 0;
        if (hipGetDevice(&dev) != hipSuccess || hipDeviceGetAttribute(&cus, hipDeviceAttributeMultiprocessorCount, dev) != hipSuccess) { grid = -1; return; }
        if (hipFuncSetAttribute((const void*)fwd, hipFuncAttributeMaxDynamicSharedMemorySize, LDS_BYTES) != hipSuccess) { fprintf(stderr, "kernel_launch: hipFuncSetAttribute failed\n"); grid = -1; return; }
        if (hipOccupancyMaxActiveBlocksPerMultiprocessor(&per_cu, (const void*)fwd, NTHREADS, LDS_BYTES) != hipSuccess || per_cu < 1) fprintf(stderr, "kernel_launch: occupancy query says %d\n", per_cu);
        (void)hipGetLastError();
        grid = cus > 256 ? 256 : cus;
    }
    if (grid < 0) return;
    (void)hipMemsetAsync((char*)d_ws + WS_CTL, 0, CTL_BYTES, stream);
    Args a{};
    for (int i = 0; i < 23; ++i) a.in[i] = (GAS const float*)d_in[i];
    a.out = (GAS float*)d_out; a.ws = (GAS unsigned char*)d_ws;
#if MK_MULTI
    for (int p = 0; p < NPHASES; ++p) { if (p >= 1 && p < 37) { const int i = (p - 1) / 9, k = (p - 1) % 9; if (k == 6 && !(i & 1)) continue; }
        a.ph_lo = p; a.ph_hi = p + 1; hipLaunchKernelGGL(fwd, dim3(grid), dim3(NTHREADS), LDS_BYTES, stream, a); }
#else
    a.ph_lo = 0; a.ph_hi = NPHASES;
    hipLaunchKernelGGL(fwd, dim3(grid), dim3(NTHREADS), LDS_BYTES, stream, a);
#endif
    const hipError_t le = hipPeekAtLastError();
    if (le != hipSuccess) fprintf(stderr, "kernel_launch: launch failed: %s\n", hipGetErrorName(le));
}
```
